# Optimizing an MI355X kernel written in HIP

```python
import math
import jax, jax.numpy as jnp
from jax import lax
import numpy as np

D_MODEL = 1024
BATCH = 8
SEQ = 2048
DEPTH = 2
DEC_BATCH = 128
DEC_SEQ = 4
PAST_LEN = 16384
PAGE_SIZE = 128

S5_WIDTH = D_MODEL // 2
S5_GROUP = 16
S5_GROUPS = S5_WIDTH // S5_GROUP
S5_STATE = 64
SSD_INNER = D_MODEL
SSD_HEAD_DIM = 64
SSD_HEADS = SSD_INNER // SSD_HEAD_DIM
SSD_GROUPS = 4
SSD_STATE = 128
SSD_CONV = 4
SSD_CONV_DIM = SSD_INNER + 2 * SSD_GROUPS * SSD_STATE
SSD_CHUNK = 128
HG_WIDTH = D_MODEL // 2
HG_EXPAND = 128
HG_HEADS = HG_WIDTH // HG_EXPAND
HG_KDIM = HG_EXPAND
HG_VDIM = HG_WIDTH // HG_HEADS
HG_CHUNK = 64
D_FF = ((8 * D_MODEL // 3 + 127) // 128) * 128
FFN_CONV = 3
N_BRANCH = 3
EPS = 1e-6
IN_COLS = S5_WIDTH + SSD_INNER + SSD_CONV_DIM + SSD_HEADS + 4 * HG_WIDTH + N_BRANCH * D_MODEL

kernel_name = 'hybrid_s5_ssd_hgrn2_gated_step'


def rms_norm(x, w):
    xf = x.astype(jnp.float32)
    y = xf * lax.rsqrt(jnp.mean(xf * xf, axis=-1, keepdims=True) + EPS)
    return (y * w.astype(jnp.float32)).astype(x.dtype)


def pad_time(t, n):
    return jnp.pad(t, [(0, 0), (0, n)] + [(0, 0)] * (t.ndim - 2))


def causal_dwconv(h, prev, w, b):
    L = h.shape[1]
    K = w.shape[0]
    cat = jnp.concatenate([prev.astype(h.dtype), h], axis=1)
    y = cat[:, 0:L] * w[0]
    for j in range(1, K):
        y = y + cat[:, j:j + L] * w[j]
    return y + b, cat[:, L:]


def s5_mixer(u, h0_re, h0_im, log_dt, lam_re, lam_im, b_re, b_im, c_re, c_im, d):
    f32 = jnp.float32
    bsz, L, _ = u.shape
    uf = u.astype(f32)
    ug = uf.reshape(bsz, L, S5_GROUPS, S5_GROUP)
    delta = jnp.exp(log_dt.astype(f32))[:, None]
    lr = lam_re.astype(f32)
    li = lam_im.astype(f32)
    mag = jnp.exp(lr * delta)
    ab_re = mag * jnp.cos(li * delta)
    ab_im = mag * jnp.sin(li * delta)
    den = lr * lr + li * li
    nr = ab_re - 1.0
    co_re = (nr * lr + ab_im * li) / den
    co_im = (ab_im * lr - nr * li) / den
    br = b_re.astype(f32)
    bi = b_im.astype(f32)
    bb_re = co_re[..., None] * br - co_im[..., None] * bi
    bb_im = co_re[..., None] * bi + co_im[..., None] * br
    bu_re = jnp.einsum('gnj,blgj->blgn', bb_re, ug)
    bu_im = jnp.einsum('gnj,blgj->blgn', bb_im, ug)
    a_re = jnp.broadcast_to(ab_re, bu_re.shape)
    a_im = jnp.broadcast_to(ab_im, bu_im.shape)

    def combine(e1, e2):
        a1r, a1i, b1r, b1i = e1
        a2r, a2i, b2r, b2i = e2
        return (a1r * a2r - a1i * a2i, a1r * a2i + a1i * a2r,
                a2r * b1r - a2i * b1i + b2r, a2r * b1i + a2i * b1r + b2i)

    _, _, xr, xi = lax.associative_scan(combine, (a_re, a_im, bu_re, bu_im), axis=1)
    t = jnp.arange(1, L + 1, dtype=f32)[:, None, None]
    pm = jnp.exp(lr * delta * t)
    ph = li * delta * t
    p_re = pm * jnp.cos(ph)
    p_im = pm * jnp.sin(ph)
    h0r = h0_re.astype(f32)[:, None]
    h0i = h0_im.astype(f32)[:, None]
    xr = xr + p_re * h0r - p_im * h0i
    xi = xi + p_re * h0i + p_im * h0r
    y = (jnp.einsum('gjn,blgn->blgj', c_re.astype(f32), xr)
         - jnp.einsum('gjn,blgn->blgj', c_im.astype(f32), xi))
    y = y.reshape(bsz, L, S5_WIDTH) + d.astype(f32) * uf
    return y.astype(u.dtype), xr[:, -1], xi[:, -1]


def ssd_scan(x, dt, a, bm, cm, s0):
    bsz, L = x.shape[:2]
    Q = min(SSD_CHUNK, L)
    nc = -(-L // Q)
    pad = nc * Q - L
    R = SSD_HEADS // SSD_GROUPS
    xc = pad_time(x, pad).reshape(bsz, nc, Q, SSD_GROUPS, R, SSD_HEAD_DIM)
    dtc = pad_time(dt, pad).reshape(bsz, nc, Q, SSD_GROUPS, R)
    bc = pad_time(bm, pad).reshape(bsz, nc, Q, SSD_GROUPS, SSD_STATE)
    cc = pad_time(cm, pad).reshape(bsz, nc, Q, SSD_GROUPS, SSD_STATE)
    acum = jnp.cumsum(dtc * a.reshape(SSD_GROUPS, R), axis=2)
    mask = jnp.tril(jnp.ones((Q, Q), dtype=bool))[:, :, None, None]
    seg = acum[:, :, :, None] - acum[:, :, None]
    decay = jnp.exp(jnp.where(mask, seg, -jnp.inf))
    cb = jnp.einsum('bcqgn,bcsgn->bcqsg', cc, bc)
    xdt = xc * dtc[..., None]
    y_diag = jnp.einsum('bcqsgr,bcsgrp->bcqgrp', cb[..., None] * decay, xdt)
    last = acum[:, :, -1:]
    st = jnp.einsum('bcsgn,bcsgrp->bcgrpn', bc, xdt * jnp.exp(last - acum)[..., None])

    def step(s, inp):
        dec, add = inp
        return dec[..., None, None] * s + add, s

    s_fin, s_prev = lax.scan(step, s0.reshape(bsz, SSD_GROUPS, R, SSD_HEAD_DIM, SSD_STATE),
                             (jnp.moveaxis(jnp.exp(last[:, :, 0]), 1, 0), jnp.moveaxis(st, 1, 0)))
    s_prev = jnp.moveaxis(s_prev, 0, 1)
    y_off = jnp.einsum('bcqgn,bcgrpn->bcqgrp', cc, s_prev) * jnp.exp(acum)[..., None]
    y = (y_diag + y_off).reshape(bsz, nc * Q, SSD_HEADS, SSD_HEAD_DIM)[:, :L]
    return y, s_fin.reshape(bsz, SSD_HEADS, SSD_HEAD_DIM, SSD_STATE)


def hgrn2_scan(q, logf, k, v, s0):
    bsz, L = q.shape[:2]
    Q = min(HG_CHUNK, L)
    nc = -(-L // Q)
    pad = nc * Q - L

    def to_chunks(t):
        t = pad_time(t, pad)
        return jnp.moveaxis(t.reshape((bsz, nc, Q) + t.shape[2:]), 1, 0)

    mask = jnp.tril(jnp.ones((Q, Q), dtype=bool))[None, :, :, None, None]

    def step(s, inp):
        qb, fb, kb, vb = inp
        bcum = jnp.cumsum(fb, axis=1)
        seg = bcum[:, :, None] - bcum[:, None]
        dec = jnp.exp(jnp.where(mask, seg, -jnp.inf))
        att = jnp.einsum('bqhk,bqshk,bshk->bhqs', qb, dec, kb)
        o = (jnp.einsum('bhqs,bshv->bqhv', att, vb)
             + jnp.einsum('bqhk,bhkv->bqhv', qb * jnp.exp(bcum), s))
        blast = bcum[:, -1]
        kd = kb * jnp.exp(blast[:, None] - bcum)
        s_new = jnp.exp(blast)[..., None] * s + jnp.einsum('bshk,bshv->bhkv', kd, vb)
        return s_new, o

    s_fin, o = lax.scan(step, s0, (to_chunks(q), to_chunks(logf), to_chunks(k), to_chunks(v)))
    o = jnp.moveaxis(o, 0, 1).reshape(bsz, nc * Q, HG_HEADS, HG_VDIM)[:, :L]
    return o, s_fin


def layer(x, st, p, lb):
    s5_re0, s5_im0, ssd0, ssd_conv0, hg0, ffn_conv0 = st
    f32 = jnp.float32
    bsz, L, _ = x.shape
    h = rms_norm(x, p['norm1_w'])
    proj = h @ p['w_in']
    widths = (S5_WIDTH, SSD_INNER, SSD_CONV_DIM, SSD_HEADS, HG_WIDTH, HG_WIDTH, HG_WIDTH, HG_WIDTH)
    cuts = [sum(widths[:i + 1]) for i in range(len(widths))]
    u_a, z_b, xbc, dt_raw, q_c, f_c, i_c, g_c, gate_logits = jnp.split(proj, cuts, axis=-1)

    y_a, s5_re1, s5_im1 = s5_mixer(u_a, s5_re0, s5_im0, p['s5_log_dt'], p['s5_lambda_re'], p['s5_lambda_im'],
                                   p['s5_b_re'], p['s5_b_im'], p['s5_c_re'], p['s5_c_im'], p['s5_d'])
    glu = jax.nn.gelu(y_a) @ p['s5_w_glu']
    out_a = glu[..., :D_MODEL] * jax.nn.sigmoid(glu[..., D_MODEL:])

    xbc_c, ssd_conv1 = causal_dwconv(xbc, ssd_conv0, p['ssd_conv_w'], p['ssd_conv_b'])
    xbc_c = jax.nn.silu(xbc_c)
    nb = SSD_GROUPS * SSD_STATE
    xs = xbc_c[..., :SSD_INNER].reshape(bsz, L, SSD_HEADS, SSD_HEAD_DIM).astype(f32)
    bm = xbc_c[..., SSD_INNER:SSD_INNER + nb].reshape(bsz, L, SSD_GROUPS, SSD_STATE).astype(f32)
    cm = xbc_c[..., SSD_INNER + nb:].reshape(bsz, L, SSD_GROUPS, SSD_STATE).astype(f32)
    dt = jax.nn.softplus(dt_raw.astype(f32) + p['ssd_dt_bias'].astype(f32))
    a = -jnp.exp(p['ssd_a_log'].astype(f32))
    y_b, ssd1 = ssd_scan(xs, dt, a, bm, cm, ssd0.astype(f32))
    y_b = y_b + p['ssd_d'].astype(f32)[:, None] * xs
    y_b = y_b.reshape(bsz, L, SSD_INNER).astype(x.dtype) * jax.nn.silu(z_b)
    out_b = rms_norm(y_b, p['ssd_norm_w']) @ p['ssd_w_out']

    zf = f_c.astype(f32).reshape(bsz, L, HG_HEADS, HG_KDIM)
    lbh = lb.reshape(HG_HEADS, HG_KDIM)
    logf = jnp.logaddexp(jnp.log(lbh), jnp.log1p(-lbh) + jax.nn.log_sigmoid(zf))
    k_c = (1.0 - lbh) * jax.nn.sigmoid(-zf)
    q = q_c.astype(f32).reshape(bsz, L, HG_HEADS, HG_KDIM)
    v = i_c.astype(f32).reshape(bsz, L, HG_HEADS, HG_VDIM)
    o_c, hg1 = hgrn2_scan(q, logf, k_c, v, hg0.astype(f32))
    o_c = rms_norm(o_c, p['hg_norm_w'].reshape(HG_HEADS, HG_VDIM)).reshape(bsz, L, HG_WIDTH).astype(x.dtype)
    out_c = (o_c * jax.nn.silu(g_c)) @ p['hg_w_out']

    gts = jax.nn.sigmoid(gate_logits.reshape(bsz, L, N_BRANCH, D_MODEL))
    mixed = gts[..., 0, :] * out_a + gts[..., 1, :] * out_b + gts[..., 2, :] * out_c
    x = x + mixed @ p['w_o']

    up = rms_norm(x, p['norm2_w']) @ p['ffn_w_up']
    a_ff = up[..., :D_FF]
    g_ff = up[..., D_FF:]
    a_conv, ffn_conv1 = causal_dwconv(a_ff, ffn_conv0, p['ffn_conv_w'], p['ffn_conv_b'])
    x = x + (jax.nn.silu(a_conv) * g_ff) @ p['ffn_w_down']
    dt_ = x.dtype
    new = (s5_re1.astype(dt_), s5_im1.astype(dt_), ssd1.astype(dt_), ssd_conv1.astype(dt_),
           hg1.astype(dt_), ffn_conv1.astype(dt_))
    return x, new


def setup_inputs(seed: int = 0) -> dict:
    key = jax.random.key(seed)
    ks = iter(jax.random.split(key, 48))
    f32 = jnp.float32

    def nrm(shape, scale):
        return jax.random.normal(next(ks), shape, f32) * scale

    def unif(shape, lo, hi):
        return jax.random.uniform(next(ks), shape, f32, lo, hi)

    x_prompt = nrm((BATCH, SEQ, D_MODEL), 1.0)
    x_sample = nrm((DEC_BATCH, DEC_SEQ, D_MODEL), 1.0)
    state_s5_re = nrm((DEPTH, DEC_BATCH, S5_GROUPS, S5_STATE), 0.1)
    state_s5_im = nrm((DEPTH, DEC_BATCH, S5_GROUPS, S5_STATE), 0.1)
    state_ssd = nrm((DEPTH, DEC_BATCH, SSD_HEADS, SSD_HEAD_DIM, SSD_STATE), 0.1)
    state_ssd_conv = nrm((DEPTH, DEC_BATCH, SSD_CONV - 1, SSD_CONV_DIM), 1.0)
    state_hgrn = nrm((DEPTH, DEC_BATCH, HG_HEADS, HG_KDIM, HG_VDIM), 0.5)
    state_ffn_conv = nrm((DEPTH, DEC_BATCH, FFN_CONV - 1, D_FF), 1.0)

    norm1_w = 1.0 + nrm((DEPTH, D_MODEL), 0.1)
    w_in = nrm((DEPTH, D_MODEL, IN_COLS), D_MODEL ** -0.5)
    s5_log_dt = unif((DEPTH, S5_GROUPS), math.log(1e-3), math.log(1e-1))
    s5_lambda_re = -0.5 + nrm((DEPTH, S5_GROUPS, S5_STATE), 0.01)
    s5_lambda_im = jnp.pi * jnp.arange(S5_STATE, dtype=f32) + nrm((DEPTH, S5_GROUPS, S5_STATE), 0.01)
    s5_b_re = nrm((DEPTH, S5_GROUPS, S5_STATE, S5_GROUP), (2 * S5_GROUP) ** -0.5)
    s5_b_im = nrm((DEPTH, S5_GROUPS, S5_STATE, S5_GROUP), (2 * S5_GROUP) ** -0.5)
    s5_c_re = nrm((DEPTH, S5_GROUPS, S5_GROUP, S5_STATE), S5_STATE ** -0.5)
    s5_c_im = nrm((DEPTH, S5_GROUPS, S5_GROUP, S5_STATE), S5_STATE ** -0.5)
    s5_d = nrm((DEPTH, S5_WIDTH), 1.0)
    s5_w_glu = nrm((DEPTH, S5_WIDTH, 2 * D_MODEL), S5_WIDTH ** -0.5)
    ssd_conv_w = nrm((DEPTH, SSD_CONV, SSD_CONV_DIM), SSD_CONV ** -0.5)
    ssd_conv_b = nrm((DEPTH, SSD_CONV_DIM), 0.01)
    dt0 = jnp.exp(unif((DEPTH, SSD_HEADS), math.log(1e-3), math.log(1e-1)))
    ssd_dt_bias = dt0 + jnp.log(-jnp.expm1(-dt0))
    ssd_a_log = jnp.log(unif((DEPTH, SSD_HEADS), 1.0, 16.0))
    ssd_d = 1.0 + nrm((DEPTH, SSD_HEADS), 0.1)
    ssd_norm_w = 1.0 + nrm((DEPTH, SSD_INNER), 0.1)
    ssd_w_out = nrm((DEPTH, SSD_INNER, D_MODEL), SSD_INNER ** -0.5)
    hg_lb_logits = nrm((DEPTH, HG_WIDTH), 1.0)
    hg_norm_w = 1.0 + nrm((DEPTH, HG_WIDTH), 0.1)
    hg_w_out = nrm((DEPTH, HG_WIDTH, D_MODEL), HG_WIDTH ** -0.5)
    w_o = nrm((DEPTH, D_MODEL, D_MODEL), D_MODEL ** -0.5)
    norm2_w = 1.0 + nrm((DEPTH, D_MODEL), 0.1)
    ffn_w_up = nrm((DEPTH, D_MODEL, 2 * D_FF), D_MODEL ** -0.5)
    ffn_conv_w = nrm((DEPTH, FFN_CONV, D_FF), FFN_CONV ** -0.5)
    ffn_conv_b = nrm((DEPTH, D_FF), 0.01)
    ffn_w_down = nrm((DEPTH, D_FF, D_MODEL), D_FF ** -0.5)
    norm_f_w = 1.0 + nrm((D_MODEL,), 0.1)
    return {
        'x_prompt': x_prompt, 'x_sample': x_sample,
        'state_s5_re': state_s5_re, 'state_s5_im': state_s5_im, 'state_ssd': state_ssd,
        'state_ssd_conv': state_ssd_conv, 'state_hgrn': state_hgrn, 'state_ffn_conv': state_ffn_conv,
        'norm1_w': norm1_w, 'w_in': w_in,
        's5_log_dt': s5_log_dt, 's5_lambda_re': s5_lambda_re, 's5_lambda_im': s5_lambda_im,
        's5_b_re': s5_b_re, 's5_b_im': s5_b_im, 's5_c_re': s5_c_re, 's5_c_im': s5_c_im,
        's5_d': s5_d, 's5_w_glu': s5_w_glu,
        'ssd_conv_w': ssd_conv_w, 'ssd_conv_b': ssd_conv_b, 'ssd_dt_bias': ssd_dt_bias,
        'ssd_a_log': ssd_a_log, 'ssd_d': ssd_d, 'ssd_norm_w': ssd_norm_w, 'ssd_w_out': ssd_w_out,
        'hg_lb_logits': hg_lb_logits, 'hg_norm_w': hg_norm_w, 'hg_w_out': hg_w_out,
        'w_o': w_o, 'norm2_w': norm2_w,
        'ffn_w_up': ffn_w_up, 'ffn_conv_w': ffn_conv_w, 'ffn_conv_b': ffn_conv_b, 'ffn_w_down': ffn_w_down,
        'norm_f_w': norm_f_w,
    }


def reference(x_prompt, x_sample, state_s5_re, state_s5_im, state_ssd, state_ssd_conv, state_hgrn,
              state_ffn_conv, norm1_w, w_in, s5_log_dt, s5_lambda_re, s5_lambda_im, s5_b_re, s5_b_im,
              s5_c_re, s5_c_im, s5_d, s5_w_glu, ssd_conv_w, ssd_conv_b, ssd_dt_bias, ssd_a_log, ssd_d,
              ssd_norm_w, ssd_w_out, hg_lb_logits, hg_norm_w, hg_w_out, w_o, norm2_w, ffn_w_up,
              ffn_conv_w, ffn_conv_b, ffn_w_down, norm_f_w):
    f32 = jnp.float32
    lb_cum = jnp.cumsum(jax.nn.softmax(hg_lb_logits.astype(f32), axis=0), axis=0)
    lb_all = lb_cum - lb_cum[0:1]
    bp = x_prompt.shape[0]
    dtp = x_prompt.dtype
    zeros_p = (jnp.zeros((bp, S5_GROUPS, S5_STATE), dtp), jnp.zeros((bp, S5_GROUPS, S5_STATE), dtp),
               jnp.zeros((bp, SSD_HEADS, SSD_HEAD_DIM, SSD_STATE), dtp),
               jnp.zeros((bp, SSD_CONV - 1, SSD_CONV_DIM), dtp),
               jnp.zeros((bp, HG_HEADS, HG_KDIM, HG_VDIM), dtp),
               jnp.zeros((bp, FFN_CONV - 1, D_FF), dtp))
    xp = x_prompt
    xs = x_sample
    new_p = []
    new_s = []
    for l in range(DEPTH):
        p = {'norm1_w': norm1_w[l], 'w_in': w_in[l], 's5_log_dt': s5_log_dt[l],
             's5_lambda_re': s5_lambda_re[l], 's5_lambda_im': s5_lambda_im[l],
             's5_b_re': s5_b_re[l], 's5_b_im': s5_b_im[l], 's5_c_re': s5_c_re[l], 's5_c_im': s5_c_im[l],
             's5_d': s5_d[l], 's5_w_glu': s5_w_glu[l],
             'ssd_conv_w': ssd_conv_w[l], 'ssd_conv_b': ssd_conv_b[l], 'ssd_dt_bias': ssd_dt_bias[l],
             'ssd_a_log': ssd_a_log[l], 'ssd_d': ssd_d[l], 'ssd_norm_w': ssd_norm_w[l],
             'ssd_w_out': ssd_w_out[l], 'hg_norm_w': hg_norm_w[l], 'hg_w_out': hg_w_out[l],
             'w_o': w_o[l], 'norm2_w': norm2_w[l], 'ffn_w_up': ffn_w_up[l],
             'ffn_conv_w': ffn_conv_w[l], 'ffn_conv_b': ffn_conv_b[l], 'ffn_w_down': ffn_w_down[l]}
        xp, sp = layer(xp, zeros_p, p, lb_all[l])
        st_s = (state_s5_re[l], state_s5_im[l], state_ssd[l], state_ssd_conv[l], state_hgrn[l],
                state_ffn_conv[l])
        xs, ss = layer(xs, st_s, p, lb_all[l])
        new_p.append(sp)
        new_s.append(ss)

    def stk(lst, i):
        return jnp.stack([s[i] for s in lst])

    y_prompt = rms_norm(xp, norm_f_w)
    y_sample = rms_norm(xs, norm_f_w)
    return (y_prompt, y_sample,
            stk(new_p, 0), stk(new_p, 1), stk(new_p, 2), stk(new_p, 3), stk(new_p, 4), stk(new_p, 5),
            stk(new_s, 0), stk(new_s, 1), stk(new_s, 2), stk(new_s, 3), stk(new_s, 4), stk(new_s, 5))
```

```cpp
#include <hip/hip_runtime.h>
#include <hip/hip_cooperative_groups.h>
#include <cstdio>
namespace cg = cooperative_groups;

#define LAS __attribute__((address_space(3)))
typedef float f32x2 __attribute__((ext_vector_type(2)));
typedef unsigned u32x2 __attribute__((ext_vector_type(2)));

constexpr int MP = 16384, MS = 512, MT = MP + MS;
constexpr int DM = 1024, NPROJ = 8960, NPROJ_REAL = 8720, DFF = 2816, NUP = 5632;
constexpr int C_U = 0, C_Z = 512, C_XBC = 1536, C_DT = 3584, C_Q = 3600, C_F = 4112, C_I = 4624, C_G = 5136, C_GATE = 5648;
constexpr float EPSN = 1e-6f;
constexpr size_t W_IN = 0, W_GLU = 18350080, W_SSD = 20447232, W_HG = 22544384, W_O3 = 23592960, W_UP = 29884416, W_DN = 41418752;
constexpr size_t OFF_XN = 47185920, OFF_PROJ = 81788928, OFF_AGLU = 384565248, OFF_AHG = 401866752, OFF_SSQ = 419168256, OFF_TCAT = 420249600, OFF_CTL = 524058624, OFF_BAR = 524062720, WS_END = 524079104;
constexpr size_t O_PS5R = 17301504, O_PS5I = 17334272, O_PSSD = 17367040, O_PSSDC = 19464192, O_PHG = 19562496, O_PFFC = 20611072;
constexpr size_t O_SS5R = 20701184, O_SS5I = 21225472, O_SSSD = 21749760, O_SSSDC = 55304192, O_SHG = 56877056, O_SFFC = 73654272;
constexpr int MISC_OFF = 151552, LDS_BYTES = MISC_OFF + 256;

struct Params {
    const float* in[36];
    float* out;
    unsigned char* ws;
};
enum { I_XP = 0, I_XS, I_S5R, I_S5I, I_SSD, I_SSDC, I_HG, I_FFC, I_N1W, I_WIN, I_S5LDT, I_S5LR, I_S5LI, I_S5BR, I_S5BI, I_S5CR, I_S5CI, I_S5D, I_S5GLU,
       I_CONVW, I_CONVB, I_DTB, I_ALOG, I_SSDD, I_SSDNW, I_SSDWO, I_LB, I_HGNW, I_HGWO, I_WO, I_N2W, I_WUP, I_FCW, I_FCB, I_WDN, I_NFW };

namespace pg8 {
#define PG8_LAS __attribute__((address_space(3)))
typedef unsigned short bf16_t;
typedef short bf16x8 __attribute__((ext_vector_type(8)));
typedef float f32x4 __attribute__((ext_vector_type(4)));
typedef unsigned u32x4 __attribute__((ext_vector_type(4)));
constexpr int BM = 256, BK = 64, HALF = 128, HTB = HALF * BK * 2  , STAGE_BYTES = 8 * HTB, NXCD = 8, WGM = 8;

__host__ __device__ __forceinline__ int lds_byte(int r, int c) { const int st = (r >> 4) * 2 + (c >> 5), rr = r & 15, cc = c & 31, ob = rr * 64 + cc * 2; return st * 1024 + (ob ^ (((ob >> 9) & 1) << 5)); }
__host__ __device__ __forceinline__ void stage_rc(int b, int& R, int& C) { const int st = b / 1024, sb = b % 1024, swz = sb ^ (((sb >> 9) & 1) << 5); R = (st >> 1) * 16 + swz / 64; C = (st & 1) * 32 + (swz % 64) / 2; }
__host__ __device__ __forceinline__ int perm32(int rho) { const int n = rho >> 4, i = rho & 15; return 8 * (i >> 2) + 4 * n + (i & 3); }

struct Unit { int pm, pn; };
struct Gemm { const bf16_t* A; const bf16_t* Bt; int M, N, K; };

struct StaticOrder {
    int nM, nN, nwg, G, c;
    __host__ __device__ void init(int M, int N, int G_, int c_) { nM = M / BM; nN = N / BM; nwg = nM * nN; G = G_; c = c_; }
    __host__ __device__ bool next(int i, Unit& u) const {
        const long L = (long)i * G + c; if (L >= nwg) return false;
        int wgid = (int)L; { const int q = nwg / NXCD, r = nwg % NXCD, xcd = wgid % NXCD, off = wgid / NXCD; wgid = (xcd < r ? xcd * (q + 1) : r * (q + 1) + (xcd - r) * q) + off; }
        const int nig = WGM * nN, gid = wgid / nig, fm = gid * WGM, gsz = (nM - fm) < WGM ? (nM - fm) : WGM;
        u.pm = fm + ((wgid % nig) % gsz); u.pn = (wgid % nig) / gsz; return true;
    }
    __device__ __forceinline__ void a_ready(const Unit&) const {}
    __device__ __forceinline__ void done(const Unit&) const {}
};
typedef __bf16 bf16x2_t __attribute__((ext_vector_type(2)));
__device__ __forceinline__ unsigned cvt_pk_bf16(float lo, float hi) { f32x2 v = {lo, hi}; bf16x2_t h = __builtin_convertvector(v, bf16x2_t); return __builtin_bit_cast(unsigned, h); }
__device__ __forceinline__ float bf2f(unsigned b) { return __builtin_bit_cast(float, b << 16); }
__device__ __forceinline__ float bflo(unsigned w) { return __builtin_bit_cast(float, w << 16); }
__device__ __forceinline__ float bfhi(unsigned w) { return __builtin_bit_cast(float, w & 0xffff0000u); }
__device__ __forceinline__ bf16_t f2bf(float f) { return __builtin_bit_cast(bf16_t, (__bf16)f); }
__device__ __forceinline__ float sigm(float x) { return __builtin_amdgcn_rcpf(1.f + __expf(-x)); }
__device__ __forceinline__ float silu(float x) { return x * __builtin_amdgcn_rcpf(1.f + __expf(-x)); }
__device__ __forceinline__ float gelu_tanh(float x) { const float u = 0.7978845608028654f * (x + 0.044715f * x * x * x); const float th = 1.f - 2.f * __builtin_amdgcn_rcpf(__expf(2.f * u) + 1.f); return 0.5f * x * (1.f + th); }
__device__ __forceinline__ float dpp_f(float v, int ctrl_sel) { return v; }
#define DPP_ADD(v, CTRL) ((v) + __builtin_bit_cast(float, __builtin_amdgcn_update_dpp(0, __builtin_bit_cast(int, (v)), (CTRL), 0xF, 0xF, true)))
__device__ __forceinline__ float sum8(float v) { v = DPP_ADD(v, 0xB1); v = DPP_ADD(v, 0x4E); v = DPP_ADD(v, 0x141); return v; }
__device__ __forceinline__ float wave_sum(float v) {
    v = DPP_ADD(v, 0xB1); v = DPP_ADD(v, 0x4E); v = DPP_ADD(v, 0x141); v = DPP_ADD(v, 0x140);
    const float a = __builtin_bit_cast(float, __builtin_amdgcn_readlane(__builtin_bit_cast(int, v), 0)), b = __builtin_bit_cast(float, __builtin_amdgcn_readlane(__builtin_bit_cast(int, v), 16));
    const float c = __builtin_bit_cast(float, __builtin_amdgcn_readlane(__builtin_bit_cast(int, v), 32)), d = __builtin_bit_cast(float, __builtin_amdgcn_readlane(__builtin_bit_cast(int, v), 48));
    return (a + b) + (c + d);
}
__device__ __forceinline__ float wave_prefix(float v, int lane) {
    v = DPP_ADD(v, 0x111); v = DPP_ADD(v, 0x112); v = DPP_ADD(v, 0x114); v = DPP_ADD(v, 0x118);
    const float t0 = __builtin_bit_cast(float, __builtin_amdgcn_readlane(__builtin_bit_cast(int, v), 15)), t1 = __builtin_bit_cast(float, __builtin_amdgcn_readlane(__builtin_bit_cast(int, v), 31));
    const float t2 = __builtin_bit_cast(float, __builtin_amdgcn_readlane(__builtin_bit_cast(int, v), 47));
    const int r = lane >> 4;
    return v + (r >= 1 ? t0 : 0.f) + (r >= 2 ? t1 : 0.f) + (r >= 3 ? t2 : 0.f);
}

struct EpiStoreBf16 {
    static constexpr bool PERM = true, AFTER_DRAIN = false;
    bf16_t* O; int ldc;
    __device__ __forceinline__ void operator()(const f32x4 (&acc)[2][2][4][2], const Unit& u, int wr, int wc, int fr, int fq) const {
        const int row0 = u.pm * BM + wr * 64 + fr, col0 = u.pn * BM + wc * 32 + 8 * fq;
#pragma unroll
        for (int ai = 0; ai < 2; ++ai)
#pragma unroll
            for (int m = 0; m < 4; ++m) { bf16_t* rowp = O + (size_t)(row0 + ai * HALF + m * 16) * ldc + col0;
#pragma unroll
                for (int bj = 0; bj < 2; ++bj) { const f32x4 v0 = acc[ai][bj][m][0], v1 = acc[ai][bj][m][1];
                    u32x4 w; w.x = cvt_pk_bf16(v0[0], v0[1]); w.y = cvt_pk_bf16(v0[2], v0[3]); w.z = cvt_pk_bf16(v1[0], v1[1]); w.w = cvt_pk_bf16(v1[2], v1[3]);
                    *(u32x4*)(rowp + bj * HALF) = w; } }
    }
};
struct EpiGlu {
    static constexpr bool PERM = true, AFTER_DRAIN = false;
    const bf16_t* proj; bf16_t* tcat;
    __device__ __forceinline__ void operator()(const f32x4 (&acc)[2][2][4][2], const Unit& u, int wr, int wc, int fr, int fq) const {
        const int row0 = u.pm * BM + wr * 64 + fr, oc = u.pn * 128 + wc * 32 + 8 * fq;
#pragma unroll
        for (int ai = 0; ai < 2; ++ai) {
            u32x4 gl[4], od[4];
#pragma unroll
            for (int m = 0; m < 4; ++m) { const size_t r = (size_t)(row0 + ai * HALF + m * 16); gl[m] = *(const u32x4*)(proj + r * NPROJ + C_GATE + oc); od[m] = *(const u32x4*)(tcat + r * 1024 + oc); }
            __builtin_amdgcn_sched_barrier(0);
#pragma unroll
            for (int m = 0; m < 4; ++m) { const size_t r = (size_t)(row0 + ai * HALF + m * 16);
                const f32x4 a0 = acc[ai][0][m][0], a1 = acc[ai][0][m][1], g0 = acc[ai][1][m][0], g1 = acc[ai][1][m][1];
                float t[8];
                t[0] = sigm(bflo(gl[m].x)) * a0[0] * sigm(g0[0]) + bflo(od[m].x); t[1] = sigm(bfhi(gl[m].x)) * a0[1] * sigm(g0[1]) + bfhi(od[m].x);
                t[2] = sigm(bflo(gl[m].y)) * a0[2] * sigm(g0[2]) + bflo(od[m].y); t[3] = sigm(bfhi(gl[m].y)) * a0[3] * sigm(g0[3]) + bfhi(od[m].y);
                t[4] = sigm(bflo(gl[m].z)) * a1[0] * sigm(g1[0]) + bflo(od[m].z); t[5] = sigm(bfhi(gl[m].z)) * a1[1] * sigm(g1[1]) + bfhi(od[m].z);
                t[6] = sigm(bflo(gl[m].w)) * a1[2] * sigm(g1[2]) + bflo(od[m].w); t[7] = sigm(bfhi(gl[m].w)) * a1[3] * sigm(g1[3]) + bfhi(od[m].w);
                u32x4 w; w.x = cvt_pk_bf16(t[0], t[1]); w.y = cvt_pk_bf16(t[2], t[3]); w.z = cvt_pk_bf16(t[4], t[5]); w.w = cvt_pk_bf16(t[6], t[7]);
                *(u32x4*)(tcat + r * 1024 + oc) = w; }
            __builtin_amdgcn_sched_barrier(0);
        }
    }
};
template <bool RSTD, bool RMW> struct EpiSG {
    static constexpr bool PERM = true, AFTER_DRAIN = false;
    const bf16_t* proj; bf16_t* tcat; const float* ssq; int br;
    __device__ __forceinline__ void operator()(const f32x4 (&acc)[2][2][4][2], const Unit& u, int wr, int wc, int fr, int fq) const {
        const int row0 = u.pm * BM + wr * 64 + fr, col0 = u.pn * BM + wc * 32 + 8 * fq;
#pragma unroll
        for (int ai = 0; ai < 2; ++ai) {
            float sc[4] = {1.f, 1.f, 1.f, 1.f};
            if (RSTD) { f32x4 sv[4][4];
#pragma unroll
                for (int m = 0; m < 4; ++m) { const f32x4* sp = (const f32x4*)(ssq + (size_t)(row0 + ai * HALF + m * 16) * 16); sv[m][0] = sp[0]; sv[m][1] = sp[1]; sv[m][2] = sp[2]; sv[m][3] = sp[3]; }
                __builtin_amdgcn_sched_barrier(0);
#pragma unroll
                for (int m = 0; m < 4; ++m) { const f32x4 q = (sv[m][0] + sv[m][1]) + (sv[m][2] + sv[m][3]); sc[m] = 1.f / sqrtf(((q[0] + q[1]) + (q[2] + q[3])) * (1.f / 1024.f) + EPSN); } }
            u32x4 gl[4][2], od[4][2];
#pragma unroll
            for (int m = 0; m < 4; ++m)
#pragma unroll
                for (int bj = 0; bj < 2; ++bj) { const size_t r = (size_t)(row0 + ai * HALF + m * 16); const int c = col0 + bj * HALF;
                    gl[m][bj] = *(const u32x4*)(proj + r * NPROJ + C_GATE + br * 1024 + c); if (RMW) od[m][bj] = *(const u32x4*)(tcat + r * 1024 + c); }
            __builtin_amdgcn_sched_barrier(0);
#pragma unroll
            for (int m = 0; m < 4; ++m)
#pragma unroll
                for (int bj = 0; bj < 2; ++bj) { const size_t r = (size_t)(row0 + ai * HALF + m * 16); const int c = col0 + bj * HALF;
                    const f32x4 v0 = acc[ai][bj][m][0], v1 = acc[ai][bj][m][1]; const u32x4 g = gl[m][bj]; const float s = sc[m];
                    float t[8] = { sigm(bflo(g.x)) * s * v0[0], sigm(bfhi(g.x)) * s * v0[1], sigm(bflo(g.y)) * s * v0[2], sigm(bfhi(g.y)) * s * v0[3],
                                   sigm(bflo(g.z)) * s * v1[0], sigm(bfhi(g.z)) * s * v1[1], sigm(bflo(g.w)) * s * v1[2], sigm(bfhi(g.w)) * s * v1[3] };
                    if (RMW) { const u32x4 o = od[m][bj];
                        t[0] += bflo(o.x); t[1] += bfhi(o.x); t[2] += bflo(o.y); t[3] += bfhi(o.y); t[4] += bflo(o.z); t[5] += bfhi(o.z); t[6] += bflo(o.w); t[7] += bfhi(o.w); }
                    u32x4 w; w.x = cvt_pk_bf16(t[0], t[1]); w.y = cvt_pk_bf16(t[2], t[3]); w.z = cvt_pk_bf16(t[4], t[5]); w.w = cvt_pk_bf16(t[6], t[7]);
                    *(u32x4*)(tcat + r * 1024 + c) = w; }
            __builtin_amdgcn_sched_barrier(0);
        }
    }
};
struct EpiRes {
    static constexpr bool PERM = false, AFTER_DRAIN = false;
    const float* xp; const float* xs; float* xres; int from_in;
    __device__ __forceinline__ void operator()(const f32x4 (&acc)[2][2][4][2], const Unit& u, int wr, int wc, int fr, int fq) const {
        const int row0 = u.pm * BM + wr * 64 + fr, col0 = u.pn * BM + wc * 32 + 4 * fq;
#pragma unroll
        for (int ai = 0; ai < 2; ++ai) {
            f32x4 bs[4][2][2];
#pragma unroll
            for (int m = 0; m < 4; ++m) { const int r = row0 + ai * HALF + m * 16;
                const float* src = from_in ? (r < MP ? xp + (size_t)r * DM : xs + (size_t)(r - MP) * DM) + col0 : xres + (size_t)r * DM + col0;
#pragma unroll
                for (int bj = 0; bj < 2; ++bj)
#pragma unroll
                    for (int n = 0; n < 2; ++n) bs[m][bj][n] = *(const f32x4*)(src + bj * HALF + n * 16); }
            __builtin_amdgcn_sched_barrier(0);
#pragma unroll
            for (int m = 0; m < 4; ++m) { float* dst = xres + (size_t)(row0 + ai * HALF + m * 16) * DM + col0;
#pragma unroll
                for (int bj = 0; bj < 2; ++bj)
#pragma unroll
                    for (int n = 0; n < 2; ++n) *(f32x4*)(dst + bj * HALF + n * 16) = bs[m][bj][n] + acc[ai][bj][m][n]; }
            __builtin_amdgcn_sched_barrier(0);
        }
    }
};

template <class Epi, class Sched>
__device__ __forceinline__ void gemm_phase(PG8_LAS unsigned char* lds, const Gemm g, const Sched& S, const Epi& E, int tid_in) {
    int tid = tid_in; asm volatile("" : "+v"(tid));
    const int wid = __builtin_amdgcn_readfirstlane(tid >> 6), lane = tid & 63, wr = wid >> 2, wc = wid & 3, fr = lane & 15, fq = lane >> 4;
    const int K = g.K, nt = K / BK;
    unsigned voffA[2], voffB[2];
#pragma unroll
    for (int i = 0; i < 2; ++i) { int R, C; stage_rc(tid * 16 + i * 8192, R, C); const int Rb = Epi::PERM ? ((R & ~31) + perm32(R & 31)) : R;
        voffA[i] = (unsigned)(R * K + C) * 2u; voffB[i] = (unsigned)(Rb * K + C) * 2u; }
    const size_t kstep = (size_t)(BK * 2);
    const size_t hstep = (size_t)HALF * K * 2;
    const size_t tstep = 2 * hstep;
    const unsigned ldsw = (unsigned)wid * 1024u;
    const int aoff = lds_byte(wr * 64 + fr, fq * 8), boff = lds_byte(wc * 32 + fr, fq * 8);
#define PG8_SA(b, h) (((b) * 2 + (h)) * HTB)
#define PG8_SB(b, h) ((4 + (b) * 2 + (h)) * HTB)
#define PG8_STAGE(bufoff, gbase, voff) do { _Pragma("unroll") for (int _i = 0; _i < 2; ++_i) \
        __builtin_amdgcn_global_load_lds((const unsigned*)((const char*)(gbase) + (voff)[_i]), (PG8_LAS unsigned*)(lds + (bufoff) + ldsw + _i * 8192), 16, 0, 0); } while (0)
#define PG8_LDA(dst, b, h) do { _Pragma("unroll") for (int m = 0; m < 4; ++m) _Pragma("unroll") for (int k = 0; k < 2; ++k) dst[m][k] = *(const PG8_LAS bf16x8*)(lds + PG8_SA(b, h) + aoff + m * 2048 + k * 1024); } while (0)
#define PG8_LDB(dst, b, h) do { _Pragma("unroll") for (int n = 0; n < 2; ++n) _Pragma("unroll") for (int k = 0; k < 2; ++k) dst[n][k] = *(const PG8_LAS bf16x8*)(lds + PG8_SB(b, h) + boff + n * 2048 + k * 1024); } while (0)
#define PG8_MMA(ai, bj, At, Bt) do { __builtin_amdgcn_s_setprio(1); _Pragma("unroll") for (int m = 0; m < 4; ++m) _Pragma("unroll") for (int n = 0; n < 2; ++n) _Pragma("unroll") for (int k = 0; k < 2; ++k) \
        acc[ai][bj][m][n] = __builtin_amdgcn_mfma_f32_16x16x32_bf16(Bt[n][k], At[m][k], acc[ai][bj][m][n], 0, 0, 0); __builtin_amdgcn_s_setprio(0); } while (0)
#define PG8_WAIT_V(n) asm volatile("s_waitcnt vmcnt(" #n ")" ::: "memory")
#define PG8_WAIT_L(n) asm volatile("s_waitcnt lgkmcnt(" #n ")" ::: "memory")
#define PG8_BAR __builtin_amdgcn_s_barrier()
#define PG8_SCHED __builtin_amdgcn_sched_barrier(0)
    Unit cur, nxt; int ui = 0;
    if (!S.next(0, cur)) return;
    f32x4 acc[2][2][4][2];
#pragma unroll
    for (int a = 0; a < 2; ++a)
#pragma unroll
        for (int b = 0; b < 2; ++b)
#pragma unroll
            for (int m = 0; m < 4; ++m)
#pragma unroll
                for (int n = 0; n < 2; ++n) acc[a][b][m][n] = (f32x4){0.f, 0.f, 0.f, 0.f};
    bf16x8 At[4][2], B0[2][2], B1[2][2];
    const char* cA = (const char*)g.A + (size_t)cur.pm * tstep; const char* cB = (const char*)g.Bt + (size_t)cur.pn * tstep;
    S.a_ready(cur);
    PG8_STAGE(PG8_SB(0, 0), cB, voffB); PG8_STAGE(PG8_SA(0, 0), cA, voffA); PG8_STAGE(PG8_SB(0, 1), cB + hstep, voffB); PG8_STAGE(PG8_SA(0, 1), cA + hstep, voffA);
    if (wr == 1) PG8_BAR;
    PG8_WAIT_V(4); PG8_BAR;
    PG8_STAGE(PG8_SB(1, 0), cB + kstep, voffB); PG8_STAGE(PG8_SA(1, 0), cA + kstep, voffA); PG8_STAGE(PG8_SB(1, 1), cB + hstep + kstep, voffB);
    PG8_WAIT_V(6); PG8_BAR;
    for (;;) {
        const bool has_next = S.next(ui + 1, nxt);
        const char* nA = has_next ? (const char*)g.A + (size_t)nxt.pm * tstep : cA; const char* nB = has_next ? (const char*)g.Bt + (size_t)nxt.pn * tstep : cB;
        for (int t = 0; t < nt; t += 2) {
            const bool last = (t == nt - 2);
            const char* a1 = cA + (size_t)(t + 1) * kstep;
            const char* a2 = last ? nA : cA + (size_t)(t + 2) * kstep; const char* b2 = last ? nB : cB + (size_t)(t + 2) * kstep;
            const char* a3 = a2 + kstep; const char* b3 = b2 + kstep;
            if (last && has_next) S.a_ready(nxt);
            PG8_LDB(B0, 0, 0); PG8_SCHED; PG8_LDA(At, 0, 0); PG8_STAGE(PG8_SA(1, 1), a1 + hstep, voffA);
            PG8_WAIT_L(8); PG8_BAR; PG8_WAIT_L(0); PG8_MMA(0, 0, At, B0); PG8_BAR; PG8_SCHED;
            PG8_LDB(B1, 0, 1); PG8_STAGE(PG8_SB(0, 0), b2, voffB);
            PG8_BAR; PG8_WAIT_L(0); PG8_MMA(0, 1, At, B1); PG8_BAR;
            PG8_LDA(At, 0, 1); PG8_STAGE(PG8_SA(0, 0), a2, voffA);
            PG8_BAR; PG8_WAIT_L(0); PG8_MMA(1, 0, At, B0); PG8_BAR; PG8_SCHED;
            PG8_STAGE(PG8_SB(0, 1), b2 + hstep, voffB);
            PG8_WAIT_V(6); PG8_BAR; PG8_MMA(1, 1, At, B1); PG8_BAR;
            PG8_LDB(B0, 1, 0); PG8_SCHED; PG8_LDA(At, 1, 0); PG8_STAGE(PG8_SA(0, 1), a2 + hstep, voffA);
            PG8_WAIT_L(8); PG8_BAR; PG8_WAIT_L(0); PG8_MMA(0, 0, At, B0); PG8_BAR; PG8_SCHED;
            PG8_LDB(B1, 1, 1); PG8_STAGE(PG8_SB(1, 0), b3, voffB);
            PG8_BAR; PG8_WAIT_L(0); PG8_MMA(0, 1, At, B1); PG8_BAR;
            PG8_LDA(At, 1, 1); PG8_STAGE(PG8_SA(1, 0), a3, voffA);
            PG8_BAR; PG8_WAIT_L(0); PG8_MMA(1, 0, At, B0); PG8_BAR; PG8_SCHED;
            PG8_STAGE(PG8_SB(1, 1), b3 + hstep, voffB);
            PG8_WAIT_V(6); PG8_BAR; PG8_MMA(1, 1, At, B1); PG8_BAR;
        }
        if constexpr (!Epi::AFTER_DRAIN) { E(acc, cur, wr, wc, fr, fq); S.done(cur); }
        if (!has_next) break;
#pragma unroll
        for (int a = 0; a < 2; ++a)
#pragma unroll
            for (int b = 0; b < 2; ++b)
#pragma unroll
                for (int m = 0; m < 4; ++m)
#pragma unroll
                    for (int n = 0; n < 2; ++n) acc[a][b][m][n] = (f32x4){0.f, 0.f, 0.f, 0.f};
        cur = nxt; cA = nA; cB = nB; ++ui;
    }
    PG8_WAIT_V(0);
    if (wr == 0) PG8_BAR;
    PG8_BAR;
    if constexpr (Epi::AFTER_DRAIN) { E.fused(acc, cur, wr, wc, fr, fq, lds, wid, lane); S.done(cur); }
#undef PG8_SA
#undef PG8_SB
#undef PG8_STAGE
#undef PG8_LDA
#undef PG8_LDB
#undef PG8_MMA
#undef PG8_WAIT_V
#undef PG8_WAIT_L
#undef PG8_BAR
#undef PG8_SCHED
}
}
using namespace pg8;
constexpr int NTH = 512;

template <int MODE>
__device__ __forceinline__ void cvt_wt(const float* W, int K, int N, int Nphys, bf16_t* WT, int ldk, int koff, LAS float* scr, int tid, int rot) {
    const int nnb = Nphys / 64, ntile = (K / 64) * nnb;
    int bx_ = blockIdx.x; asm volatile("" : "+s"(bx_));
    for (int it = (bx_ + rot) % (int)gridDim.x; it < ntile; it += gridDim.x) {
        const int kb = it / nnb, nb = it % nnb, k0 = kb * 64, n0 = nb * 64;
        int src0 = n0;
        if (MODE == 2) { const int blk = n0 >> 8, within = n0 & 255; src0 = (within >> 7) * 1024 + blk * 128 + (within & 127); }
        const int c = tid & 63;
#pragma unroll
        for (int i = 0; i < 8; ++i) { const int kk = (tid >> 6) + 8 * i;
            float v = 0.f; if (MODE != 1 || src0 + c < N) v = W[(size_t)(k0 + kk) * N + src0 + c];
            scr[kk * 65 + c] = v; }
        __syncthreads();
        { const int n = tid >> 3, ch = tid & 7; const LAS float* s = scr + (8 * ch) * 65 + n;
          u32x4 o; o.x = cvt_pk_bf16(s[0], s[65]); o.y = cvt_pk_bf16(s[130], s[195]); o.z = cvt_pk_bf16(s[260], s[325]); o.w = cvt_pk_bf16(s[390], s[455]);
          *(u32x4*)(WT + (size_t)(n0 + n) * ldk + koff + k0 + 8 * ch) = o; }
        __syncthreads();
    }
}
__device__ __forceinline__ void convert_weights(const Params& P, int l, LAS unsigned char* L, int tid) {
    LAS float* scr = (LAS float*)L; unsigned char* ws = P.ws;
    cvt_wt<1>(P.in[I_WIN] + (size_t)l * 1024 * NPROJ_REAL, 1024, NPROJ_REAL, NPROJ, (bf16_t*)(ws + W_IN), 1024, 0, scr, tid, 0);
    cvt_wt<2>(P.in[I_S5GLU] + (size_t)l * 512 * 2048, 512, 2048, 2048, (bf16_t*)(ws + W_GLU), 512, 0, scr, tid, 192);
    cvt_wt<0>(P.in[I_SSDWO] + (size_t)l * 1024 * 1024, 1024, 1024, 1024, (bf16_t*)(ws + W_SSD), 1024, 0, scr, tid, 192);
    cvt_wt<0>(P.in[I_HGWO] + (size_t)l * 512 * 1024, 512, 1024, 1024, (bf16_t*)(ws + W_HG), 512, 0, scr, tid, 192);
    cvt_wt<0>(P.in[I_WO] + (size_t)l * 1024 * 1024, 1024, 1024, 1024, (bf16_t*)(ws + W_O3), 1024, 0, scr, tid, 64);
    cvt_wt<0>(P.in[I_WUP] + (size_t)l * 1024 * NUP, 1024, NUP, NUP, (bf16_t*)(ws + W_UP), 1024, 0, scr, tid, 128);
    cvt_wt<0>(P.in[I_WDN] + (size_t)l * DFF * 1024, DFF, 1024, 1024, (bf16_t*)(ws + W_DN), DFF, 0, scr, tid, 0);
}

__device__ __forceinline__ void norm_rows_bf16(const Params& P, int from_in, const float* w, bf16_t* out, int tid) {
    const int lane = tid & 63, gw = blockIdx.x * 8 + (tid >> 6), ngw = gridDim.x * 8;
    f32x4 wv[4];
#pragma unroll
    for (int j = 0; j < 4; ++j) wv[j] = ((const f32x4*)w)[lane + 64 * j];
    for (int row = gw; row < MT; row += ngw) {
        const float* xr = from_in ? (row < MP ? P.in[I_XP] + (size_t)row * DM : P.in[I_XS] + (size_t)(row - MP) * DM) : P.out + (size_t)row * DM;
        f32x4 v[4]; float ss = 0.f;
#pragma unroll
        for (int j = 0; j < 4; ++j) { v[j] = ((const f32x4*)xr)[lane + 64 * j]; ss += (v[j][0] * v[j][0] + v[j][1] * v[j][1]) + (v[j][2] * v[j][2] + v[j][3] * v[j][3]); }
        const float rstd = 1.f / sqrtf(wave_sum(ss) * (1.f / 1024.f) + EPSN);
        u32x2* o = (u32x2*)(out + (size_t)row * DM);
#pragma unroll
        for (int j = 0; j < 4; ++j) { u32x2 q; q.x = cvt_pk_bf16(v[j][0] * rstd * wv[j][0], v[j][1] * rstd * wv[j][1]); q.y = cvt_pk_bf16(v[j][2] * rstd * wv[j][2], v[j][3] * rstd * wv[j][3]); o[lane + 64 * j] = q; }
    }
}
__device__ __forceinline__ void final_norm(const Params& P, int tid) {
    const int lane = tid & 63, gw = blockIdx.x * 8 + (tid >> 6), ngw = gridDim.x * 8;
    const float* w = P.in[I_NFW];
    f32x4 wv[4];
#pragma unroll
    for (int j = 0; j < 4; ++j) wv[j] = ((const f32x4*)w)[lane + 64 * j];
    for (int row = gw; row < MT; row += ngw) {
        float* xr = P.out + (size_t)row * DM;
        f32x4 v[4]; float ss = 0.f;
#pragma unroll
        for (int j = 0; j < 4; ++j) { v[j] = ((const f32x4*)xr)[lane + 64 * j]; ss += (v[j][0] * v[j][0] + v[j][1] * v[j][1]) + (v[j][2] * v[j][2] + v[j][3] * v[j][3]); }
        const float rstd = 1.f / sqrtf(wave_sum(ss) * (1.f / 1024.f) + EPSN);
#pragma unroll
        for (int j = 0; j < 4; ++j) ((f32x4*)xr)[lane + 64 * j] = v[j] * rstd * wv[j];
    }
}

__device__ __forceinline__ void ffn_conv_phase(const Params& P, int l, int tid) {
    const bf16_t* up = (const bf16_t*)(P.ws + OFF_PROJ); bf16_t* hff = (bf16_t*)(P.ws + OFF_TCAT);
    const float* cw = P.in[I_FCW] + (size_t)l * 3 * DFF; const float* cb = P.in[I_FCB] + (size_t)l * DFF;
    const int total = MT * 352;
    for (int idx = blockIdx.x * NTH + tid; idx < total; idx += gridDim.x * NTH) {
        const int row = idx / 352, c0 = (idx - row * 352) * 8;
        int t, b; const bool pr = row < MP;
        if (pr) { b = row >> 11; t = row & 2047; } else { b = (row - MP) >> 2; t = (row - MP) & 3; }
        const u32x4 a2 = *(const u32x4*)(up + (size_t)row * NUP + c0);
        const u32x4 gg = *(const u32x4*)(up + (size_t)row * NUP + DFF + c0);
        float x2[8] = { bflo(a2.x), bfhi(a2.x), bflo(a2.y), bfhi(a2.y), bflo(a2.z), bfhi(a2.z), bflo(a2.w), bfhi(a2.w) };
        float gv[8] = { bflo(gg.x), bfhi(gg.x), bflo(gg.y), bfhi(gg.y), bflo(gg.z), bfhi(gg.z), bflo(gg.w), bfhi(gg.w) };
        float x1[8], x0[8];
        if (t >= 1) { const u32x4 a1 = *(const u32x4*)(up + (size_t)(row - 1) * NUP + c0);
            x1[0] = bflo(a1.x); x1[1] = bfhi(a1.x); x1[2] = bflo(a1.y); x1[3] = bfhi(a1.y); x1[4] = bflo(a1.z); x1[5] = bfhi(a1.z); x1[6] = bflo(a1.w); x1[7] = bfhi(a1.w);
        } else if (!pr) { const float* st = P.in[I_FFC] + ((size_t)(l * 128 + b) * 2 + 1) * DFF + c0;
#pragma unroll
            for (int i = 0; i < 8; ++i) x1[i] = st[i];
        } else {
#pragma unroll
            for (int i = 0; i < 8; ++i) x1[i] = 0.f; }
        if (t >= 2) { const u32x4 a0 = *(const u32x4*)(up + (size_t)(row - 2) * NUP + c0);
            x0[0] = bflo(a0.x); x0[1] = bfhi(a0.x); x0[2] = bflo(a0.y); x0[3] = bfhi(a0.y); x0[4] = bflo(a0.z); x0[5] = bfhi(a0.z); x0[6] = bflo(a0.w); x0[7] = bfhi(a0.w);
        } else if (!pr) { const float* st = P.in[I_FFC] + ((size_t)(l * 128 + b) * 2 + t) * DFF + c0;
#pragma unroll
            for (int i = 0; i < 8; ++i) x0[i] = st[i];
        } else {
#pragma unroll
            for (int i = 0; i < 8; ++i) x0[i] = 0.f; }
        float hv[8];
#pragma unroll
        for (int i = 0; i < 8; ++i) { const float cv = x0[i] * cw[c0 + i] + x1[i] * cw[DFF + c0 + i] + x2[i] * cw[2 * DFF + c0 + i] + cb[c0 + i]; hv[i] = silu(cv) * gv[i]; }
        u32x4 o; o.x = cvt_pk_bf16(hv[0], hv[1]); o.y = cvt_pk_bf16(hv[2], hv[3]); o.z = cvt_pk_bf16(hv[4], hv[5]); o.w = cvt_pk_bf16(hv[6], hv[7]);
        *(u32x4*)(hff + (size_t)row * DFF + c0) = o;
        if (pr && t >= 2046) { float* d = P.out + O_PFFC + ((size_t)(l * 8 + b) * 2 + (t - 2046)) * DFF + c0;
#pragma unroll
            for (int i = 0; i < 8; ++i) d[i] = x2[i]; }
        if (!pr && t >= 2) { float* d = P.out + O_SFFC + ((size_t)(l * 128 + b) * 2 + (t - 2)) * DFF + c0;
#pragma unroll
            for (int i = 0; i < 8; ++i) d[i] = x2[i]; }
    }
}

__device__ __forceinline__ float softplus(float x) { const float t = __expf(x); const float sm = t * (1.f - t * (0.5f - t * 0.33333334f)); return x > 20.f ? x : (t < 0.03f ? sm : __logf(1.f + t)); }

__device__ __forceinline__ void ssd_item(const Params& P, int l, bool prompt, int b, int h, LAS unsigned char* L, int tid) {
    const int Lseq = prompt ? 2048 : 4, row0 = prompt ? b * 2048 : MP + b * 4, g = h >> 2;
    LAS float* Bs = (LAS float*)L; LAS float* Cs = Bs + 4096; LAS float* xs = Cs + 4096; LAS float* zs = xs + 2048; LAS float* yb = zs + 2048; LAS float* dts = yb + 2048; LAS float* dAs = dts + 32;
    const bf16_t* proj = (const bf16_t*)(P.ws + OFF_PROJ);
    int role = 3, col = 0, xc = 0, dstride = 64; LAS float* dst = xs;
    if (tid < 128) { xc = 1024 + g * 128 + tid; dst = Bs + tid; dstride = 128; role = 0; }
    else if (tid < 256) { xc = 1536 + g * 128 + (tid - 128); dst = Cs + (tid - 128); dstride = 128; role = 0; }
    else if (tid < 320) { xc = h * 64 + (tid - 256); dst = xs + (tid - 256); dstride = 64; role = 0; }
    else if (tid < 384) { col = C_Z + h * 64 + (tid - 320); dst = zs + (tid - 320); dstride = 64; role = 1; }
    else if (tid < 416) role = 2;
    if (role == 0) col = C_XBC + xc;
    float w0 = 0.f, w1 = 0.f, w2 = 0.f, w3 = 0.f, cb = 0.f, r0 = 0.f, r1 = 0.f, r2 = 0.f;
    if (role == 0) { const float* cw = P.in[I_CONVW] + (size_t)l * 4 * 2048; w0 = cw[xc]; w1 = cw[2048 + xc]; w2 = cw[4096 + xc]; w3 = cw[6144 + xc]; cb = P.in[I_CONVB][l * 2048 + xc];
        if (!prompt) { const float* st = P.in[I_SSDC] + (size_t)(l * 128 + b) * 3 * 2048; r0 = st[xc]; r1 = st[2048 + xc]; r2 = st[4096 + xc]; } }
    const float dt_bias = P.in[I_DTB][l * 16 + h], aneg = -__expf(P.in[I_ALOG][l * 16 + h]), Dh = P.in[I_SSDD][l * 16 + h];
    const int p = tid >> 3, ns = tid & 7;
    f32x4 s[4];
    if (prompt) {
#pragma unroll
        for (int i = 0; i < 4; ++i) s[i] = (f32x4){0.f, 0.f, 0.f, 0.f};
    } else { const float* sp = P.in[I_SSD] + ((size_t)((l * 128 + b) * 16 + h) * 64 + p) * 128 + 4 * ns;
#pragma unroll
        for (int i = 0; i < 4; ++i) s[i] = *(const f32x4*)(sp + 32 * i); }
    bf16_t* Assd = (bf16_t*)(P.ws + OFF_XN); float* ssq = (float*)(P.ws + OFF_SSQ);
    const float* nw = P.in[I_SSDNW] + l * 1024 + h * 64;
    unsigned short rv[4];
#define SSD_LOAD(T0) do { if (role <= 1) { _Pragma("unroll") for (int tt = 0; tt < 4; ++tt) { int r_ = (T0) + tt; r_ = r_ < Lseq ? r_ : Lseq - 1; rv[tt] = proj[(size_t)(row0 + r_) * NPROJ + col]; } } \
        else if (role == 2) { int r_ = (T0) + (tid - 384); r_ = r_ < Lseq ? r_ : Lseq - 1; rv[0] = proj[(size_t)(row0 + r_) * NPROJ + C_DT + h]; } } while (0)
    SSD_LOAD(0);
    for (int t0 = 0; t0 < Lseq; t0 += 32) {
        const int len = (Lseq - t0) < 32 ? (Lseq - t0) : 32;
        if (role == 0) {
#pragma unroll
            for (int tt = 0; tt < 4; ++tt) { const float raw = bf2f(rv[tt]); const float y = r0 * w0 + r1 * w1 + r2 * w2 + raw * w3 + cb; dst[tt * dstride] = silu(y); r0 = r1; r1 = r2; r2 = raw; }
        } else if (role == 1) {
#pragma unroll
            for (int tt = 0; tt < 4; ++tt) dst[tt * dstride] = bf2f(rv[tt]);
        } else if (role == 2) { const int tt = tid - 384;
            const float raw = bf2f(rv[0]); const float dt = softplus(raw + dt_bias); dts[tt] = dt; dAs[tt] = __expf(dt * aneg); }
        __syncthreads();
        if (t0 + 32 < Lseq) SSD_LOAD(t0 + 32);
#define SSD_LD(Bx, Cx, dAx, dtx, xvx, TT) do { const int t_ = (TT) & 31; _Pragma("unroll") for (int i = 0; i < 4; ++i) { Bx[i] = *(const LAS f32x4*)(Bs + t_ * 128 + 32 * i + 4 * ns); Cx[i] = *(const LAS f32x4*)(Cs + t_ * 128 + 32 * i + 4 * ns); } \
            dAx = dAs[t_]; dtx = dts[t_]; xvx = xs[t_ * 64 + p]; } while (0)
#define SSD_STEP(Bx, Cx, dAx, dtx, xvx, TT) do { const float xdt_ = xvx * dtx; f32x4 y4_ = (f32x4){0.f, 0.f, 0.f, 0.f}; \
            _Pragma("unroll") for (int i = 0; i < 4; ++i) { s[i] = s[i] * dAx + Bx[i] * xdt_; y4_ += s[i] * Cx[i]; } \
            const float y_ = sum8((y4_[0] + y4_[1]) + (y4_[2] + y4_[3])); if (ns == 0) yb[(TT) * 64 + p] = y_; } while (0)
        { f32x4 B0[4], C0[4], B1[4], C1[4]; float dA0, dt0, xv0, dA1, dt1, xv1;
          SSD_LD(B0, C0, dA0, dt0, xv0, 0);
          for (int tt = 0; tt < len; tt += 2) {
              SSD_LD(B1, C1, dA1, dt1, xv1, tt + 1);
              SSD_STEP(B0, C0, dA0, dt0, xv0, tt);
              SSD_LD(B0, C0, dA0, dt0, xv0, tt + 2);
              SSD_STEP(B1, C1, dA1, dt1, xv1, tt + 1);
          } }
        __syncthreads();
        { const int tt = tid >> 4, q = tid & 15; f32x4 v = *(const LAS f32x4*)(yb + tt * 64 + 4 * q);
          { const f32x4 xv4 = *(const LAS f32x4*)(xs + tt * 64 + 4 * q), z4 = *(const LAS f32x4*)(zs + tt * 64 + 4 * q);
            v[0] = (v[0] + Dh * xv4[0]) * silu(z4[0]); v[1] = (v[1] + Dh * xv4[1]) * silu(z4[1]); v[2] = (v[2] + Dh * xv4[2]) * silu(z4[2]); v[3] = (v[3] + Dh * xv4[3]) * silu(z4[3]); }
          float sq = (v[0] * v[0] + v[1] * v[1]) + (v[2] * v[2] + v[3] * v[3]);
          sq = sum8(sq); sq = DPP_ADD(sq, 0x140);
          if (tt < len) { const size_t row = (size_t)(row0 + t0 + tt); const f32x4 wv = *(const f32x4*)(nw + 4 * q);
              u32x2 o; o.x = cvt_pk_bf16(v[0] * wv[0], v[1] * wv[1]); o.y = cvt_pk_bf16(v[2] * wv[2], v[3] * wv[3]);
              *(u32x2*)(Assd + row * DM + h * 64 + 4 * q) = o;
              if (q == 0) ssq[row * 16 + h] = sq; } }
    }
    { float* sp = P.out + (prompt ? O_PSSD + ((size_t)((l * 8 + b) * 16 + h) * 64 + p) * 128 : O_SSSD + ((size_t)((l * 128 + b) * 16 + h) * 64 + p) * 128) + 4 * ns;
#pragma unroll
      for (int i = 0; i < 4; ++i) *(f32x4*)(sp + 32 * i) = s[i]; }
    __syncthreads();
}

__device__ __forceinline__ void ssd_s4_item(const Params& P, int l, int b, int g, LAS unsigned char* L, int tid) {
    const int row0 = MP + b * 4;
    LAS float* Bs = (LAS float*)L; LAS float* Cs = Bs + 512; LAS float* xs = Cs + 512; LAS float* zs = xs + 1024; LAS float* yb = zs + 1024; LAS float* dts = yb + 1024; LAS float* dAs = dts + 16;
    const bf16_t* proj = (const bf16_t*)(P.ws + OFF_PROJ);
    const bool isx = tid >= 256; const int hh2 = (tid - 256) >> 6, p2 = (tid - 256) & 63;
    const int xc = !isx ? (tid < 128 ? 1024 + g * 128 + tid : 1536 + g * 128 + (tid - 128)) : (4 * g + hh2) * 64 + p2;
    LAS float* dst = !isx ? (tid < 128 ? Bs + tid : Cs + (tid - 128)) : xs + hh2 * 256 + p2;
    const int dstride = !isx ? 128 : 64;
    const float* cw = P.in[I_CONVW] + (size_t)l * 4 * 2048; const float w0 = cw[xc], w1 = cw[2048 + xc], w2 = cw[4096 + xc], w3 = cw[6144 + xc], cb = P.in[I_CONVB][l * 2048 + xc];
    const float* st = P.in[I_SSDC] + (size_t)(l * 128 + b) * 3 * 2048; float r0 = st[xc], r1 = st[2048 + xc], r2 = st[4096 + xc];
    unsigned short rv[4], zv[4] = {0, 0, 0, 0};
#pragma unroll
    for (int tt = 0; tt < 4; ++tt) { rv[tt] = proj[(size_t)(row0 + tt) * NPROJ + C_XBC + xc]; if (isx) zv[tt] = proj[(size_t)(row0 + tt) * NPROJ + C_Z + (4 * g + hh2) * 64 + p2]; }
    float dtr = 0.f, dtb = 0.f, an = 0.f;
    if (tid < 16) { const int hh = tid >> 2, tt = tid & 3; dtr = bf2f(proj[(size_t)(row0 + tt) * NPROJ + C_DT + 4 * g + hh]); dtb = P.in[I_DTB][l * 16 + 4 * g + hh]; an = -__expf(P.in[I_ALOG][l * 16 + 4 * g + hh]); }
    const int p = tid >> 3, ns = tid & 7;
    f32x4 s[4][4];
#pragma unroll
    for (int hh = 0; hh < 4; ++hh) { const float* sp = P.in[I_SSD] + ((size_t)((l * 128 + b) * 16 + 4 * g + hh) * 64 + p) * 128 + 4 * ns;
#pragma unroll
        for (int i = 0; i < 4; ++i) s[hh][i] = *(const f32x4*)(sp + 32 * i); }
#pragma unroll
    for (int tt = 0; tt < 4; ++tt) { const float raw = bf2f(rv[tt]); const float y = r0 * w0 + r1 * w1 + r2 * w2 + raw * w3 + cb; dst[tt * dstride] = silu(y); r0 = r1; r1 = r2; r2 = raw; }
    if (isx) {
#pragma unroll
        for (int tt = 0; tt < 4; ++tt) zs[hh2 * 256 + tt * 64 + p2] = bf2f(zv[tt]); }
    if (tid < 16) { const float dt = softplus(dtr + dtb); dts[tid] = dt; dAs[tid] = __expf(dt * an); }
    __syncthreads();
#pragma unroll
    for (int tt = 0; tt < 4; ++tt) {
        f32x4 Bv[4], Cv[4];
#pragma unroll
        for (int i = 0; i < 4; ++i) { Bv[i] = *(const LAS f32x4*)(Bs + tt * 128 + 32 * i + 4 * ns); Cv[i] = *(const LAS f32x4*)(Cs + tt * 128 + 32 * i + 4 * ns); }
#pragma unroll
        for (int hh = 0; hh < 4; ++hh) { const float dA = dAs[hh * 4 + tt], xdt = xs[hh * 256 + tt * 64 + p] * dts[hh * 4 + tt];
            f32x4 y4 = (f32x4){0.f, 0.f, 0.f, 0.f};
#pragma unroll
            for (int i = 0; i < 4; ++i) { s[hh][i] = s[hh][i] * dA + Bv[i] * xdt; y4 += s[hh][i] * Cv[i]; }
            const float y = sum8((y4[0] + y4[1]) + (y4[2] + y4[3])); if (ns == 0) yb[hh * 256 + tt * 64 + p] = y; }
    }
#pragma unroll
    for (int hh = 0; hh < 4; ++hh) { float* sp = P.out + O_SSSD + ((size_t)((l * 128 + b) * 16 + 4 * g + hh) * 64 + p) * 128 + 4 * ns;
#pragma unroll
        for (int i = 0; i < 4; ++i) *(f32x4*)(sp + 32 * i) = s[hh][i]; }
    __syncthreads();
    { const int pair = (tid >> 4) & 15, q = tid & 15, hh = pair >> 2, tt = pair & 3, h = 4 * g + hh;
      f32x4 v = *(const LAS f32x4*)(yb + pair * 64 + 4 * q); const f32x4 xv4 = *(const LAS f32x4*)(xs + pair * 64 + 4 * q), z4 = *(const LAS f32x4*)(zs + pair * 64 + 4 * q);
      const float Dh = P.in[I_SSDD][l * 16 + h];
      v[0] = (v[0] + Dh * xv4[0]) * silu(z4[0]); v[1] = (v[1] + Dh * xv4[1]) * silu(z4[1]); v[2] = (v[2] + Dh * xv4[2]) * silu(z4[2]); v[3] = (v[3] + Dh * xv4[3]) * silu(z4[3]);
      float sq = (v[0] * v[0] + v[1] * v[1]) + (v[2] * v[2] + v[3] * v[3]);
      sq = sum8(sq); sq = DPP_ADD(sq, 0x140);
      if (tid < 256) { const size_t row = (size_t)(row0 + tt); const f32x4 wv = *(const f32x4*)(P.in[I_SSDNW] + l * 1024 + h * 64 + 4 * q);
          u32x2 o; o.x = cvt_pk_bf16(v[0] * wv[0], v[1] * wv[1]); o.y = cvt_pk_bf16(v[2] * wv[2], v[3] * wv[3]);
          *(u32x2*)((bf16_t*)(P.ws + OFF_XN) + row * DM + h * 64 + 4 * q) = o;
          if (q == 0) ((float*)(P.ws + OFF_SSQ))[row * 16 + h] = sq; } }
    __syncthreads();
}

template <int KT>
__device__ __forceinline__ f32x4 mma_rt(const LAS bf16_t* A, int pa, const LAS bf16_t* Bt, int pb, f32x4 acc, int lane) {
    const LAS bf16_t* ap = A + (lane & 15) * pa + (lane >> 4) * 8; const LAS bf16_t* bp = Bt + (lane & 15) * pb + (lane >> 4) * 8;
#pragma unroll
    for (int kt = 0; kt < KT; ++kt) { const bf16x8 a = *(const LAS bf16x8*)(ap + kt * 32), b = *(const LAS bf16x8*)(bp + kt * 32); acc = __builtin_amdgcn_mfma_f32_16x16x32_bf16(a, b, acc, 0, 0, 0); }
    return acc;
}
__device__ __forceinline__ u32x4 pack8(float a0, float a1, float a2, float a3, float a4, float a5, float a6, float a7) { u32x4 w; w.x = cvt_pk_bf16(a0, a1); w.y = cvt_pk_bf16(a2, a3); w.z = cvt_pk_bf16(a4, a5); w.w = cvt_pk_bf16(a6, a7); return w; }

__device__ __forceinline__ void ssd_mfma_item(const Params& P, int l, int b, int h, LAS unsigned char* L, int tid) {
    constexpr int PC = 136, PT = 72;
    LAS bf16_t* Cl = (LAS bf16_t*)L; LAS bf16_t* Bl = (LAS bf16_t*)(L + 17408); LAS bf16_t* BTl = (LAS bf16_t*)(L + 34816); LAS float* ybuf = (LAS float*)(L + 34816);
    LAS bf16_t* XdT = (LAS bf16_t*)(L + 53248); LAS bf16_t* XwT = (LAS bf16_t*)(L + 62464); LAS bf16_t* Gl = (LAS bf16_t*)(L + 71680); LAS bf16_t* Sl = (LAS bf16_t*)(L + 80896);
    LAS float* xf = (LAS float*)(L + 98304); LAS float* dtl = (LAS float*)(L + 114688); LAS float* acl = dtl + 64;
    const bf16_t* proj = (const bf16_t*)(P.ws + OFF_PROJ);
    const int lane = tid & 63, w = tid >> 6, kq = lane >> 4, lc = lane & 15, g = h >> 2, row0 = b * 2048;
    const float dt_bias = P.in[I_DTB][l * 16 + h], aneg = -__expf(P.in[I_ALOG][l * 16 + h]), Dh = P.in[I_SSDD][l * 16 + h];
    const bool stg = tid < 320; const int oct = tid % 40, rg = tid / 40;
    const int kind = oct < 16 ? 0 : (oct < 32 ? 1 : 2);
    const int ch0 = kind == 0 ? oct * 8 : (kind == 1 ? (oct - 16) * 8 : (oct - 32) * 8);
    const int xc0 = kind == 0 ? 1024 + g * 128 + ch0 : (kind == 1 ? 1536 + g * 128 + ch0 : h * 64 + ch0);
    LAS float* wl = (LAS float*)(L + 115200);
    LAS float* nwl = wl + 1600;
    if (stg) { const int xc = tid < 128 ? 1024 + g * 128 + tid : (tid < 256 ? 1536 + g * 128 + (tid - 128) : h * 64 + (tid - 256));
        const float* cwp = P.in[I_CONVW] + (size_t)l * 4 * 2048 + xc;
        wl[tid] = cwp[0]; wl[320 + tid] = cwp[2048]; wl[640 + tid] = cwp[4096]; wl[960 + tid] = cwp[6144]; wl[1280 + tid] = P.in[I_CONVB][l * 2048 + xc]; }
    else if (tid < 384) nwl[tid - 320] = P.in[I_SSDNW][l * 1024 + h * 64 + (tid - 320)];
    const int cbase = kind == 0 ? ch0 : (kind == 1 ? 128 + ch0 : 256 + ch0);
    for (int i = tid; i < 64 * PC / 2; i += NTH) ((LAS unsigned*)Sl)[i] = 0u;
    f32x4 accS[4];
#pragma unroll
    for (int i = 0; i < 4; ++i) accS[i] = (f32x4){0.f, 0.f, 0.f, 0.f};
    bf16_t* Assd = (bf16_t*)(P.ws + OFF_XN); float* ssq = (float*)(P.ws + OFF_SSQ);
    u32x4 raw[11]; unsigned short dtraw = 0; u32x4 zraw;
#define SSDM_LOAD(C) do { if (stg) { _Pragma("unroll") for (int r = 0; r < 11; ++r) { const int gr_ = (C) * 64 + rg * 8 - 3 + r; \
            raw[r] = gr_ >= 0 ? *(const u32x4*)(proj + (size_t)(row0 + gr_) * NPROJ + C_XBC + xc0) : (u32x4){0u, 0u, 0u, 0u}; } } \
        if (w == 0) dtraw = proj[(size_t)(row0 + (C) * 64 + lane) * NPROJ + C_DT + h]; \
        zraw = *(const u32x4*)(proj + (size_t)(row0 + (C) * 64 + (tid >> 3)) * NPROJ + C_Z + h * 64 + 8 * (tid & 7)); } while (0)
    SSDM_LOAD(0);
    __syncthreads();
    for (int c = 0; c < 32; ++c) {
        if (w == 0) { const float dt = softplus(bf2f(dtraw) + dt_bias); float a = dt * aneg;
            a = wave_prefix(a, lane);
            dtl[lane] = dt; acl[lane] = a; }
        const u32x4 zcur = zraw;
        __syncthreads();
        if (stg) {
            const int sb = rg * 8;
            float cw[4][8], cbv[8];
#pragma unroll
            for (int k = 0; k < 4; ++k) { const f32x4 a = *(const LAS f32x4*)(wl + k * 320 + cbase), c4 = *(const LAS f32x4*)(wl + k * 320 + cbase + 4);
                cw[k][0] = a[0]; cw[k][1] = a[1]; cw[k][2] = a[2]; cw[k][3] = a[3]; cw[k][4] = c4[0]; cw[k][5] = c4[1]; cw[k][6] = c4[2]; cw[k][7] = c4[3]; }
            { const f32x4 a = *(const LAS f32x4*)(wl + 1280 + cbase), c4 = *(const LAS f32x4*)(wl + 1280 + cbase + 4);
              cbv[0] = a[0]; cbv[1] = a[1]; cbv[2] = a[2]; cbv[3] = a[3]; cbv[4] = c4[0]; cbv[5] = c4[1]; cbv[6] = c4[2]; cbv[7] = c4[3]; }
#pragma unroll
            for (int hf = 0; hf < 2; ++hf) {
                float o8[4][8];
#pragma unroll
                for (int i = 0; i < 4; ++i) {
#pragma unroll
                    for (int j = 0; j < 8; ++j) { float y = cbv[j];
#pragma unroll
                        for (int k = 0; k < 4; ++k) { const u32x4 rr = raw[hf * 4 + i + k]; const unsigned wd = (j >> 1) == 0 ? rr.x : ((j >> 1) == 1 ? rr.y : ((j >> 1) == 2 ? rr.z : rr.w));
                            y += cw[k][j] * ((j & 1) ? bfhi(wd) : bflo(wd)); }
                        o8[i][j] = silu(y); } }
                const int s0 = sb + hf * 4;
                if (kind == 0) {
#pragma unroll
                    for (int i = 0; i < 4; ++i) *(LAS u32x4*)(Bl + (s0 + i) * PC + ch0) = pack8(o8[i][0], o8[i][1], o8[i][2], o8[i][3], o8[i][4], o8[i][5], o8[i][6], o8[i][7]);
#pragma unroll
                    for (int j = 0; j < 8; ++j) { u32x2 q; q.x = cvt_pk_bf16(o8[0][j], o8[1][j]); q.y = cvt_pk_bf16(o8[2][j], o8[3][j]); *(LAS u32x2*)(BTl + (ch0 + j) * PT + s0) = q; }
                } else if (kind == 1) {
#pragma unroll
                    for (int i = 0; i < 4; ++i) *(LAS u32x4*)(Cl + (s0 + i) * PC + ch0) = pack8(o8[i][0], o8[i][1], o8[i][2], o8[i][3], o8[i][4], o8[i][5], o8[i][6], o8[i][7]);
                } else {
                    const f32x4 d0 = *(const LAS f32x4*)(dtl + s0), a0 = *(const LAS f32x4*)(acl + s0);
                    const float alast = acl[63];
                    float dv[4] = {d0[0], d0[1], d0[2], d0[3]};
                    float ev[4] = {a0[0], a0[1], a0[2], a0[3]};
#pragma unroll
                    for (int i = 0; i < 4; ++i) ev[i] = dv[i] * __expf(alast - ev[i]);
#pragma unroll
                    for (int i = 0; i < 4; ++i) { *(LAS f32x4*)(xf + (s0 + i) * 64 + ch0) = (f32x4){o8[i][0], o8[i][1], o8[i][2], o8[i][3]}; *(LAS f32x4*)(xf + (s0 + i) * 64 + ch0 + 4) = (f32x4){o8[i][4], o8[i][5], o8[i][6], o8[i][7]}; }
#pragma unroll
                    for (int j = 0; j < 8; ++j) { u32x2 q;
                        q.x = cvt_pk_bf16(o8[0][j] * dv[0], o8[1][j] * dv[1]); q.y = cvt_pk_bf16(o8[2][j] * dv[2], o8[3][j] * dv[3]); *(LAS u32x2*)(XdT + (ch0 + j) * PT + s0) = q;
                        q.x = cvt_pk_bf16(o8[0][j] * ev[0], o8[1][j] * ev[1]); q.y = cvt_pk_bf16(o8[2][j] * ev[2], o8[3][j] * ev[3]); *(LAS u32x2*)(XwT + (ch0 + j) * PT + s0) = q; }
                }
            }
        }
        __syncthreads();
        if (c + 1 < 32) SSDM_LOAD(c + 1);
        f32x4 y2[2];
#pragma unroll
        for (int ti = 0; ti < 2; ++ti) { const int tile = 2 * w + ti, qi = tile >> 2, si = tile & 3;
            f32x4 acc = (f32x4){0.f, 0.f, 0.f, 0.f};
            if (si <= qi) acc = mma_rt<4>(Cl + qi * 16 * PC, PC, Bl + si * 16 * PC, PC, acc, lane);
            const int q0 = qi * 16 + kq * 4, s = si * 16 + lc; const f32x4 aq = *(const LAS f32x4*)(acl + q0); const float as = acl[s];
#pragma unroll
            for (int j = 0; j < 4; ++j) { const float gv = (s <= q0 + j) ? acc[j] * __expf(aq[j] - as) : 0.f; Gl[(q0 + j) * PT + s] = f2bf(gv); }
            y2[ti] = mma_rt<4>(Cl + qi * 16 * PC, PC, Sl + si * 16 * PC, PC, (f32x4){0.f, 0.f, 0.f, 0.f}, lane);
        }
        __syncthreads();
        f32x4 yv[2];
#pragma unroll
        for (int ti = 0; ti < 2; ++ti) { const int tile = 2 * w + ti, qi = tile >> 2, pi = tile & 3;
            const f32x4 y1 = mma_rt<2>(Gl + qi * 16 * PT, PT, XdT + pi * 16 * PT, PT, (f32x4){0.f, 0.f, 0.f, 0.f}, lane);
            const f32x4 aq = *(const LAS f32x4*)(acl + qi * 16 + kq * 4);
#pragma unroll
            for (int j = 0; j < 4; ++j) yv[ti][j] = y1[j] + __expf(aq[j]) * y2[ti][j]; }
        { const float dec = __expf(acl[63]);
#pragma unroll
          for (int i = 0; i < 4; ++i) { const int tile = 4 * w + i, pi = tile >> 3, ni = tile & 7;
              accS[i] = accS[i] * dec; accS[i] = mma_rt<2>(XwT + pi * 16 * PT, PT, BTl + ni * 16 * PT, PT, accS[i], lane);
#pragma unroll
              for (int j = 0; j < 4; ++j) Sl[(pi * 16 + kq * 4 + j) * PC + ni * 16 + lc] = f2bf(accS[i][j]); } }
        __syncthreads();
#pragma unroll
        for (int ti = 0; ti < 2; ++ti) { const int tile = 2 * w + ti, qi = tile >> 2, pi = tile & 3;
#pragma unroll
            for (int j = 0; j < 4; ++j) ybuf[(qi * 16 + kq * 4 + j) * 68 + pi * 16 + lc] = yv[ti][j]; }
        __syncthreads();
        { const int tt = tid >> 3, q8 = tid & 7; const size_t row = (size_t)(row0 + c * 64 + tt);
          const f32x4 v0 = *(const LAS f32x4*)(ybuf + tt * 68 + 8 * q8), v1 = *(const LAS f32x4*)(ybuf + tt * 68 + 8 * q8 + 4);
          const f32x4 x0 = *(const LAS f32x4*)(xf + tt * 64 + 8 * q8), x1 = *(const LAS f32x4*)(xf + tt * 64 + 8 * q8 + 4);
          const f32x4 nw0 = *(const LAS f32x4*)(nwl + 8 * q8), nw1 = *(const LAS f32x4*)(nwl + 8 * q8 + 4);
          float o[8];
          o[0] = (v0[0] + Dh * x0[0]) * silu(bflo(zcur.x)); o[1] = (v0[1] + Dh * x0[1]) * silu(bfhi(zcur.x));
          o[2] = (v0[2] + Dh * x0[2]) * silu(bflo(zcur.y)); o[3] = (v0[3] + Dh * x0[3]) * silu(bfhi(zcur.y));
          o[4] = (v1[0] + Dh * x1[0]) * silu(bflo(zcur.z)); o[5] = (v1[1] + Dh * x1[1]) * silu(bfhi(zcur.z));
          o[6] = (v1[2] + Dh * x1[2]) * silu(bflo(zcur.w)); o[7] = (v1[3] + Dh * x1[3]) * silu(bfhi(zcur.w));
          float sq = 0.f;
#pragma unroll
          for (int j = 0; j < 8; ++j) sq += o[j] * o[j];
          sq = sum8(sq);
          *(u32x4*)(Assd + row * DM + h * 64 + 8 * q8) = pack8(o[0] * nw0[0], o[1] * nw0[1], o[2] * nw0[2], o[3] * nw0[3], o[4] * nw1[0], o[5] * nw1[1], o[6] * nw1[2], o[7] * nw1[3]);
          if (q8 == 0) ssq[row * 16 + h] = sq; }
    }
#undef SSDM_LOAD
    { int t2 = tid; asm volatile("" : "+v"(t2)); const int lane = t2 & 63, w = t2 >> 6, kq = lane >> 4, lc = lane & 15;
      float* sp = P.out + O_PSSD + (size_t)((l * 8 + b) * 16 + h) * 64 * 128;
#pragma unroll
      for (int i = 0; i < 4; ++i) { const int tile = 4 * w + i, pi = tile >> 3, ni = tile & 7;
#pragma unroll
          for (int j = 0; j < 4; ++j) sp[(size_t)(pi * 16 + kq * 4 + j) * 128 + ni * 16 + lc] = accS[i][j]; } }
    __syncthreads();
}

__device__ __forceinline__ void hg_half(const Params& P, int l, bool prompt, int b, int hd, int vh, LAS unsigned char* L, int tid) {
    const int Lseq = prompt ? 2048 : 4, row0 = prompt ? b * 2048 : MP + b * 4;
    LAS float* fs = (LAS float*)L; LAS float* qs = fs + 4096; LAS float* vs = qs + 4096; LAS float* ob = vs + 2048;
    const bf16_t* proj = (const bf16_t*)(P.ws + OFF_PROJ); float* oraw = (float*)(P.ws + OFF_TCAT);
    int role = 3, col = 0, dstride = 128; LAS float* dst = fs; float lb = 0.f;
    if (tid < 128) { col = C_F + hd * 128 + tid; dst = fs + tid; role = 0;
        if (l > 0) { const float l0 = P.in[I_LB][hd * 128 + tid], l1 = P.in[I_LB][512 + hd * 128 + tid]; lb = 1.f / (1.f + expf(l0 - l1)); } }
    else if (tid < 256) { col = C_Q + hd * 128 + (tid - 128); dst = qs + (tid - 128); role = 1; }
    else if (tid < 320) { col = C_I + hd * 128 + vh * 64 + (tid - 256); dst = vs + (tid - 256); dstride = 64; role = 1; }
    const int v = tid >> 3, ks = tid & 7;
    f32x4 S[4];
    const size_t sbase = ((size_t)hd * 128) * 128 + vh * 64 + v;
    if (prompt) {
#pragma unroll
        for (int i = 0; i < 4; ++i) S[i] = (f32x4){0.f, 0.f, 0.f, 0.f};
    } else { const float* sp = P.in[I_HG] + (size_t)(l * 128 + b) * 4 * 16384 + sbase;
#pragma unroll
        for (int i = 0; i < 4; ++i)
#pragma unroll
            for (int j = 0; j < 4; ++j) S[i][j] = sp[(size_t)(32 * i + 4 * ks + j) * 128]; }
    unsigned short rv[4];
#define HG_LOAD(T0) do { if (role <= 1) { _Pragma("unroll") for (int tt = 0; tt < 4; ++tt) { int r_ = (T0) + tt; r_ = r_ < Lseq ? r_ : Lseq - 1; rv[tt] = proj[(size_t)(row0 + r_) * NPROJ + col]; } } } while (0)
    HG_LOAD(0);
    for (int t0 = 0; t0 < Lseq; t0 += 32) {
        const int len = (Lseq - t0) < 32 ? (Lseq - t0) : 32;
        if (role == 0) {
#pragma unroll
            for (int tt = 0; tt < 4; ++tt) { const float z = bf2f(rv[tt]); dst[tt * 128] = lb + (1.f - lb) * sigm(z); }
        } else if (role == 1) {
#pragma unroll
            for (int tt = 0; tt < 4; ++tt) dst[tt * dstride] = bf2f(rv[tt]);
        }
        __syncthreads();
        if (t0 + 32 < Lseq) HG_LOAD(t0 + 32);
#define HG_LD(Fx, Qx, vvx, TT) do { const int t_ = (TT) & 31; _Pragma("unroll") for (int i = 0; i < 4; ++i) { Fx[i] = *(const LAS f32x4*)(fs + t_ * 128 + 32 * i + 4 * ks); Qx[i] = *(const LAS f32x4*)(qs + t_ * 128 + 32 * i + 4 * ks); } \
            vvx = vs[t_ * 64 + v]; } while (0)
#define HG_STEP(Fx, Qx, vvx, TT) do { f32x4 o4_ = (f32x4){0.f, 0.f, 0.f, 0.f}; \
            _Pragma("unroll") for (int i = 0; i < 4; ++i) { S[i] = Fx[i] * (S[i] - vvx) + vvx; o4_ += S[i] * Qx[i]; } \
            const float o_ = sum8((o4_[0] + o4_[1]) + (o4_[2] + o4_[3])); if (ks == 0) ob[(TT) * 64 + v] = o_; } while (0)
        { f32x4 F0[4], Q0[4], F1[4], Q1[4]; float vv0, vv1;
          HG_LD(F0, Q0, vv0, 0);
          for (int tt = 0; tt < len; tt += 2) {
              HG_LD(F1, Q1, vv1, tt + 1);
              HG_STEP(F0, Q0, vv0, tt);
              HG_LD(F0, Q0, vv0, tt + 2);
              HG_STEP(F1, Q1, vv1, tt + 1);
          } }
        __syncthreads();
        { const int tt = tid >> 4, q = tid & 15;
          if (tt < len) *(f32x4*)(oraw + (size_t)(row0 + t0 + tt) * 512 + hd * 128 + vh * 64 + 4 * q) = *(const LAS f32x4*)(ob + tt * 64 + 4 * q); }
    }
    { float* sp = P.out + (prompt ? O_PHG + (size_t)(l * 8 + b) * 4 * 16384 : O_SHG + (size_t)(l * 128 + b) * 4 * 16384) + sbase;
#pragma unroll
      for (int i = 0; i < 4; ++i)
#pragma unroll
          for (int j = 0; j < 4; ++j) sp[(size_t)(32 * i + 4 * ks + j) * 128] = S[i][j]; }
    __syncthreads();
}
__device__ __forceinline__ void hg_mfma_half(const Params& P, int l, int b, int hd, int vh, LAS unsigned char* L, int tid) {
    constexpr int PC = 136, PT = 72;
    LAS bf16_t* Qt = (LAS bf16_t*)L; LAS bf16_t* Kt = (LAS bf16_t*)(L + 17408); LAS bf16_t* Qs = (LAS bf16_t*)(L + 34816); LAS bf16_t* Al = (LAS bf16_t*)(L + 52224);
    LAS bf16_t* VT = (LAS bf16_t*)(L + 61440); LAS bf16_t* KdT = (LAS bf16_t*)(L + 70656); LAS bf16_t* ST = (LAS bf16_t*)(L + 89088);
    LAS float* tot = (LAS float*)(L + 106496); LAS float* el = (LAS float*)(L + 114688); LAS float* lbl = (LAS float*)(L + 115200); LAS float* plx = (LAS float*)(L + 115712);
    const bf16_t* proj = (const bf16_t*)(P.ws + OFF_PROJ); float* oraw = (float*)(P.ws + OFF_TCAT);
    const int lane = tid & 63, w = tid >> 6, kq = lane >> 4, lc = lane & 15, row0 = b * 2048;
    const bool isf = tid < 256; const int t2 = tid & 255, oct = t2 & 15, rg = t2 >> 4, k0 = oct * 8, s0 = rg * 4;
    const bool hasv = !isf && oct < 8;
    const int colA = (isf ? C_F : C_Q) + hd * 128 + k0, colV = C_I + hd * 128 + vh * 64 + k0;
    if (tid < 128) { float lb = 0.f; if (l > 0) { const float l0 = P.in[I_LB][hd * 128 + tid], l1 = P.in[I_LB][512 + hd * 128 + tid]; lb = 1.f / (1.f + expf(l0 - l1)); } lbl[tid] = lb; }
    for (int i = tid; i < 64 * PC / 2; i += NTH) ((LAS unsigned*)ST)[i] = 0u;
    f32x4 accS[4];
#pragma unroll
    for (int i = 0; i < 4; ++i) accS[i] = (f32x4){0.f, 0.f, 0.f, 0.f};
    u32x4 rawA[4], rawV[4];
#define HGM_LOAD(C) do { _Pragma("unroll") for (int r = 0; r < 4; ++r) { const size_t ro_ = (size_t)(row0 + (C) * 64 + s0 + r) * NPROJ; \
            rawA[r] = *(const u32x4*)(proj + ro_ + colA); if (hasv) rawV[r] = *(const u32x4*)(proj + ro_ + colV); } } while (0)
#define UNP(rr, j) (((j) & 1) ? bfhi(((j) >> 1) == 0 ? (rr).x : (((j) >> 1) == 1 ? (rr).y : (((j) >> 1) == 2 ? (rr).z : (rr).w))) : bflo(((j) >> 1) == 0 ? (rr).x : (((j) >> 1) == 1 ? (rr).y : (((j) >> 1) == 2 ? (rr).z : (rr).w))))
    HGM_LOAD(0);
    __syncthreads();
    for (int c = 0; c < 32; ++c) {
        int tl_ = tid; asm volatile("" : "+v"(tl_));
        const int lane = tl_ & 63, w = tl_ >> 6, kq = lane >> 4, lc = lane & 15;
        const bool isf = tl_ < 256; const int t2 = tl_ & 255, oct = t2 & 15, rg = t2 >> 4, k0 = oct * 8, s0 = rg * 4;
        const bool hasv = !isf && oct < 8;
        const int colA = (isf ? C_F : C_Q) + hd * 128 + k0, colV = C_I + hd * 128 + vh * 64 + k0;
        float pl[4][8], kk[4][8];
        if (isf) {
            const f32x4 la = *(const LAS f32x4*)(lbl + k0), lb4 = *(const LAS f32x4*)(lbl + k0 + 4);
            const float lbv[8] = {la[0], la[1], la[2], la[3], lb4[0], lb4[1], lb4[2], lb4[3]};
#pragma unroll
            for (int j = 0; j < 8; ++j) { float run = 0.f;
#pragma unroll
                for (int i = 0; i < 4; ++i) { const float z = UNP(rawA[i], j); const float t = __expf(-z), r = __builtin_amdgcn_rcpf(1.f + t);
                    const float f = lbv[j] + (1.f - lbv[j]) * r; kk[i][j] = (1.f - lbv[j]) * t * r; run += __logf(f); pl[i][j] = run; } }
            *(LAS f32x4*)(tot + rg * 128 + k0) = (f32x4){pl[3][0], pl[3][1], pl[3][2], pl[3][3]}; *(LAS f32x4*)(tot + rg * 128 + k0 + 4) = (f32x4){pl[3][4], pl[3][5], pl[3][6], pl[3][7]};
#pragma unroll
            for (int i = 0; i < 4; ++i) { *(LAS f32x4*)(plx + (s0 + i) * 128 + k0) = (f32x4){pl[i][0], pl[i][1], pl[i][2], pl[i][3]}; *(LAS f32x4*)(plx + (s0 + i) * 128 + k0 + 4) = (f32x4){pl[i][4], pl[i][5], pl[i][6], pl[i][7]}; }
        } else {
#pragma unroll
            for (int i = 0; i < 4; ++i)
#pragma unroll
                for (int j = 0; j < 8; ++j) { pl[i][j] = 0.f; kk[i][j] = 0.f; }
            if (hasv) {
#pragma unroll
                for (int j = 0; j < 8; ++j) { u32x2 q; q.x = cvt_pk_bf16(UNP(rawV[0], j), UNP(rawV[1], j)); q.y = cvt_pk_bf16(UNP(rawV[2], j), UNP(rawV[3], j)); *(LAS u32x2*)(VT + (k0 + j) * PT + s0) = q; } }
        }
        __syncthreads();
        { float base[8], ref[8], bl[8];
#pragma unroll
          for (int j = 0; j < 8; ++j) { base[j] = 0.f; ref[j] = 0.f; bl[j] = 0.f; }
#pragma unroll
          for (int r = 0; r < 16; ++r) { const f32x4 t0 = *(const LAS f32x4*)(tot + r * 128 + k0), t1 = *(const LAS f32x4*)(tot + r * 128 + k0 + 4);
              const float tv[8] = {t0[0], t0[1], t0[2], t0[3], t1[0], t1[1], t1[2], t1[3]};
#pragma unroll
              for (int j = 0; j < 8; ++j) { if (r < rg) base[j] += tv[j]; if (r < 8) ref[j] += tv[j]; bl[j] += tv[j]; } }
          if (isf) {
              float kt[4][8], kd[4][8];
#pragma unroll
              for (int j = 0; j < 8; ++j) { const float e1 = __expf(bl[j] - ref[j]);
#pragma unroll
                  for (int i = 0; i < 4; ++i) { kt[i][j] = kk[i][j] * __expf(ref[j] - (base[j] + pl[i][j])); kd[i][j] = kt[i][j] * e1; } }
#pragma unroll
              for (int i = 0; i < 4; ++i) *(LAS u32x4*)(Kt + (s0 + i) * PC + k0) = pack8(kt[i][0], kt[i][1], kt[i][2], kt[i][3], kt[i][4], kt[i][5], kt[i][6], kt[i][7]);
#pragma unroll
              for (int j = 0; j < 8; ++j) { u32x2 q; q.x = cvt_pk_bf16(kd[0][j], kd[1][j]); q.y = cvt_pk_bf16(kd[2][j], kd[3][j]); *(LAS u32x2*)(KdT + (k0 + j) * PT + s0) = q; }
              if (rg == 0) { *(LAS f32x4*)(el + k0) = (f32x4){__expf(bl[0]), __expf(bl[1]), __expf(bl[2]), __expf(bl[3])}; *(LAS f32x4*)(el + k0 + 4) = (f32x4){__expf(bl[4]), __expf(bl[5]), __expf(bl[6]), __expf(bl[7])}; }
          } else {
              float e2[8];
#pragma unroll
              for (int j = 0; j < 8; ++j) e2[j] = __expf(ref[j]);
#pragma unroll
              for (int i = 0; i < 4; ++i) { float qt[8], qs[8];
                  const f32x4 p0 = *(const LAS f32x4*)(plx + (s0 + i) * 128 + k0), p1 = *(const LAS f32x4*)(plx + (s0 + i) * 128 + k0 + 4);
                  const float pv[8] = {p0[0], p0[1], p0[2], p0[3], p1[0], p1[1], p1[2], p1[3]};
#pragma unroll
                  for (int j = 0; j < 8; ++j) { const float qv = UNP(rawA[i], j); qt[j] = qv * __expf(base[j] + pv[j] - ref[j]); qs[j] = qt[j] * e2[j]; }
                  *(LAS u32x4*)(Qt + (s0 + i) * PC + k0) = pack8(qt[0], qt[1], qt[2], qt[3], qt[4], qt[5], qt[6], qt[7]);
                  *(LAS u32x4*)(Qs + (s0 + i) * PC + k0) = pack8(qs[0], qs[1], qs[2], qs[3], qs[4], qs[5], qs[6], qs[7]); }
          } }
        __syncthreads();
        if (c + 1 < 32) HGM_LOAD(c + 1);
        f32x4 o2[2];
#pragma unroll
        for (int ti = 0; ti < 2; ++ti) { const int tile = 2 * w + ti, qi = tile >> 2, si = tile & 3;
            f32x4 acc = (f32x4){0.f, 0.f, 0.f, 0.f};
            if (si <= qi) acc = mma_rt<4>(Qt + qi * 16 * PC, PC, Kt + si * 16 * PC, PC, acc, lane);
            const int q0 = qi * 16 + kq * 4, s = si * 16 + lc;
#pragma unroll
            for (int j = 0; j < 4; ++j) Al[(q0 + j) * PT + s] = f2bf((s <= q0 + j) ? acc[j] : 0.f);
            o2[ti] = mma_rt<4>(Qs + qi * 16 * PC, PC, ST + si * 16 * PC, PC, (f32x4){0.f, 0.f, 0.f, 0.f}, lane);
        }
        __syncthreads();
#pragma unroll
        for (int ti = 0; ti < 2; ++ti) { const int tile = 2 * w + ti, qi = tile >> 2, vi = tile & 3;
            const f32x4 o1 = mma_rt<2>(Al + qi * 16 * PT, PT, VT + vi * 16 * PT, PT, o2[ti], lane);
            float* op = oraw + (size_t)(row0 + c * 64 + qi * 16 + kq * 4) * 512 + hd * 128 + vh * 64 + vi * 16 + lc;
#pragma unroll
            for (int j = 0; j < 4; ++j) op[(size_t)j * 512] = o1[j]; }
#pragma unroll
        for (int i = 0; i < 4; ++i) { const int tile = 4 * w + i, vi = tile >> 3, ki = tile & 7;
            const float dec = el[ki * 16 + lc];
            accS[i] = accS[i] * dec; accS[i] = mma_rt<2>(VT + vi * 16 * PT, PT, KdT + ki * 16 * PT, PT, accS[i], lane);
#pragma unroll
            for (int j = 0; j < 4; ++j) ST[(vi * 16 + kq * 4 + j) * PC + ki * 16 + lc] = f2bf(accS[i][j]); }
        __syncthreads();
    }
#undef HGM_LOAD
#undef UNP
    { int t2 = tid; asm volatile("" : "+v"(t2)); const int lane = t2 & 63, w = t2 >> 6, kq = lane >> 4, lc = lane & 15;
      float* sp = P.out + O_PHG + (size_t)((l * 8 + b) * 4 + hd) * 16384 + vh * 64;
#pragma unroll
      for (int i = 0; i < 4; ++i) { const int tile = 4 * w + i, vi = tile >> 3, ki = tile & 7;
#pragma unroll
          for (int j = 0; j < 4; ++j) sp[(size_t)(ki * 16 + lc) * 128 + vi * 16 + kq * 4 + j] = accS[i][j]; } }
    __syncthreads();
}

__device__ __forceinline__ void hg_norm(const Params& P, int l, int row0, int nrows, int hd, int tid) {
    const int sub = tid & 7, rg = tid >> 3;
    const bf16_t* proj = (const bf16_t*)(P.ws + OFF_PROJ); const float* oraw = (const float*)(P.ws + OFF_TCAT); bf16_t* Ahg = (bf16_t*)(P.ws + OFF_AHG);
    const float* nwp = P.in[I_HGNW] + l * 512 + hd * 128 + 16 * sub;
    f32x4 nw[4];
#pragma unroll
    for (int i = 0; i < 4; ++i) nw[i] = *(const f32x4*)(nwp + 4 * i);
    for (int r = rg; r < ((nrows + 63) & ~63); r += 64) { const int rr = r < nrows ? r : nrows - 1; const size_t row = (size_t)(row0 + rr);
        const float* op = oraw + row * 512 + hd * 128 + 16 * sub;
        f32x4 o[4]; float ss = 0.f;
#pragma unroll
        for (int i = 0; i < 4; ++i) { o[i] = *(const f32x4*)(op + 4 * i); ss += (o[i][0] * o[i][0] + o[i][1] * o[i][1]) + (o[i][2] * o[i][2] + o[i][3] * o[i][3]); }
        const u32x4 g0 = *(const u32x4*)(proj + row * NPROJ + C_G + hd * 128 + 16 * sub), g1 = *(const u32x4*)(proj + row * NPROJ + C_G + hd * 128 + 16 * sub + 8);
        ss = sum8(ss);
        const float rstd = 1.f / sqrtf(ss * (1.f / 128.f) + EPSN);
        u32x4 w0, w1;
        w0.x = cvt_pk_bf16(o[0][0] * rstd * nw[0][0] * silu(bflo(g0.x)), o[0][1] * rstd * nw[0][1] * silu(bfhi(g0.x)));
        w0.y = cvt_pk_bf16(o[0][2] * rstd * nw[0][2] * silu(bflo(g0.y)), o[0][3] * rstd * nw[0][3] * silu(bfhi(g0.y)));
        w0.z = cvt_pk_bf16(o[1][0] * rstd * nw[1][0] * silu(bflo(g0.z)), o[1][1] * rstd * nw[1][1] * silu(bfhi(g0.z)));
        w0.w = cvt_pk_bf16(o[1][2] * rstd * nw[1][2] * silu(bflo(g0.w)), o[1][3] * rstd * nw[1][3] * silu(bfhi(g0.w)));
        w1.x = cvt_pk_bf16(o[2][0] * rstd * nw[2][0] * silu(bflo(g1.x)), o[2][1] * rstd * nw[2][1] * silu(bfhi(g1.x)));
        w1.y = cvt_pk_bf16(o[2][2] * rstd * nw[2][2] * silu(bflo(g1.y)), o[2][3] * rstd * nw[2][3] * silu(bfhi(g1.y)));
        w1.z = cvt_pk_bf16(o[3][0] * rstd * nw[3][0] * silu(bflo(g1.z)), o[3][1] * rstd * nw[3][1] * silu(bfhi(g1.z)));
        w1.w = cvt_pk_bf16(o[3][2] * rstd * nw[3][2] * silu(bflo(g1.w)), o[3][3] * rstd * nw[3][3] * silu(bfhi(g1.w)));
        if (r < nrows) { *(u32x4*)(Ahg + row * 512 + hd * 128 + 16 * sub) = w0; *(u32x4*)(Ahg + row * 512 + hd * 128 + 16 * sub + 8) = w1; }
    }
}

__device__ __forceinline__ void s5_item(const Params& P, int l, bool prompt, int bq, int g, LAS unsigned char* L, int tid) {
    const int lane = tid & 63, w = tid >> 6, n = lane, jc = lane & 15, tq = lane >> 4;
    LAS float* us = (LAS float*)(L + w * 14336); LAS bf16_t* Xc = (LAS bf16_t*)(L + w * 14336 + 1024); LAS float* BUl = (LAS float*)(L + w * 14336 + 5376); LAS float* hl = (LAS float*)(L + 8 * 14336);
    const bf16_t* proj = (const bf16_t*)(P.ws + OFF_PROJ); bf16_t* Aglu = (bf16_t*)(P.ws + OFF_AGLU);
    const int lg = l * 32 + g;
    const float delta = expf(P.in[I_S5LDT][lg]), lr = P.in[I_S5LR][lg * 64 + n], li = P.in[I_S5LI][lg * 64 + n];
    const float mag = expf(lr * delta), ab_re = mag * cosf(li * delta), ab_im = mag * sinf(li * delta);
    const float den = lr * lr + li * li, nr = ab_re - 1.f, co_re = (nr * lr + ab_im * li) / den, co_im = (ab_im * lr - nr * li) / den;
    bf16x8 Bu[8];
#pragma unroll
    for (int tile = 0; tile < 4; ++tile) { const int nn = tile * 16 + jc; const float cr = __shfl(co_re, nn), ci = __shfl(co_im, nn);
        u32x4 pr = (u32x4){0u, 0u, 0u, 0u}, pi = (u32x4){0u, 0u, 0u, 0u};
        if (tq < 2) { const f32x4* br4 = (const f32x4*)(P.in[I_S5BR] + ((size_t)lg * 64 + nn) * 16 + tq * 8); const f32x4* bi4 = (const f32x4*)(P.in[I_S5BI] + ((size_t)lg * 64 + nn) * 16 + tq * 8);
            const f32x4 a0 = br4[0], a1 = br4[1], c0 = bi4[0], c1 = bi4[1];
            pr = pack8(cr * a0[0] - ci * c0[0], cr * a0[1] - ci * c0[1], cr * a0[2] - ci * c0[2], cr * a0[3] - ci * c0[3], cr * a1[0] - ci * c1[0], cr * a1[1] - ci * c1[1], cr * a1[2] - ci * c1[2], cr * a1[3] - ci * c1[3]);
            pi = pack8(cr * c0[0] + ci * a0[0], cr * c0[1] + ci * a0[1], cr * c0[2] + ci * a0[2], cr * c0[3] + ci * a0[3], cr * c1[0] + ci * a1[0], cr * c1[1] + ci * a1[1], cr * c1[2] + ci * a1[2], cr * c1[3] + ci * a1[3]); }
        Bu[tile] = __builtin_bit_cast(bf16x8, pr); Bu[4 + tile] = __builtin_bit_cast(bf16x8, pi); }
    bf16x8 Breg[4];
    { const float* cr = P.in[I_S5CR] + ((size_t)lg * 16 + jc) * 64; const float* ci = P.in[I_S5CI] + ((size_t)lg * 16 + jc) * 64;
#pragma unroll
      for (int kt = 0; kt < 4; ++kt) { const float* src = (kt < 2 ? cr : ci) + (kt & 1) * 32 + tq * 8; const float sg = kt < 2 ? 1.f : -1.f;
          const f32x4 a = *(const f32x4*)src, c = *(const f32x4*)(src + 4);
          Breg[kt] = __builtin_bit_cast(bf16x8, pack8(sg * a[0], sg * a[1], sg * a[2], sg * a[3], sg * c[0], sg * c[1], sg * c[2], sg * c[3])); } }
    const float dj = P.in[I_S5D][l * 512 + g * 16 + jc];
    const int b = prompt ? bq : bq * 8 + w;
    const int rowseg = prompt ? b * 2048 + w * 256 : MP + b * 4;
    const int nchunk = prompt ? 16 : 1, clen = prompt ? 16 : 4;
    const int tA = jc < clen ? jc : clen - 1;
#define S5_LDA(CH) ((tq < 2) ? *(const u32x4*)(proj + (size_t)(rowseg + (CH) * 16 + tA) * NPROJ + C_U + g * 16 + tq * 8) : (u32x4){0u, 0u, 0u, 0u})
#define S5_BU(AF) do { const bf16x8 a_ = __builtin_bit_cast(bf16x8, (AF)); _Pragma("unroll") for (int tile = 0; tile < 8; ++tile) { \
        const f32x4 d_ = __builtin_amdgcn_mfma_f32_16x16x32_bf16(a_, Bu[tile], (f32x4){0.f, 0.f, 0.f, 0.f}, 0, 0, 0); \
        _Pragma("unroll") for (int j = 0; j < 4; ++j) BUl[(tq * 4 + j) * 132 + tile * 16 + jc] = d_[j]; } } while (0)
    float xr = 0.f, xi = 0.f;
    if (prompt) {
        u32x4 af = S5_LDA(0);
        for (int ch = 0; ch < nchunk; ++ch) {
            S5_BU(af);
            __syncthreads();
            if (ch + 1 < nchunk) af = S5_LDA(ch + 1);
            for (int tt = 0; tt < 16; ++tt) { const float bur = BUl[tt * 132 + n], bui = BUl[tt * 132 + 64 + n];
                const float nxr = ab_re * xr - ab_im * xi + bur, nxi = ab_re * xi + ab_im * xr + bui; xr = nxr; xi = nxi; }
            __syncthreads();
        }
        hl[(w * 64 + n) * 2] = xr; hl[(w * 64 + n) * 2 + 1] = xi;
        float pr_ = ab_re, pi_ = ab_im;
#pragma unroll
        for (int q = 0; q < 8; ++q) { const float a = pr_ * pr_ - pi_ * pi_, c = 2.f * pr_ * pi_; pr_ = a; pi_ = c; }
        __syncthreads();
        xr = 0.f; xi = 0.f;
        for (int ww = 0; ww < w; ++ww) { const float hr = hl[(ww * 64 + n) * 2], hi = hl[(ww * 64 + n) * 2 + 1]; const float a = pr_ * xr - pi_ * xi + hr, c = pr_ * xi + pi_ * xr + hi; xr = a; xi = c; }
    } else { xr = P.in[I_S5R][((size_t)(l * 128 + b) * 32 + g) * 64 + n]; xi = P.in[I_S5I][((size_t)(l * 128 + b) * 32 + g) * 64 + n]; }
    u32x2 uu2; { const int t = (lane >> 2) < clen ? (lane >> 2) : clen - 1; uu2 = *(const u32x2*)(proj + (size_t)(rowseg + t) * NPROJ + C_U + g * 16 + (lane & 3) * 4); }
    u32x4 af2 = S5_LDA(0);
    for (int ch = 0; ch < nchunk; ++ch) {
        { const int t = lane >> 2, q4 = lane & 3;
          *(LAS f32x4*)(us + t * 16 + q4 * 4) = (f32x4){bflo(uu2.x), bfhi(uu2.x), bflo(uu2.y), bfhi(uu2.y)}; }
        S5_BU(af2);
        __syncthreads();
        if (ch + 1 < nchunk) { uu2 = *(const u32x2*)(proj + (size_t)(rowseg + (ch + 1) * 16 + (lane >> 2)) * NPROJ + C_U + g * 16 + (lane & 3) * 4); af2 = S5_LDA(ch + 1); }
        for (int tt = 0; tt < clen; ++tt) { const float bur = BUl[tt * 132 + n], bui = BUl[tt * 132 + 64 + n];
            const float nxr = ab_re * xr - ab_im * xi + bur, nxi = ab_re * xi + ab_im * xr + bui; xr = nxr; xi = nxi;
            Xc[tt * 136 + n] = f2bf(xr); Xc[tt * 136 + 64 + n] = f2bf(xi); }
        __syncthreads();
        f32x4 acc = (f32x4){0.f, 0.f, 0.f, 0.f};
#pragma unroll
        for (int kt = 0; kt < 4; ++kt) { const bf16x8 a = *(const LAS bf16x8*)(Xc + jc * 136 + kt * 32 + tq * 8); acc = __builtin_amdgcn_mfma_f32_16x16x32_bf16(a, Breg[kt], acc, 0, 0, 0); }
#pragma unroll
        for (int j = 0; j < 4; ++j) { const int t = tq * 4 + j;
            if (t < clen) { const float y = acc[j] + dj * us[t * 16 + jc]; Aglu[(size_t)(rowseg + ch * 16 + t) * 512 + g * 16 + jc] = f2bf(gelu_tanh(y)); } }
        __syncthreads();
    }
#undef S5_LDA
#undef S5_BU
    if (prompt) { if (w == 7) { P.out[O_PS5R + ((size_t)(l * 8 + b) * 32 + g) * 64 + n] = xr; P.out[O_PS5I + ((size_t)(l * 8 + b) * 32 + g) * 64 + n] = xi; } }
    else { P.out[O_SS5R + ((size_t)(l * 128 + b) * 32 + g) * 64 + n] = xr; P.out[O_SS5I + ((size_t)(l * 128 + b) * 32 + g) * 64 + n] = xi; }
}

__device__ __forceinline__ void convstate_item(const Params& P, int l, int sq, int tid) {
    const bf16_t* proj = (const bf16_t*)(P.ws + OFF_PROJ);
    const bool pr = sq < 8; const int b = pr ? sq : sq - 8;
    const int rbase = pr ? b * 2048 + 2045 : MP + b * 4 + 1;
    float* dst = P.out + (pr ? O_PSSDC + (size_t)(l * 8 + b) * 3 * 2048 : O_SSSDC + (size_t)(l * 128 + b) * 3 * 2048);
    for (int e = tid; e < 768; e += NTH) { const int j = e >> 8, oc = e & 255;
        const u32x4 v = *(const u32x4*)(proj + (size_t)(rbase + j) * NPROJ + C_XBC + oc * 8);
        *(f32x4*)(dst + j * 2048 + oc * 8) = (f32x4){bflo(v.x), bfhi(v.x), bflo(v.y), bfhi(v.y)};
        *(f32x4*)(dst + j * 2048 + oc * 8 + 4) = (f32x4){bflo(v.z), bfhi(v.z), bflo(v.w), bfhi(v.w)}; }
}

constexpr int IT_SSDP = 128, IT_HGP = 64, IT_S5P = 256, IT_SSDS = 512, IT_HGS = 512, IT_S5S = 512, IT_CS = 136, IT_HGN = 128;
constexpr int IT_TOTAL = IT_SSDP + IT_HGP + IT_S5P + IT_SSDS + IT_HGS + IT_S5S + IT_CS + IT_HGN;
__device__ __forceinline__ void mix_phase(const Params& P, int l, LAS unsigned char* L, int tid_in, int rep = 0, int lo = 0, int hi = 1 << 30) {
    int tid = tid_in;
    unsigned* ctl = (unsigned*)(P.ws + OFF_CTL);
    volatile LAS int* misc = (volatile LAS int*)(L + MISC_OFF);
    for (;;) {
        if (tid == 0) misc[0] = (int)atomicAdd(ctl + l + 2 * rep, 1u);
        __syncthreads();
        int it = misc[0] + lo;
        __syncthreads();
        if (it >= IT_TOTAL || it >= hi) break;
        asm volatile("" : "+v"(tid));
        if (it < IT_SSDP) { ssd_mfma_item(P, l, it >> 4, it & 15, L, tid); continue; } it -= IT_SSDP;
        if (it < IT_HGP) { const int b = it >> 3, hd = (it >> 1) & 3, vh = it & 1;
            hg_mfma_half(P, l, b, hd, vh, L, tid);
            asm volatile("s_waitcnt vmcnt(0)" ::: "memory"); __syncthreads();
            if (tid == 0) { __builtin_amdgcn_fence(__ATOMIC_RELEASE, "agent"); asm volatile("s_waitcnt vmcnt(0)" ::: "memory"); (void)atomicAdd(ctl + 16 + rep * 64 + l * 32 + b * 4 + hd, 1u); }
            continue; } it -= IT_HGP;
        if (it < IT_S5P) { s5_item(P, l, true, it >> 5, it & 31, L, tid); continue; } it -= IT_S5P;
        if (it < IT_SSDS) { ssd_s4_item(P, l, it >> 2, it & 3, L, tid); continue; } it -= IT_SSDS;
        if (it < IT_HGS) { const int b = it >> 2, hd = it & 3;
            hg_half(P, l, false, b, hd, 0, L, tid); hg_half(P, l, false, b, hd, 1, L, tid);
            asm volatile("s_waitcnt vmcnt(0)" ::: "memory"); __syncthreads();
            hg_norm(P, l, MP + b * 4, 4, hd, tid);
            continue; } it -= IT_HGS;
        if (it < IT_S5S) { s5_item(P, l, false, it >> 5, it & 31, L, tid); continue; } it -= IT_S5S;
        if (it < IT_CS) { convstate_item(P, l, it, tid); continue; } it -= IT_CS;
        { const int bh = it >> 2, rq = it & 3;
          if (tid == 0) { unsigned* c = ctl + 16 + rep * 64 + l * 32 + bh; unsigned sp = 0;
              while (__hip_atomic_load(c, __ATOMIC_RELAXED, __HIP_MEMORY_SCOPE_AGENT) < 2u && ++sp < (1u << 24)) __builtin_amdgcn_s_sleep(8); }
          __syncthreads();
          __builtin_amdgcn_fence(__ATOMIC_ACQUIRE, "agent"); asm volatile("s_waitcnt vmcnt(0)" ::: "memory");
          hg_norm(P, l, (bh >> 2) * 2048 + rq * 512, 512, bh & 3, tid); }
    }
}

__device__ __forceinline__ void small_res_gemm(const bf16_t* A, const bf16_t* Bt, int K, const Params& P, int from_in, int tid, int bid) {
    const int lane = tid & 63, w = tid >> 6, kq = lane >> 4, lc = lane & 15;
    for (int t = bid; t < 256; t += gridDim.x) {
        const int rt = t >> 4, ct = t & 15, r0 = MP + rt * 32 + (w >> 2) * 16, c0 = ct * 64 + (w & 3) * 16;
        const bf16_t* ap = A + (size_t)(r0 + lc) * K + kq * 8; const bf16_t* bp = Bt + (size_t)(c0 + lc) * K + kq * 8;
        f32x4 acc = (f32x4){0.f, 0.f, 0.f, 0.f};
        { bf16x8 a0[8], b0[8], a1[8], b1[8]; const int nb = K >> 8;
#define SG_LD(AX, BX, I) do { _Pragma("unroll") for (int i_ = 0; i_ < 8; ++i_) { AX[i_] = *(const bf16x8*)(ap + (I) * 256 + i_ * 32); BX[i_] = *(const bf16x8*)(bp + (I) * 256 + i_ * 32); } } while (0)
#define SG_MM(AX, BX) do { _Pragma("unroll") for (int i_ = 0; i_ < 8; ++i_) acc = __builtin_amdgcn_mfma_f32_16x16x32_bf16(AX[i_], BX[i_], acc, 0, 0, 0); } while (0)
          SG_LD(a0, b0, 0);
          for (int i = 0; i < nb; i += 2) {
              if (i + 1 < nb) SG_LD(a1, b1, i + 1);
              SG_MM(a0, b0);
              if (i + 2 < nb) SG_LD(a0, b0, i + 2);
              if (i + 1 < nb) SG_MM(a1, b1);
          }
#undef SG_LD
#undef SG_MM
        }
#pragma unroll
        for (int j = 0; j < 4; ++j) { const int r = r0 + kq * 4 + j, c = c0 + lc;
            const float base = from_in ? P.in[I_XS][(size_t)(r - MP) * DM + c] : P.out[(size_t)r * DM + c];
            P.out[(size_t)r * DM + c] = base + acc[j]; }
    }
}

template <int MODE>
__device__ __forceinline__ void small_sg_gemm(const bf16_t* A, const bf16_t* Bt, int K, const Params& P, int tid, int bid) {
    const int lane = tid & 63, w = tid >> 6, kq = lane >> 4, lc = lane & 15;
    for (int t = bid; t < 256; t += gridDim.x) {
        const int rt = t >> 4, ct = t & 15, r0 = MP + rt * 32 + (w >> 2) * 16, c0 = ct * 64 + (w & 3) * 16;
        const bf16_t* ap = A + (size_t)(r0 + lc) * K + kq * 8; const bf16_t* bp = Bt + (size_t)(c0 + lc) * K + kq * 8;
        f32x4 acc = (f32x4){0.f, 0.f, 0.f, 0.f};
        { bf16x8 a0[8], b0[8], a1[8], b1[8]; const int nb = K >> 8;
#define SG_LD(AX, BX, I) do { _Pragma("unroll") for (int i_ = 0; i_ < 8; ++i_) { AX[i_] = *(const bf16x8*)(ap + (I) * 256 + i_ * 32); BX[i_] = *(const bf16x8*)(bp + (I) * 256 + i_ * 32); } } while (0)
#define SG_MM(AX, BX) do { _Pragma("unroll") for (int i_ = 0; i_ < 8; ++i_) acc = __builtin_amdgcn_mfma_f32_16x16x32_bf16(AX[i_], BX[i_], acc, 0, 0, 0); } while (0)
          SG_LD(a0, b0, 0);
          for (int i = 0; i < nb; i += 2) {
              if (i + 1 < nb) SG_LD(a1, b1, i + 1);
              SG_MM(a0, b0);
              if (i + 2 < nb) SG_LD(a0, b0, i + 2);
              if (i + 1 < nb) SG_MM(a1, b1);
          }
#undef SG_LD
#undef SG_MM
        }
#pragma unroll
        for (int j = 0; j < 4; ++j) { const int r = r0 + kq * 4 + j, c = c0 + lc;
            const bf16_t* proj = (const bf16_t*)(P.ws + OFF_PROJ); bf16_t* mp = (bf16_t*)(P.ws + OFF_TCAT) + (size_t)r * 1024 + c;
            float val = sigm(bf2f(proj[(size_t)r * NPROJ + C_GATE + MODE * 1024 + c])) * acc[j];
            if (MODE == 1) { const f32x4* sp = (const f32x4*)((const float*)(P.ws + OFF_SSQ) + (size_t)r * 16); const f32x4 s0 = sp[0], s1 = sp[1], s2 = sp[2], s3 = sp[3];
                const float tot = ((s0[0] + s0[1]) + (s0[2] + s0[3])) + ((s1[0] + s1[1]) + (s1[2] + s1[3])) + ((s2[0] + s2[1]) + (s2[2] + s2[3])) + ((s3[0] + s3[1]) + (s3[2] + s3[3]));
                val *= 1.f / sqrtf(tot * (1.f / 1024.f) + EPSN); *mp = f2bf(val); }
            else *mp = f2bf(bf2f(*mp) + val); }
    }
}

__device__ __forceinline__ void small_g1_tail(const bf16_t* A, const bf16_t* Bt, bf16_t* proj, int tid, int bid) {
    const int lane = tid & 63, w = tid >> 6, kq = lane >> 4, lc = lane & 15;
    const bf16_t* bp = Bt + (size_t)(8704 + lc) * 1024 + kq * 8;
    for (int t = bid * 8 + w; t < MT / 16; t += gridDim.x * 8) {
        const bf16_t* ap = A + (size_t)(t * 16 + lc) * 1024 + kq * 8;
        f32x4 acc = (f32x4){0.f, 0.f, 0.f, 0.f};
        bf16x8 a0[8], b0[8], a1[8], b1[8];
#define SG_LD(AX, BX, I) do { _Pragma("unroll") for (int i_ = 0; i_ < 8; ++i_) { AX[i_] = *(const bf16x8*)(ap + (I) * 256 + i_ * 32); BX[i_] = *(const bf16x8*)(bp + (I) * 256 + i_ * 32); } } while (0)
#define SG_MM(AX, BX) do { _Pragma("unroll") for (int i_ = 0; i_ < 8; ++i_) acc = __builtin_amdgcn_mfma_f32_16x16x32_bf16(AX[i_], BX[i_], acc, 0, 0, 0); } while (0)
        SG_LD(a0, b0, 0); SG_LD(a1, b1, 1); SG_MM(a0, b0); SG_LD(a0, b0, 2); SG_MM(a1, b1); SG_LD(a1, b1, 3); SG_MM(a0, b0); SG_MM(a1, b1);
#undef SG_LD
#undef SG_MM
#pragma unroll
        for (int j = 0; j < 4; ++j) proj[(size_t)(t * 16 + kq * 4 + j) * NPROJ + 8704 + lc] = f2bf(acc[j]);
    }
}

template <int MODE>
__device__ __forceinline__ void small_gemm_ks(const bf16_t* A, const bf16_t* Bt, const int K, const Params& P, int from_in, LAS unsigned char* L, int tid, int bid) {
    const int lane = tid & 63, w = tid >> 6, kq = lane >> 4, lc = lane & 15;
    LAS float* red = (LAS float*)L;
    const int ks = K >> 3, nst = ks >> 5;
    for (int t = bid; t < 256; t += gridDim.x) {
        const int rbase = MP + (t >> 4) * 32, cbase = (t & 15) * 64;
        const bf16_t* ap = A + (size_t)(rbase + lc) * K + w * ks + kq * 8; const bf16_t* bp = Bt + (size_t)(cbase + lc) * K + w * ks + kq * 8;
        f32x4 acc[2][4];
#pragma unroll
        for (int i = 0; i < 2; ++i)
#pragma unroll
            for (int j = 0; j < 4; ++j) acc[i][j] = (f32x4){0.f, 0.f, 0.f, 0.f};
        for (int s0 = 0; s0 < nst; s0 += 6) {
            bf16x8 a[6][2], b[6][4];
#pragma unroll
            for (int i = 0; i < 6; ++i) if (s0 + i < nst) {
#pragma unroll
                for (int r = 0; r < 2; ++r) a[i][r] = *(const bf16x8*)(ap + (size_t)r * 16 * K + (s0 + i) * 32);
#pragma unroll
                for (int c = 0; c < 4; ++c) b[i][c] = *(const bf16x8*)(bp + (size_t)c * 16 * K + (s0 + i) * 32); }
#pragma unroll
            for (int i = 0; i < 6; ++i) if (s0 + i < nst) {
#pragma unroll
                for (int r = 0; r < 2; ++r)
#pragma unroll
                    for (int c = 0; c < 4; ++c) acc[r][c] = __builtin_amdgcn_mfma_f32_16x16x32_bf16(a[i][r], b[i][c], acc[r][c], 0, 0, 0); }
        }
#pragma unroll
        for (int r = 0; r < 2; ++r)
#pragma unroll
            for (int c = 0; c < 4; ++c) *(LAS f32x4*)(red + ((w * 8 + r * 4 + c) * 64 + lane) * 4) = acc[r][c];
        __syncthreads();
        f32x4 sum = (f32x4){0.f, 0.f, 0.f, 0.f};
#pragma unroll
        for (int ww = 0; ww < 8; ++ww) sum += *(const LAS f32x4*)(red + ((ww * 8 + w) * 64 + lane) * 4);
        const int r0 = rbase + (w >> 2) * 16, c0 = cbase + (w & 3) * 16;
#pragma unroll
        for (int j = 0; j < 4; ++j) { const int r = r0 + kq * 4 + j, c = c0 + lc;
            if (MODE == 0) { const float base = from_in ? P.in[I_XS][(size_t)(r - MP) * DM + c] : P.out[(size_t)r * DM + c]; P.out[(size_t)r * DM + c] = base + sum[j]; }
            else { const bf16_t* proj = (const bf16_t*)(P.ws + OFF_PROJ); bf16_t* mp = (bf16_t*)(P.ws + OFF_TCAT) + (size_t)r * 1024 + c;
                float val = sigm(bf2f(proj[(size_t)r * NPROJ + C_GATE + MODE * 1024 + c])) * sum[j];
                if (MODE == 1) { const f32x4* sp = (const f32x4*)((const float*)(P.ws + OFF_SSQ) + (size_t)r * 16); const f32x4 s0 = sp[0], s1 = sp[1], s2 = sp[2], s3 = sp[3];
                    const float tot = ((s0[0] + s0[1]) + (s0[2] + s0[3])) + ((s1[0] + s1[1]) + (s1[2] + s1[3])) + ((s2[0] + s2[1]) + (s2[2] + s2[3])) + ((s3[0] + s3[1]) + (s3[2] + s3[3]));
                    val *= 1.f / sqrtf(tot * (1.f / 1024.f) + EPSN); *mp = f2bf(val); }
                else *mp = f2bf(bf2f(*mp) + val); } }
        __syncthreads();
    }
}

__device__ __forceinline__ void small_glu_ks(const bf16_t* A, const bf16_t* Bt, const Params& P, LAS unsigned char* L, int tid, int bid) {
    constexpr int K = 512, ks = K >> 3;
    const int lane = tid & 63, w = tid >> 6, kq = lane >> 4, lc = lane & 15;
    LAS float* red = (LAS float*)L;
    for (int t = bid; t < 256; t += gridDim.x) {
        const int rbase = MP + (t >> 4) * 32, cbase = (t & 15) * 64, prow = 256 * (cbase >> 7) + (cbase & 127);
        const bf16_t* ap = A + (size_t)(rbase + lc) * K + w * ks + kq * 8; const bf16_t* bp = Bt + (size_t)(prow + lc) * K + w * ks + kq * 8;
        bf16x8 a[2][2], b[2][8];
#pragma unroll
        for (int i = 0; i < 2; ++i) {
#pragma unroll
            for (int r = 0; r < 2; ++r) a[i][r] = *(const bf16x8*)(ap + (size_t)r * 16 * K + i * 32);
#pragma unroll
            for (int c = 0; c < 8; ++c) b[i][c] = *(const bf16x8*)(bp + (size_t)((c >> 2) * 128 + (c & 3) * 16) * K + i * 32); }
        f32x4 acc[2][8];
#pragma unroll
        for (int r = 0; r < 2; ++r)
#pragma unroll
            for (int c = 0; c < 8; ++c) { acc[r][c] = __builtin_amdgcn_mfma_f32_16x16x32_bf16(a[0][r], b[0][c], (f32x4){0.f, 0.f, 0.f, 0.f}, 0, 0, 0); acc[r][c] = __builtin_amdgcn_mfma_f32_16x16x32_bf16(a[1][r], b[1][c], acc[r][c], 0, 0, 0); }
#pragma unroll
        for (int r = 0; r < 2; ++r)
#pragma unroll
            for (int c = 0; c < 8; ++c) *(LAS f32x4*)(red + ((w * 16 + (c >> 2) * 8 + r * 4 + (c & 3)) * 64 + lane) * 4) = acc[r][c];
        __syncthreads();
        f32x4 sa = (f32x4){0.f, 0.f, 0.f, 0.f}, sg = (f32x4){0.f, 0.f, 0.f, 0.f};
#pragma unroll
        for (int ww = 0; ww < 8; ++ww) { sa += *(const LAS f32x4*)(red + ((ww * 16 + w) * 64 + lane) * 4); sg += *(const LAS f32x4*)(red + ((ww * 16 + 8 + w) * 64 + lane) * 4); }
        const int r0 = rbase + (w >> 2) * 16, c0 = cbase + (w & 3) * 16;
        const bf16_t* proj = (const bf16_t*)(P.ws + OFF_PROJ);
#pragma unroll
        for (int j = 0; j < 4; ++j) { const int r = r0 + kq * 4 + j, c = c0 + lc;
            bf16_t* mp = (bf16_t*)(P.ws + OFF_TCAT) + (size_t)r * 1024 + c;
            const float val = sigm(bf2f(proj[(size_t)r * NPROJ + C_GATE + c])) * sa[j] * sigm(sg[j]);
            *mp = f2bf(bf2f(*mp) + val); }
        __syncthreads();
    }
}

#define XB_TMO      128
#define XB_XCNT(j)  (256  + 64 * (j))
#define XB_XSUB(j)  (1280 + 64 * (j))
#define XB_XGEN(j)  (2304 + 64 * (j))
#define XB_TOP      3328
#define XB_TOPGEN   3392
#define XCD_BAR_WORDS 3456
#define XB_SPIN_CAP (1u << 18)
__device__ __forceinline__ unsigned xb_ld(unsigned* p)              { return __hip_atomic_load(p, __ATOMIC_RELAXED, __HIP_MEMORY_SCOPE_AGENT); }
__device__ __forceinline__ unsigned xb_add(unsigned* p, unsigned v) { return __hip_atomic_fetch_add(p, v, __ATOMIC_RELAXED, __HIP_MEMORY_SCOPE_AGENT); }
__device__ __forceinline__ unsigned xb_xcc_id() { return (unsigned)__builtin_amdgcn_s_getreg((3 << 11) | 20) & 0xFu; }
#define XB_SPIN(cond, bar) do { unsigned _sp = 0; while (cond) { __builtin_amdgcn_s_sleep(1); \
    if ((++_sp & 255u) == 0u) { if (xb_ld(&(bar)[XB_TMO])) break; if (_sp > XB_SPIN_CAP) { atomicAdd(&(bar)[XB_TMO], 1u); break; } } } } while (0)
__device__ __forceinline__ void xcd_barrier_post(unsigned* bar, int tid) { if (tid == 0) (void)xb_add(&bar[XB_XCNT(xb_xcc_id())], 1u); }
__device__ __forceinline__ void xcd_barrier_complete(unsigned* bar, unsigned x, unsigned& nloc, unsigned& nx) {
    const unsigned G = gridDim.x;
    unsigned sum, cnt, mine, sp = 0u;
    for (;;) {
        sum = 0u; cnt = 0u; mine = 0u;
#pragma unroll
        for (unsigned j = 0; j < 16; ++j) { const unsigned c = xb_ld(&bar[XB_XCNT(j)]); sum += c; cnt += (c > 0u) ? 1u : 0u; mine = (j == x) ? c : mine; }
        if (sum == G) break;
        __builtin_amdgcn_s_sleep(1);
        if ((++sp & 255u) == 0u) { if (xb_ld(&bar[XB_TMO])) break; if (sp > XB_SPIN_CAP) { atomicAdd(&bar[XB_TMO], 1u); break; } }
    }
    nloc = mine > 0u ? mine : 1u; nx = cnt > 0u ? cnt : 1u;
}
__device__ __forceinline__ void xcd_barrier(unsigned* bar, volatile LAS unsigned* st, int tid) {
    asm volatile("s_waitcnt vmcnt(0)" ::: "memory");
    __syncthreads();
    if (tid == 0) {
        const unsigned x = xb_xcc_id();
        __builtin_amdgcn_s_waitcnt(0);
        unsigned nloc = st[0], nx = st[1];
        if (nloc == 0u) { xcd_barrier_complete(bar, x, nloc, nx); st[0] = nloc; st[1] = nx; }
        const unsigned old = xb_add(&bar[XB_XSUB(x)], 1u);
        const unsigned gen = old / nloc;
        if (old + 1u == (gen + 1u) * nloc) {
            __builtin_amdgcn_fence(__ATOMIC_RELEASE, "agent");
            asm volatile("s_waitcnt vmcnt(0)" ::: "memory");
            const unsigned og = xb_add(&bar[XB_TOP], 1u);
            const unsigned tg = og / nx;
            if (og + 1u == (tg + 1u) * nx) xb_add(&bar[XB_TOPGEN], 1u);
            else XB_SPIN(xb_ld(&bar[XB_TOPGEN]) == tg, bar);
            __builtin_amdgcn_fence(__ATOMIC_ACQUIRE, "agent");
            xb_add(&bar[XB_XGEN(x)], 1u);
            asm volatile("s_waitcnt vmcnt(0)" ::: "memory");
        } else {
            XB_SPIN(xb_ld(&bar[XB_XGEN(x)]) == gen, bar);
            __builtin_amdgcn_fence(__ATOMIC_ACQUIRE, "agent");
            asm volatile("s_waitcnt vmcnt(0)" ::: "memory");
        }
    }
    __syncthreads();
}

__global__ void __launch_bounds__(NTH, 2) mega(Params P) {
    extern __shared__ __attribute__((aligned(16))) unsigned char lds_raw[];
    LAS unsigned char* L = (LAS unsigned char*)lds_raw;
    cg::grid_group grid = cg::this_grid();
    const int G = gridDim.x;
    const int wave_s = __builtin_amdgcn_readfirstlane((int)threadIdx.x >> 6);
#define TIDL() ({ int ln_; asm volatile("v_mbcnt_lo_u32_b32 %0, -1, 0\n\tv_mbcnt_hi_u32_b32 %0, -1, %0" : "=v"(ln_)); int t_ = wave_s * 64 + ln_; t_; })
#define BIDL() ({ int b_ = blockIdx.x; asm volatile("" : "+s"(b_)); b_; })
    const int tid0 = TIDL();
    unsigned char* ws = P.ws;
    unsigned* barw = (unsigned*)(ws + OFF_BAR);
    volatile LAS unsigned* xst = (volatile LAS unsigned*)(L + MISC_OFF + 16);
    if (tid0 == 0) { xst[0] = 0u; xst[1] = 0u; }
    __syncthreads();
    xcd_barrier_post(barw, tid0);
    if (ws == nullptr) grid.sync();
#define GSYNC() xcd_barrier(barw, xst, TIDL())
#ifndef DUP
#define DUP 0
#endif
#pragma unroll 1
    for (int l = 0; l < 2; ++l) {
        convert_weights(P, l, L, TIDL());
        if (DUP & 4) convert_weights(P, l, L, TIDL());
        norm_rows_bf16(P, l == 0, P.in[I_N1W] + l * 1024, (bf16_t*)(ws + OFF_XN), TIDL());
        GSYNC();
        small_g1_tail((const bf16_t*)(ws + OFF_XN), (const bf16_t*)(ws + W_IN), (bf16_t*)(ws + OFF_PROJ), TIDL(), BIDL());
        { Gemm g{(const bf16_t*)(ws + OFF_XN), (const bf16_t*)(ws + W_IN), MT, 8704, 1024}; StaticOrder S; S.init(MT, 8704, G, BIDL());
          EpiStoreBf16 E{(bf16_t*)(ws + OFF_PROJ), NPROJ}; gemm_phase(L, g, S, E, TIDL()); if (DUP & 2) gemm_phase(L, g, S, E, TIDL()); }
        GSYNC();
        mix_phase(P, l, L, TIDL());
        GSYNC();
        if (DUP & 1) { mix_phase(P, l, L, TIDL(), 1); GSYNC(); }
        if (DUP & 64) { mix_phase(P, l, L, TIDL(), 1, IT_SSDP + IT_HGP, IT_SSDP + IT_HGP + IT_S5P); GSYNC(); }
        if (DUP & 1024) { mix_phase(P, l, L, TIDL(), 1, 0, IT_SSDP); GSYNC(); }
        if (DUP & 2048) { mix_phase(P, l, L, TIDL(), 1, IT_SSDP, IT_SSDP + IT_HGP); GSYNC(); }
        if (DUP & 128) { mix_phase(P, l, L, TIDL(), 1, IT_SSDP + IT_HGP + IT_S5P, IT_TOTAL); GSYNC(); }
        small_gemm_ks<1>((const bf16_t*)(ws + OFF_XN), (const bf16_t*)(ws + W_SSD), 1024, P, 0, L, TIDL(), BIDL());
        { Gemm g{(const bf16_t*)(ws + OFF_XN), (const bf16_t*)(ws + W_SSD), MP, 1024, 1024}; StaticOrder S; S.init(MP, 1024, G, BIDL());
          EpiSG<true, false> E{(const bf16_t*)(ws + OFF_PROJ), (bf16_t*)(ws + OFF_TCAT), (const float*)(ws + OFF_SSQ), 1}; gemm_phase(L, g, S, E, TIDL()); }
        GSYNC();
        small_glu_ks((const bf16_t*)(ws + OFF_AGLU), (const bf16_t*)(ws + W_GLU), P, L, TIDL(), BIDL());
        { Gemm g{(const bf16_t*)(ws + OFF_AGLU), (const bf16_t*)(ws + W_GLU), MP, 2048, 512}; StaticOrder S; S.init(MP, 2048, G, BIDL());
          EpiGlu E{(const bf16_t*)(ws + OFF_PROJ), (bf16_t*)(ws + OFF_TCAT)}; gemm_phase(L, g, S, E, TIDL()); }
        GSYNC();
        small_gemm_ks<2>((const bf16_t*)(ws + OFF_AHG), (const bf16_t*)(ws + W_HG), 512, P, 0, L, TIDL(), BIDL());
        { Gemm g{(const bf16_t*)(ws + OFF_AHG), (const bf16_t*)(ws + W_HG), MP, 1024, 512}; StaticOrder S; S.init(MP, 1024, G, BIDL());
          EpiSG<false, true> E{(const bf16_t*)(ws + OFF_PROJ), (bf16_t*)(ws + OFF_TCAT), nullptr, 2}; gemm_phase(L, g, S, E, TIDL()); }
        GSYNC();
        small_gemm_ks<0>((const bf16_t*)(ws + OFF_TCAT), (const bf16_t*)(ws + W_O3), 1024, P, l == 0, L, TIDL(), BIDL());
        { Gemm g{(const bf16_t*)(ws + OFF_TCAT), (const bf16_t*)(ws + W_O3), MP, 1024, 1024}; StaticOrder S; S.init(MP, 1024, G, BIDL());
          EpiRes E{P.in[I_XP], P.in[I_XS], P.out, l == 0}; gemm_phase(L, g, S, E, TIDL()); }
        GSYNC();
        norm_rows_bf16(P, 0, P.in[I_N2W] + l * 1024, (bf16_t*)(ws + OFF_XN), TIDL());
        GSYNC();
        { Gemm g{(const bf16_t*)(ws + OFF_XN), (const bf16_t*)(ws + W_UP), MT, NUP, 1024}; StaticOrder S; S.init(MT, NUP, G, BIDL());
          EpiStoreBf16 E{(bf16_t*)(ws + OFF_PROJ), NUP}; gemm_phase(L, g, S, E, TIDL()); if (DUP & 8) gemm_phase(L, g, S, E, TIDL()); }
        GSYNC();
        ffn_conv_phase(P, l, TIDL());
        if (DUP & 32) ffn_conv_phase(P, l, TIDL());
        if (DUP & 512) { for (int q_ = 0; q_ < 10; ++q_) GSYNC(); }
        if (DUP & 256) norm_rows_bf16(P, 0, P.in[I_N2W] + l * 1024, (bf16_t*)(ws + OFF_AGLU), TIDL());
        GSYNC();
        small_gemm_ks<0>((const bf16_t*)(ws + OFF_TCAT), (const bf16_t*)(ws + W_DN), DFF, P, 0, L, TIDL(), BIDL());
        { Gemm g{(const bf16_t*)(ws + OFF_TCAT), (const bf16_t*)(ws + W_DN), MP, 1024, DFF}; StaticOrder S; S.init(MP, 1024, G, BIDL());
          EpiRes E{P.in[I_XP], P.in[I_XS], P.out, 0}; gemm_phase(L, g, S, E, TIDL()); }
        GSYNC();
    }
    final_norm(P, TIDL());
}

extern "C" void kernel_launch(void* const* d_in, const int* in_sizes, int n_in, void* d_out, int out_size, void* d_ws, size_t ws_size, hipStream_t stream) {
    static int grid_blocks = 0;
    if (grid_blocks == 0) {
        if (n_in != 36 || ws_size < WS_END) { fprintf(stderr, "kernel_launch: unexpected n_in %d / ws_size %zu\n", n_in, ws_size); grid_blocks = -1; return; }
        int dev = 0, cus = 0, per_cu = 0;
        hipGetDevice(&dev);
        hipDeviceGetAttribute(&cus, hipDeviceAttributeMultiprocessorCount, dev);
        hipFuncSetAttribute((const void*)mega, hipFuncAttributeMaxDynamicSharedMemorySize, LDS_BYTES);
        hipOccupancyMaxActiveBlocksPerMultiprocessor(&per_cu, (const void*)mega, NTH, LDS_BYTES);
        if (per_cu < 1) per_cu = 1;
        grid_blocks = cus * 1;
        (void)hipGetLastError();
    }
    if (grid_blocks < 0) return;
    Params p{};
    for (int i = 0; i < 36; ++i) p.in[i] = (const float*)d_in[i];
    p.out = (float*)d_out; p.ws = (unsigned char*)d_ws;
    void* args[] = {&p};
    (void)hipMemsetAsync((unsigned char*)d_ws + OFF_CTL, 0, WS_END - OFF_CTL, stream);
    hipError_t e = hipLaunchCooperativeKernel((const void*)mega, dim3(grid_blocks), dim3(NTH), args, LDS_BYTES, stream);
    if (e != hipSuccess) fprintf(stderr, "cooperative launch failed: %s (grid %d)\n", hipGetErrorString(e), grid_blocks);
}
```

```cpp
#include <hip/hip_runtime.h>
#include <hip/hip_cooperative_groups.h>
#include <cstdio>
namespace cg = cooperative_groups;

#define LAS __attribute__((address_space(3)))
typedef float f32x2 __attribute__((ext_vector_type(2)));
typedef unsigned u32x2 __attribute__((ext_vector_type(2)));

constexpr int MP = 16384, MS = 512, MT = MP + MS;
constexpr int DM = 1024, NPROJ = 8960, NPROJ_REAL = 8720, DFF = 2816, NUP = 5632;
constexpr int C_U = 0, C_Z = 512, C_XBC = 1536, C_DT = 3584, C_Q = 3600, C_F = 4112, C_I = 4624, C_G = 5136, C_GATE = 5648;
constexpr float EPSN = 1e-6f;
constexpr size_t W_IN = 0, W_GLU = 18350080, W_SSD = 20447232, W_HG = 22544384, W_O3 = 23592960, W_UP = 29884416, W_DN = 41418752;
constexpr size_t OFF_XN = 47185920, OFF_PROJ = 81788928, OFF_AGLU = 384565248, OFF_AHG = 401866752, OFF_SSQ = 419168256, OFF_TCAT = 420249600, OFF_CTL = 524058624, OFF_BAR = 524062720, WS_END = 524079104;
constexpr size_t O_PS5R = 17301504, O_PS5I = 17334272, O_PSSD = 17367040, O_PSSDC = 19464192, O_PHG = 19562496, O_PFFC = 20611072;
constexpr size_t O_SS5R = 20701184, O_SS5I = 21225472, O_SSSD = 21749760, O_SSSDC = 55304192, O_SHG = 56877056, O_SFFC = 73654272;
constexpr int MISC_OFF = 151552, LDS_BYTES = MISC_OFF + 256;

struct Params {
    const float* in[36];
    float* out;
    unsigned char* ws;
};
enum { I_XP = 0, I_XS, I_S5R, I_S5I, I_SSD, I_SSDC, I_HG, I_FFC, I_N1W, I_WIN, I_S5LDT, I_S5LR, I_S5LI, I_S5BR, I_S5BI, I_S5CR, I_S5CI, I_S5D, I_S5GLU,
       I_CONVW, I_CONVB, I_DTB, I_ALOG, I_SSDD, I_SSDNW, I_SSDWO, I_LB, I_HGNW, I_HGWO, I_WO, I_N2W, I_WUP, I_FCW, I_FCB, I_WDN, I_NFW };

namespace pg8 {
#define PG8_LAS __attribute__((address_space(3)))
typedef unsigned short bf16_t;
typedef short bf16x8 __attribute__((ext_vector_type(8)));
typedef float f32x4 __attribute__((ext_vector_type(4)));
typedef unsigned u32x4 __attribute__((ext_vector_type(4)));
constexpr int BM = 256, BK = 64, HALF = 128, HTB = HALF * BK * 2  , STAGE_BYTES = 8 * HTB, NXCD = 8, WGM = 8;

__host__ __device__ __forceinline__ int lds_byte(int r, int c) { const int st = (r >> 4) * 2 + (c >> 5), rr = r & 15, cc = c & 31, ob = rr * 64 + cc * 2; return st * 1024 + (ob ^ (((ob >> 9) & 1) << 5)); }
__host__ __device__ __forceinline__ void stage_rc(int b, int& R, int& C) { const int st = b / 1024, sb = b % 1024, swz = sb ^ (((sb >> 9) & 1) << 5); R = (st >> 1) * 16 + swz / 64; C = (st & 1) * 32 + (swz % 64) / 2; }
__host__ __device__ __forceinline__ int perm32(int rho) { const int n = rho >> 4, i = rho & 15; return 8 * (i >> 2) + 4 * n + (i & 3); }

struct Unit { int pm, pn; };
struct Gemm { const bf16_t* A; const bf16_t* Bt; int M, N, K; };

struct StaticOrder {
    int nM, nN, nwg, G, c;
    __host__ __device__ void init(int M, int N, int G_, int c_) { nM = M / BM; nN = N / BM; nwg = nM * nN; G = G_; c = c_; }
    __host__ __device__ bool next(int i, Unit& u) const {
        const long L = (long)i * G + c; if (L >= nwg) return false;
        int wgid = (int)L; { const int q = nwg / NXCD, r = nwg % NXCD, xcd = wgid % NXCD, off = wgid / NXCD; wgid = (xcd < r ? xcd * (q + 1) : r * (q + 1) + (xcd - r) * q) + off; }
        const int nig = WGM * nN, gid = wgid / nig, fm = gid * WGM, gsz = (nM - fm) < WGM ? (nM - fm) : WGM;
        u.pm = fm + ((wgid % nig) % gsz); u.pn = (wgid % nig) / gsz; return true;
    }
    __device__ __forceinline__ void a_ready(const Unit&) const {}
    __device__ __forceinline__ void done(const Unit&) const {}
};
typedef __bf16 bf16x2_t __attribute__((ext_vector_type(2)));
__device__ __forceinline__ unsigned cvt_pk_bf16(float lo, float hi) { f32x2 v = {lo, hi}; bf16x2_t h = __builtin_convertvector(v, bf16x2_t); return __builtin_bit_cast(unsigned, h); }
__device__ __forceinline__ float bf2f(unsigned b) { return __builtin_bit_cast(float, b << 16); }
__device__ __forceinline__ float bflo(unsigned w) { return __builtin_bit_cast(float, w << 16); }
__device__ __forceinline__ float bfhi(unsigned w) { return __builtin_bit_cast(float, w & 0xffff0000u); }
__device__ __forceinline__ bf16_t f2bf(float f) { return __builtin_bit_cast(bf16_t, (__bf16)f); }
__device__ __forceinline__ float sigm(float x) { return __builtin_amdgcn_rcpf(1.f + __expf(-x)); }
__device__ __forceinline__ float silu(float x) { return x * __builtin_amdgcn_rcpf(1.f + __expf(-x)); }
__device__ __forceinline__ float gelu_tanh(float x) { const float u = 0.7978845608028654f * (x + 0.044715f * x * x * x); const float th = 1.f - 2.f * __builtin_amdgcn_rcpf(__expf(2.f * u) + 1.f); return 0.5f * x * (1.f + th); }
__device__ __forceinline__ float dpp_f(float v, int ctrl_sel) { return v; }
#define DPP_ADD(v, CTRL) ((v) + __builtin_bit_cast(float, __builtin_amdgcn_update_dpp(0, __builtin_bit_cast(int, (v)), (CTRL), 0xF, 0xF, true)))
__device__ __forceinline__ float sum8(float v) { v = DPP_ADD(v, 0xB1); v = DPP_ADD(v, 0x4E); v = DPP_ADD(v, 0x141); return v; }
__device__ __forceinline__ float wave_sum(float v) {
    v = DPP_ADD(v, 0xB1); v = DPP_ADD(v, 0x4E); v = DPP_ADD(v, 0x141); v = DPP_ADD(v, 0x140);
    const float a = __builtin_bit_cast(float, __builtin_amdgcn_readlane(__builtin_bit_cast(int, v), 0)), b = __builtin_bit_cast(float, __builtin_amdgcn_readlane(__builtin_bit_cast(int, v), 16));
    const float c = __builtin_bit_cast(float, __builtin_amdgcn_readlane(__builtin_bit_cast(int, v), 32)), d = __builtin_bit_cast(float, __builtin_amdgcn_readlane(__builtin_bit_cast(int, v), 48));
    return (a + b) + (c + d);
}
__device__ __forceinline__ float wave_prefix(float v, int lane) {
    v = DPP_ADD(v, 0x111); v = DPP_ADD(v, 0x112); v = DPP_ADD(v, 0x114); v = DPP_ADD(v, 0x118);
    const float t0 = __builtin_bit_cast(float, __builtin_amdgcn_readlane(__builtin_bit_cast(int, v), 15)), t1 = __builtin_bit_cast(float, __builtin_amdgcn_readlane(__builtin_bit_cast(int, v), 31));
    const float t2 = __builtin_bit_cast(float, __builtin_amdgcn_readlane(__builtin_bit_cast(int, v), 47));
    const int r = lane >> 4;
    return v + (r >= 1 ? t0 : 0.f) + (r >= 2 ? t1 : 0.f) + (r >= 3 ? t2 : 0.f);
}

struct EpiStoreBf16 {
    static constexpr bool PERM = true, AFTER_DRAIN = false;
    bf16_t* O; int ldc;
    __device__ __forceinline__ void operator()(const f32x4 (&acc)[2][2][4][2], const Unit& u, int wr, int wc, int fr, int fq) const {
        const int row0 = u.pm * BM + wr * 64 + fr, col0 = u.pn * BM + wc * 32 + 8 * fq;
#pragma unroll
        for (int ai = 0; ai < 2; ++ai)
#pragma unroll
            for (int m = 0; m < 4; ++m) { bf16_t* rowp = O + (size_t)(row0 + ai * HALF + m * 16) * ldc + col0;
#pragma unroll
                for (int bj = 0; bj < 2; ++bj) { const f32x4 v0 = acc[ai][bj][m][0], v1 = acc[ai][bj][m][1];
                    u32x4 w; w.x = cvt_pk_bf16(v0[0], v0[1]); w.y = cvt_pk_bf16(v0[2], v0[3]); w.z = cvt_pk_bf16(v1[0], v1[1]); w.w = cvt_pk_bf16(v1[2], v1[3]);
                    *(u32x4*)(rowp + bj * HALF) = w; } }
    }
};
struct EpiGlu {
    static constexpr bool PERM = true, AFTER_DRAIN = false;
    const bf16_t* proj; bf16_t* tcat;
    __device__ __forceinline__ void operator()(const f32x4 (&acc)[2][2][4][2], const Unit& u, int wr, int wc, int fr, int fq) const {
        const int row0 = u.pm * BM + wr * 64 + fr, oc = u.pn * 128 + wc * 32 + 8 * fq;
#pragma unroll
        for (int ai = 0; ai < 2; ++ai) {
            u32x4 gl[4], od[4];
#pragma unroll
            for (int m = 0; m < 4; ++m) { const size_t r = (size_t)(row0 + ai * HALF + m * 16); gl[m] = *(const u32x4*)(proj + r * NPROJ + C_GATE + oc); od[m] = *(const u32x4*)(tcat + r * 1024 + oc); }
            __builtin_amdgcn_sched_barrier(0);
#pragma unroll
            for (int m = 0; m < 4; ++m) { const size_t r = (size_t)(row0 + ai * HALF + m * 16);
                const f32x4 a0 = acc[ai][0][m][0], a1 = acc[ai][0][m][1], g0 = acc[ai][1][m][0], g1 = acc[ai][1][m][1];
                float t[8];
                t[0] = sigm(bflo(gl[m].x)) * a0[0] * sigm(g0[0]) + bflo(od[m].x); t[1] = sigm(bfhi(gl[m].x)) * a0[1] * sigm(g0[1]) + bfhi(od[m].x);
                t[2] = sigm(bflo(gl[m].y)) * a0[2] * sigm(g0[2]) + bflo(od[m].y); t[3] = sigm(bfhi(gl[m].y)) * a0[3] * sigm(g0[3]) + bfhi(od[m].y);
                t[4] = sigm(bflo(gl[m].z)) * a1[0] * sigm(g1[0]) + bflo(od[m].z); t[5] = sigm(bfhi(gl[m].z)) * a1[1] * sigm(g1[1]) + bfhi(od[m].z);
                t[6] = sigm(bflo(gl[m].w)) * a1[2] * sigm(g1[2]) + bflo(od[m].w); t[7] = sigm(bfhi(gl[m].w)) * a1[3] * sigm(g1[3]) + bfhi(od[m].w);
                u32x4 w; w.x = cvt_pk_bf16(t[0], t[1]); w.y = cvt_pk_bf16(t[2], t[3]); w.z = cvt_pk_bf16(t[4], t[5]); w.w = cvt_pk_bf16(t[6], t[7]);
                *(u32x4*)(tcat + r * 1024 + oc) = w; }
            __builtin_amdgcn_sched_barrier(0);
        }
    }
};
template <bool RSTD, bool RMW> struct EpiSG {
    static constexpr bool PERM = true, AFTER_DRAIN = false;
    const bf16_t* proj; bf16_t* tcat; const float* ssq; int br;
    __device__ __forceinline__ void operator()(const f32x4 (&acc)[2][2][4][2], const Unit& u, int wr, int wc, int fr, int fq) const {
        const int row0 = u.pm * BM + wr * 64 + fr, col0 = u.pn * BM + wc * 32 + 8 * fq;
#pragma unroll
        for (int ai = 0; ai < 2; ++ai) {
            float sc[4] = {1.f, 1.f, 1.f, 1.f};
            if (RSTD) { f32x4 sv[4][4];
#pragma unroll
                for (int m = 0; m < 4; ++m) { const f32x4* sp = (const f32x4*)(ssq + (size_t)(row0 + ai * HALF + m * 16) * 16); sv[m][0] = sp[0]; sv[m][1] = sp[1]; sv[m][2] = sp[2]; sv[m][3] = sp[3]; }
                __builtin_amdgcn_sched_barrier(0);
#pragma unroll
                for (int m = 0; m < 4; ++m) { const f32x4 q = (sv[m][0] + sv[m][1]) + (sv[m][2] + sv[m][3]); sc[m] = 1.f / sqrtf(((q[0] + q[1]) + (q[2] + q[3])) * (1.f / 1024.f) + EPSN); } }
            u32x4 gl[4][2], od[4][2];
#pragma unroll
            for (int m = 0; m < 4; ++m)
#pragma unroll
                for (int bj = 0; bj < 2; ++bj) { const size_t r = (size_t)(row0 + ai * HALF + m * 16); const int c = col0 + bj * HALF;
                    gl[m][bj] = *(const u32x4*)(proj + r * NPROJ + C_GATE + br * 1024 + c); if (RMW) od[m][bj] = *(const u32x4*)(tcat + r * 1024 + c); }
            __builtin_amdgcn_sched_barrier(0);
#pragma unroll
            for (int m = 0; m < 4; ++m)
#pragma unroll
                for (int bj = 0; bj < 2; ++bj) { const size_t r = (size_t)(row0 + ai * HALF + m * 16); const int c = col0 + bj * HALF;
                    const f32x4 v0 = acc[ai][bj][m][0], v1 = acc[ai][bj][m][1]; const u32x4 g = gl[m][bj]; const float s = sc[m];
                    float t[8] = { sigm(bflo(g.x)) * s * v0[0], sigm(bfhi(g.x)) * s * v0[1], sigm(bflo(g.y)) * s * v0[2], sigm(bfhi(g.y)) * s * v0[3],
                                   sigm(bflo(g.z)) * s * v1[0], sigm(bfhi(g.z)) * s * v1[1], sigm(bflo(g.w)) * s * v1[2], sigm(bfhi(g.w)) * s * v1[3] };
                    if (RMW) { const u32x4 o = od[m][bj];
                        t[0] += bflo(o.x); t[1] += bfhi(o.x); t[2] += bflo(o.y); t[3] += bfhi(o.y); t[4] += bflo(o.z); t[5] += bfhi(o.z); t[6] += bflo(o.w); t[7] += bfhi(o.w); }
                    u32x4 w; w.x = cvt_pk_bf16(t[0], t[1]); w.y = cvt_pk_bf16(t[2], t[3]); w.z = cvt_pk_bf16(t[4], t[5]); w.w = cvt_pk_bf16(t[6], t[7]);
                    *(u32x4*)(tcat + r * 1024 + c) = w; }
            __builtin_amdgcn_sched_barrier(0);
        }
    }
};
struct EpiRes {
    static constexpr bool PERM = false, AFTER_DRAIN = false;
    const float* xp; const float* xs; float* xres; int from_in;
    __device__ __forceinline__ void operator()(const f32x4 (&acc)[2][2][4][2], const Unit& u, int wr, int wc, int fr, int fq) const {
        const int row0 = u.pm * BM + wr * 64 + fr, col0 = u.pn * BM + wc * 32 + 4 * fq;
#pragma unroll
        for (int ai = 0; ai < 2; ++ai) {
            f32x4 bs[4][2][2];
#pragma unroll
            for (int m = 0; m < 4; ++m) { const int r = row0 + ai * HALF + m * 16;
                const float* src = from_in ? (r < MP ? xp + (size_t)r * DM : xs + (size_t)(r - MP) * DM) + col0 : xres + (size_t)r * DM + col0;
#pragma unroll
                for (int bj = 0; bj < 2; ++bj)
#pragma unroll
                    for (int n = 0; n < 2; ++n) bs[m][bj][n] = *(const f32x4*)(src + bj * HALF + n * 16); }
            __builtin_amdgcn_sched_barrier(0);
#pragma unroll
            for (int m = 0; m < 4; ++m) { float* dst = xres + (size_t)(row0 + ai * HALF + m * 16) * DM + col0;
#pragma unroll
                for (int bj = 0; bj < 2; ++bj)
#pragma unroll
                    for (int n = 0; n < 2; ++n) *(f32x4*)(dst + bj * HALF + n * 16) = bs[m][bj][n] + acc[ai][bj][m][n]; }
            __builtin_amdgcn_sched_barrier(0);
        }
    }
};

template <class Epi, class Sched>
__device__ __forceinline__ void gemm_phase(PG8_LAS unsigned char* lds, const Gemm g, const Sched& S, const Epi& E, int tid_in) {
    int tid = tid_in; asm volatile("" : "+v"(tid));
    const int wid = __builtin_amdgcn_readfirstlane(tid >> 6), lane = tid & 63, wr = wid >> 2, wc = wid & 3, fr = lane & 15, fq = lane >> 4;
    const int K = g.K, nt = K / BK;
    unsigned voffA[2], voffB[2];
#pragma unroll
    for (int i = 0; i < 2; ++i) { int R, C; stage_rc(tid * 16 + i * 8192, R, C); const int Rb = Epi::PERM ? ((R & ~31) + perm32(R & 31)) : R;
        voffA[i] = (unsigned)(R * K + C) * 2u; voffB[i] = (unsigned)(Rb * K + C) * 2u; }
    const size_t kstep = (size_t)(BK * 2);
    const size_t hstep = (size_t)HALF * K * 2;
    const size_t tstep = 2 * hstep;
    const unsigned ldsw = (unsigned)wid * 1024u;
    const int aoff = lds_byte(wr * 64 + fr, fq * 8), boff = lds_byte(wc * 32 + fr, fq * 8);
#define PG8_SA(b, h) (((b) * 2 + (h)) * HTB)
#define PG8_SB(b, h) ((4 + (b) * 2 + (h)) * HTB)
#define PG8_STAGE(bufoff, gbase, voff) do { _Pragma("unroll") for (int _i = 0; _i < 2; ++_i) \
        __builtin_amdgcn_global_load_lds((const unsigned*)((const char*)(gbase) + (voff)[_i]), (PG8_LAS unsigned*)(lds + (bufoff) + ldsw + _i * 8192), 16, 0, 0); } while (0)
#define PG8_LDA(dst, b, h) do { _Pragma("unroll") for (int m = 0; m < 4; ++m) _Pragma("unroll") for (int k = 0; k < 2; ++k) dst[m][k] = *(const PG8_LAS bf16x8*)(lds + PG8_SA(b, h) + aoff + m * 2048 + k * 1024); } while (0)
#define PG8_LDB(dst, b, h) do { _Pragma("unroll") for (int n = 0; n < 2; ++n) _Pragma("unroll") for (int k = 0; k < 2; ++k) dst[n][k] = *(const PG8_LAS bf16x8*)(lds + PG8_SB(b, h) + boff + n * 2048 + k * 1024); } while (0)
#define PG8_MMA(ai, bj, At, Bt) do { __builtin_amdgcn_s_setprio(1); _Pragma("unroll") for (int m = 0; m < 4; ++m) _Pragma("unroll") for (int n = 0; n < 2; ++n) _Pragma("unroll") for (int k = 0; k < 2; ++k) \
        acc[ai][bj][m][n] = __builtin_amdgcn_mfma_f32_16x16x32_bf16(Bt[n][k], At[m][k], acc[ai][bj][m][n], 0, 0, 0); __builtin_amdgcn_s_setprio(0); } while (0)
#define PG8_WAIT_V(n) asm volatile("s_waitcnt vmcnt(" #n ")" ::: "memory")
#define PG8_WAIT_L(n) asm volatile("s_waitcnt lgkmcnt(" #n ")" ::: "memory")
#define PG8_BAR __builtin_amdgcn_s_barrier()
#define PG8_SCHED __builtin_amdgcn_sched_barrier(0)
    Unit cur, nxt; int ui = 0;
    if (!S.next(0, cur)) return;
    f32x4 acc[2][2][4][2];
#pragma unroll
    for (int a = 0; a < 2; ++a)
#pragma unroll
        for (int b = 0; b < 2; ++b)
#pragma unroll
            for (int m = 0; m < 4; ++m)
#pragma unroll
                for (int n = 0; n < 2; ++n) acc[a][b][m][n] = (f32x4){0.f, 0.f, 0.f, 0.f};
    bf16x8 At[4][2], B0[2][2], B1[2][2];
    const char* cA = (const char*)g.A + (size_t)cur.pm * tstep; const char* cB = (const char*)g.Bt + (size_t)cur.pn * tstep;
    S.a_ready(cur);
    PG8_STAGE(PG8_SB(0, 0), cB, voffB); PG8_STAGE(PG8_SA(0, 0), cA, voffA); PG8_STAGE(PG8_SB(0, 1), cB + hstep, voffB); PG8_STAGE(PG8_SA(0, 1), cA + hstep, voffA);
    if (wr == 1) PG8_BAR;
    PG8_WAIT_V(4); PG8_BAR;
    PG8_STAGE(PG8_SB(1, 0), cB + kstep, voffB); PG8_STAGE(PG8_SA(1, 0), cA + kstep, voffA); PG8_STAGE(PG8_SB(1, 1), cB + hstep + kstep, voffB);
    PG8_WAIT_V(6); PG8_BAR;
    for (;;) {
        const bool has_next = S.next(ui + 1, nxt);
        const char* nA = has_next ? (const char*)g.A + (size_t)nxt.pm * tstep : cA; const char* nB = has_next ? (const char*)g.Bt + (size_t)nxt.pn * tstep : cB;
        for (int t = 0; t < nt; t += 2) {
            const bool last = (t == nt - 2);
            const char* a1 = cA + (size_t)(t + 1) * kstep;
            const char* a2 = last ? nA : cA + (size_t)(t + 2) * kstep; const char* b2 = last ? nB : cB + (size_t)(t + 2) * kstep;
            const char* a3 = a2 + kstep; const char* b3 = b2 + kstep;
            if (last && has_next) S.a_ready(nxt);
            PG8_LDB(B0, 0, 0); PG8_SCHED; PG8_LDA(At, 0, 0); PG8_STAGE(PG8_SA(1, 1), a1 + hstep, voffA);
            PG8_WAIT_L(8); PG8_BAR; PG8_WAIT_L(0); PG8_MMA(0, 0, At, B0); PG8_BAR; PG8_SCHED;
            PG8_LDB(B1, 0, 1); PG8_STAGE(PG8_SB(0, 0), b2, voffB);
            PG8_BAR; PG8_WAIT_L(0); PG8_MMA(0, 1, At, B1); PG8_BAR;
            PG8_LDA(At, 0, 1); PG8_STAGE(PG8_SA(0, 0), a2, voffA);
            PG8_BAR; PG8_WAIT_L(0); PG8_MMA(1, 0, At, B0); PG8_BAR; PG8_SCHED;
            PG8_STAGE(PG8_SB(0, 1), b2 + hstep, voffB);
            PG8_WAIT_V(6); PG8_BAR; PG8_MMA(1, 1, At, B1); PG8_BAR;
            PG8_LDB(B0, 1, 0); PG8_SCHED; PG8_LDA(At, 1, 0); PG8_STAGE(PG8_SA(0, 1), a2 + hstep, voffA);
            PG8_WAIT_L(8); PG8_BAR; PG8_WAIT_L(0); PG8_MMA(0, 0, At, B0); PG8_BAR; PG8_SCHED;
            PG8_LDB(B1, 1, 1); PG8_STAGE(PG8_SB(1, 0), b3, voffB);
            PG8_BAR; PG8_WAIT_L(0); PG8_MMA(0, 1, At, B1); PG8_BAR;
            PG8_LDA(At, 1, 1); PG8_STAGE(PG8_SA(1, 0), a3, voffA);
            PG8_BAR; PG8_WAIT_L(0); PG8_MMA(1, 0, At, B0); PG8_BAR; PG8_SCHED;
            PG8_STAGE(PG8_SB(1, 1), b3 + hstep, voffB);
            PG8_WAIT_V(6); PG8_BAR; PG8_MMA(1, 1, At, B1); PG8_BAR;
        }
        if constexpr (!Epi::AFTER_DRAIN) { E(acc, cur, wr, wc, fr, fq); S.done(cur); }
        if (!has_next) break;
#pragma unroll
        for (int a = 0; a < 2; ++a)
#pragma unroll
            for (int b = 0; b < 2; ++b)
#pragma unroll
                for (int m = 0; m < 4; ++m)
#pragma unroll
                    for (int n = 0; n < 2; ++n) acc[a][b][m][n] = (f32x4){0.f, 0.f, 0.f, 0.f};
        cur = nxt; cA = nA; cB = nB; ++ui;
    }
    PG8_WAIT_V(0);
    if (wr == 0) PG8_BAR;
    PG8_BAR;
    if constexpr (Epi::AFTER_DRAIN) { E.fused(acc, cur, wr, wc, fr, fq, lds, wid, lane); S.done(cur); }
#undef PG8_SA
#undef PG8_SB
#undef PG8_STAGE
#undef PG8_LDA
#undef PG8_LDB
#undef PG8_MMA
#undef PG8_WAIT_V
#undef PG8_WAIT_L
#undef PG8_BAR
#undef PG8_SCHED
}
}
using namespace pg8;
constexpr int NTH = 512;

template <int MODE>
__device__ __forceinline__ void cvt_wt(const float* W, int K, int N, int Nphys, bf16_t* WT, int ldk, int koff, LAS float* scr, int tid, int rot) {
    const int nnb = Nphys / 64, ntile = (K / 64) * nnb;
    int bx_ = blockIdx.x; asm volatile("" : "+s"(bx_));
    for (int it = (bx_ + rot) % (int)gridDim.x; it < ntile; it += gridDim.x) {
        const int kb = it / nnb, nb = it % nnb, k0 = kb * 64, n0 = nb * 64;
        int src0 = n0;
        if (MODE == 2) { const int blk = n0 >> 8, within = n0 & 255; src0 = (within >> 7) * 1024 + blk * 128 + (within & 127); }
        const int c = tid & 63;
#pragma unroll
        for (int i = 0; i < 8; ++i) { const int kk = (tid >> 6) + 8 * i;
            float v = 0.f; if (MODE != 1 || src0 + c < N) v = W[(size_t)(k0 + kk) * N + src0 + c];
            scr[kk * 65 + c] = v; }
        __syncthreads();
        { const int n = tid >> 3, ch = tid & 7; const LAS float* s = scr + (8 * ch) * 65 + n;
          u32x4 o; o.x = cvt_pk_bf16(s[0], s[65]); o.y = cvt_pk_bf16(s[130], s[195]); o.z = cvt_pk_bf16(s[260], s[325]); o.w = cvt_pk_bf16(s[390], s[455]);
          *(u32x4*)(WT + (size_t)(n0 + n) * ldk + koff + k0 + 8 * ch) = o; }
        __syncthreads();
    }
}
__device__ __forceinline__ void convert_weights(const Params& P, int l, LAS unsigned char* L, int tid) {
    LAS float* scr = (LAS float*)L; unsigned char* ws = P.ws;
    cvt_wt<1>(P.in[I_WIN] + (size_t)l * 1024 * NPROJ_REAL, 1024, NPROJ_REAL, NPROJ, (bf16_t*)(ws + W_IN), 1024, 0, scr, tid, 0);
    cvt_wt<2>(P.in[I_S5GLU] + (size_t)l * 512 * 2048, 512, 2048, 2048, (bf16_t*)(ws + W_GLU), 512, 0, scr, tid, 192);
    cvt_wt<0>(P.in[I_SSDWO] + (size_t)l * 1024 * 1024, 1024, 1024, 1024, (bf16_t*)(ws + W_SSD), 1024, 0, scr, tid, 192);
    cvt_wt<0>(P.in[I_HGWO] + (size_t)l * 512 * 1024, 512, 1024, 1024, (bf16_t*)(ws + W_HG), 512, 0, scr, tid, 192);
    cvt_wt<0>(P.in[I_WO] + (size_t)l * 1024 * 1024, 1024, 1024, 1024, (bf16_t*)(ws + W_O3), 1024, 0, scr, tid, 64);
    cvt_wt<0>(P.in[I_WUP] + (size_t)l * 1024 * NUP, 1024, NUP, NUP, (bf16_t*)(ws + W_UP), 1024, 0, scr, tid, 128);
    cvt_wt<0>(P.in[I_WDN] + (size_t)l * DFF * 1024, DFF, 1024, 1024, (bf16_t*)(ws + W_DN), DFF, 0, scr, tid, 0);
}

__device__ __forceinline__ void norm_rows_bf16(const Params& P, int from_in, const float* w, bf16_t* out, int tid) {
    const int lane = tid & 63, gw = blockIdx.x * 8 + (tid >> 6), ngw = gridDim.x * 8;
    f32x4 wv[4];
#pragma unroll
    for (int j = 0; j < 4; ++j) wv[j] = ((const f32x4*)w)[lane + 64 * j];
    for (int row = gw; row < MT; row += ngw) {
        const float* xr = from_in ? (row < MP ? P.in[I_XP] + (size_t)row * DM : P.in[I_XS] + (size_t)(row - MP) * DM) : P.out + (size_t)row * DM;
        f32x4 v[4]; float ss = 0.f;
#pragma unroll
        for (int j = 0; j < 4; ++j) { v[j] = ((const f32x4*)xr)[lane + 64 * j]; ss += (v[j][0] * v[j][0] + v[j][1] * v[j][1]) + (v[j][2] * v[j][2] + v[j][3] * v[j][3]); }
        const float rstd = 1.f / sqrtf(wave_sum(ss) * (1.f / 1024.f) + EPSN);
        u32x2* o = (u32x2*)(out + (size_t)row * DM);
#pragma unroll
        for (int j = 0; j < 4; ++j) { u32x2 q; q.x = cvt_pk_bf16(v[j][0] * rstd * wv[j][0], v[j][1] * rstd * wv[j][1]); q.y = cvt_pk_bf16(v[j][2] * rstd * wv[j][2], v[j][3] * rstd * wv[j][3]); o[lane + 64 * j] = q; }
    }
}
__device__ __forceinline__ void final_norm(const Params& P, int tid) {
    const int lane = tid & 63, gw = blockIdx.x * 8 + (tid >> 6), ngw = gridDim.x * 8;
    const float* w = P.in[I_NFW];
    f32x4 wv[4];
#pragma unroll
    for (int j = 0; j < 4; ++j) wv[j] = ((const f32x4*)w)[lane + 64 * j];
    for (int row = gw; row < MT; row += ngw) {
        float* xr = P.out + (size_t)row * DM;
        f32x4 v[4]; float ss = 0.f;
#pragma unroll
        for (int j = 0; j < 4; ++j) { v[j] = ((const f32x4*)xr)[lane + 64 * j]; ss += (v[j][0] * v[j][0] + v[j][1] * v[j][1]) + (v[j][2] * v[j][2] + v[j][3] * v[j][3]); }
        const float rstd = 1.f / sqrtf(wave_sum(ss) * (1.f / 1024.f) + EPSN);
#pragma unroll
        for (int j = 0; j < 4; ++j) ((f32x4*)xr)[lane + 64 * j] = v[j] * rstd * wv[j];
    }
}

__device__ __forceinline__ void ffn_conv_phase(const Params& P, int l, int tid) {
    const bf16_t* up = (const bf16_t*)(P.ws + OFF_PROJ); bf16_t* hff = (bf16_t*)(P.ws + OFF_TCAT);
    const float* cw = P.in[I_FCW] + (size_t)l * 3 * DFF; const float* cb = P.in[I_FCB] + (size_t)l * DFF;
    const int total = MT * 352;
    for (int idx = blockIdx.x * NTH + tid; idx < total; idx += gridDim.x * NTH) {
        const int row = idx / 352, c0 = (idx - row * 352) * 8;
        int t, b; const bool pr = row < MP;
        if (pr) { b = row >> 11; t = row & 2047; } else { b = (row - MP) >> 2; t = (row - MP) & 3; }
        const u32x4 a2 = *(const u32x4*)(up + (size_t)row * NUP + c0);
        const u32x4 gg = *(const u32x4*)(up + (size_t)row * NUP + DFF + c0);
        float x2[8] = { bflo(a2.x), bfhi(a2.x), bflo(a2.y), bfhi(a2.y), bflo(a2.z), bfhi(a2.z), bflo(a2.w), bfhi(a2.w) };
        float gv[8] = { bflo(gg.x), bfhi(gg.x), bflo(gg.y), bfhi(gg.y), bflo(gg.z), bfhi(gg.z), bflo(gg.w), bfhi(gg.w) };
        float x1[8], x0[8];
        if (t >= 1) { const u32x4 a1 = *(const u32x4*)(up + (size_t)(row - 1) * NUP + c0);
            x1[0] = bflo(a1.x); x1[1] = bfhi(a1.x); x1[2] = bflo(a1.y); x1[3] = bfhi(a1.y); x1[4] = bflo(a1.z); x1[5] = bfhi(a1.z); x1[6] = bflo(a1.w); x1[7] = bfhi(a1.w);
        } else if (!pr) { const float* st = P.in[I_FFC] + ((size_t)(l * 128 + b) * 2 + 1) * DFF + c0;
#pragma unroll
            for (int i = 0; i < 8; ++i) x1[i] = st[i];
        } else {
#pragma unroll
            for (int i = 0; i < 8; ++i) x1[i] = 0.f; }
        if (t >= 2) { const u32x4 a0 = *(const u32x4*)(up + (size_t)(row - 2) * NUP + c0);
            x0[0] = bflo(a0.x); x0[1] = bfhi(a0.x); x0[2] = bflo(a0.y); x0[3] = bfhi(a0.y); x0[4] = bflo(a0.z); x0[5] = bfhi(a0.z); x0[6] = bflo(a0.w); x0[7] = bfhi(a0.w);
        } else if (!pr) { const float* st = P.in[I_FFC] + ((size_t)(l * 128 + b) * 2 + t) * DFF + c0;
#pragma unroll
            for (int i = 0; i < 8; ++i) x0[i] = st[i];
        } else {
#pragma unroll
            for (int i = 0; i < 8; ++i) x0[i] = 0.f; }
        float hv[8];
#pragma unroll
        for (int i = 0; i < 8; ++i) { const float cv = x0[i] * cw[c0 + i] + x1[i] * cw[DFF + c0 + i] + x2[i] * cw[2 * DFF + c0 + i] + cb[c0 + i]; hv[i] = silu(cv) * gv[i]; }
        u32x4 o; o.x = cvt_pk_bf16(hv[0], hv[1]); o.y = cvt_pk_bf16(hv[2], hv[3]); o.z = cvt_pk_bf16(hv[4], hv[5]); o.w = cvt_pk_bf16(hv[6], hv[7]);
        *(u32x4*)(hff + (size_t)row * DFF + c0) = o;
        if (pr && t >= 2046) { float* d = P.out + O_PFFC + ((size_t)(l * 8 + b) * 2 + (t - 2046)) * DFF + c0;
#pragma unroll
            for (int i = 0; i < 8; ++i) d[i] = x2[i]; }
        if (!pr && t >= 2) { float* d = P.out + O_SFFC + ((size_t)(l * 128 + b) * 2 + (t - 2)) * DFF + c0;
#pragma unroll
            for (int i = 0; i < 8; ++i) d[i] = x2[i]; }
    }
}

__device__ __forceinline__ float softplus(float x) { const float t = __expf(x); const float sm = t * (1.f - t * (0.5f - t * 0.33333334f)); return x > 20.f ? x : (t < 0.03f ? sm : __logf(1.f + t)); }

__device__ __forceinline__ void ssd_item(const Params& P, int l, bool prompt, int b, int h, LAS unsigned char* L, int tid) {
    const int Lseq = prompt ? 2048 : 4, row0 = prompt ? b * 2048 : MP + b * 4, g = h >> 2;
    LAS float* Bs = (LAS float*)L; LAS float* Cs = Bs + 4096; LAS float* xs = Cs + 4096; LAS float* zs = xs + 2048; LAS float* yb = zs + 2048; LAS float* dts = yb + 2048; LAS float* dAs = dts + 32;
    const bf16_t* proj = (const bf16_t*)(P.ws + OFF_PROJ);
    int role = 3, col = 0, xc = 0, dstride = 64; LAS float* dst = xs;
    if (tid < 128) { xc = 1024 + g * 128 + tid; dst = Bs + tid; dstride = 128; role = 0; }
    else if (tid < 256) { xc = 1536 + g * 128 + (tid - 128); dst = Cs + (tid - 128); dstride = 128; role = 0; }
    else if (tid < 320) { xc = h * 64 + (tid - 256); dst = xs + (tid - 256); dstride = 64; role = 0; }
    else if (tid < 384) { col = C_Z + h * 64 + (tid - 320); dst = zs + (tid - 320); dstride = 64; role = 1; }
    else if (tid < 416) role = 2;
    if (role == 0) col = C_XBC + xc;
    float w0 = 0.f, w1 = 0.f, w2 = 0.f, w3 = 0.f, cb = 0.f, r0 = 0.f, r1 = 0.f, r2 = 0.f;
    if (role == 0) { const float* cw = P.in[I_CONVW] + (size_t)l * 4 * 2048; w0 = cw[xc]; w1 = cw[2048 + xc]; w2 = cw[4096 + xc]; w3 = cw[6144 + xc]; cb = P.in[I_CONVB][l * 2048 + xc];
        if (!prompt) { const float* st = P.in[I_SSDC] + (size_t)(l * 128 + b) * 3 * 2048; r0 = st[xc]; r1 = st[2048 + xc]; r2 = st[4096 + xc]; } }
    const float dt_bias = P.in[I_DTB][l * 16 + h], aneg = -__expf(P.in[I_ALOG][l * 16 + h]), Dh = P.in[I_SSDD][l * 16 + h];
    const int p = tid >> 3, ns = tid & 7;
    f32x4 s[4];
    if (prompt) {
#pragma unroll
        for (int i = 0; i < 4; ++i) s[i] = (f32x4){0.f, 0.f, 0.f, 0.f};
    } else { const float* sp = P.in[I_SSD] + ((size_t)((l * 128 + b) * 16 + h) * 64 + p) * 128 + 4 * ns;
#pragma unroll
        for (int i = 0; i < 4; ++i) s[i] = *(const f32x4*)(sp + 32 * i); }
    bf16_t* Assd = (bf16_t*)(P.ws + OFF_XN); float* ssq = (float*)(P.ws + OFF_SSQ);
    const float* nw = P.in[I_SSDNW] + l * 1024 + h * 64;
    unsigned short rv[4];
#define SSD_LOAD(T0) do { if (role <= 1) { _Pragma("unroll") for (int tt = 0; tt < 4; ++tt) { int r_ = (T0) + tt; r_ = r_ < Lseq ? r_ : Lseq - 1; rv[tt] = proj[(size_t)(row0 + r_) * NPROJ + col]; } } \
        else if (role == 2) { int r_ = (T0) + (tid - 384); r_ = r_ < Lseq ? r_ : Lseq - 1; rv[0] = proj[(size_t)(row0 + r_) * NPROJ + C_DT + h]; } } while (0)
    SSD_LOAD(0);
    for (int t0 = 0; t0 < Lseq; t0 += 32) {
        const int len = (Lseq - t0) < 32 ? (Lseq - t0) : 32;
        if (role == 0) {
#pragma unroll
            for (int tt = 0; tt < 4; ++tt) { const float raw = bf2f(rv[tt]); const float y = r0 * w0 + r1 * w1 + r2 * w2 + raw * w3 + cb; dst[tt * dstride] = silu(y); r0 = r1; r1 = r2; r2 = raw; }
        } else if (role == 1) {
#pragma unroll
            for (int tt = 0; tt < 4; ++tt) dst[tt * dstride] = bf2f(rv[tt]);
        } else if (role == 2) { const int tt = tid - 384;
            const float raw = bf2f(rv[0]); const float dt = softplus(raw + dt_bias); dts[tt] = dt; dAs[tt] = __expf(dt * aneg); }
        __syncthreads();
        if (t0 + 32 < Lseq) SSD_LOAD(t0 + 32);
#define SSD_LD(Bx, Cx, dAx, dtx, xvx, TT) do { const int t_ = (TT) & 31; _Pragma("unroll") for (int i = 0; i < 4; ++i) { Bx[i] = *(const LAS f32x4*)(Bs + t_ * 128 + 32 * i + 4 * ns); Cx[i] = *(const LAS f32x4*)(Cs + t_ * 128 + 32 * i + 4 * ns); } \
            dAx = dAs[t_]; dtx = dts[t_]; xvx = xs[t_ * 64 + p]; } while (0)
#define SSD_STEP(Bx, Cx, dAx, dtx, xvx, TT) do { const float xdt_ = xvx * dtx; f32x4 y4_ = (f32x4){0.f, 0.f, 0.f, 0.f}; \
            _Pragma("unroll") for (int i = 0; i < 4; ++i) { s[i] = s[i] * dAx + Bx[i] * xdt_; y4_ += s[i] * Cx[i]; } \
            const float y_ = sum8((y4_[0] + y4_[1]) + (y4_[2] + y4_[3])); if (ns == 0) yb[(TT) * 64 + p] = y_; } while (0)
        { f32x4 B0[4], C0[4], B1[4], C1[4]; float dA0, dt0, xv0, dA1, dt1, xv1;
          SSD_LD(B0, C0, dA0, dt0, xv0, 0);
          for (int tt = 0; tt < len; tt += 2) {
              SSD_LD(B1, C1, dA1, dt1, xv1, tt + 1);
              SSD_STEP(B0, C0, dA0, dt0, xv0, tt);
              SSD_LD(B0, C0, dA0, dt0, xv0, tt + 2);
              SSD_STEP(B1, C1, dA1, dt1, xv1, tt + 1);
          } }
        __syncthreads();
        { const int tt = tid >> 4, q = tid & 15; f32x4 v = *(const LAS f32x4*)(yb + tt * 64 + 4 * q);
          { const f32x4 xv4 = *(const LAS f32x4*)(xs + tt * 64 + 4 * q), z4 = *(const LAS f32x4*)(zs + tt * 64 + 4 * q);
            v[0] = (v[0] + Dh * xv4[0]) * silu(z4[0]); v[1] = (v[1] + Dh * xv4[1]) * silu(z4[1]); v[2] = (v[2] + Dh * xv4[2]) * silu(z4[2]); v[3] = (v[3] + Dh * xv4[3]) * silu(z4[3]); }
          float sq = (v[0] * v[0] + v[1] * v[1]) + (v[2] * v[2] + v[3] * v[3]);
          sq = sum8(sq); sq = DPP_ADD(sq, 0x140);
          if (tt < len) { const size_t row = (size_t)(row0 + t0 + tt); const f32x4 wv = *(const f32x4*)(nw + 4 * q);
              u32x2 o; o.x = cvt_pk_bf16(v[0] * wv[0], v[1] * wv[1]); o.y = cvt_pk_bf16(v[2] * wv[2], v[3] * wv[3]);
              *(u32x2*)(Assd + row * DM + h * 64 + 4 * q) = o;
              if (q == 0) ssq[row * 16 + h] = sq; } }
    }
    { float* sp = P.out + (prompt ? O_PSSD + ((size_t)((l * 8 + b) * 16 + h) * 64 + p) * 128 : O_SSSD + ((size_t)((l * 128 + b) * 16 + h) * 64 + p) * 128) + 4 * ns;
#pragma unroll
      for (int i = 0; i < 4; ++i) *(f32x4*)(sp + 32 * i) = s[i]; }
    __syncthreads();
}

__device__ __forceinline__ void ssd_s4_item(const Params& P, int l, int b, int g, LAS unsigned char* L, int tid) {
    const int row0 = MP + b * 4;
    LAS float* Bs = (LAS float*)L; LAS float* Cs = Bs + 512; LAS float* xs = Cs + 512; LAS float* zs = xs + 1024; LAS float* yb = zs + 1024; LAS float* dts = yb + 1024; LAS float* dAs = dts + 16;
    const bf16_t* proj = (const bf16_t*)(P.ws + OFF_PROJ);
    const bool isx = tid >= 256; const int hh2 = (tid - 256) >> 6, p2 = (tid - 256) & 63;
    const int xc = !isx ? (tid < 128 ? 1024 + g * 128 + tid : 1536 + g * 128 + (tid - 128)) : (4 * g + hh2) * 64 + p2;
    LAS float* dst = !isx ? (tid < 128 ? Bs + tid : Cs + (tid - 128)) : xs + hh2 * 256 + p2;
    const int dstride = !isx ? 128 : 64;
    const float* cw = P.in[I_CONVW] + (size_t)l * 4 * 2048; const float w0 = cw[xc], w1 = cw[2048 + xc], w2 = cw[4096 + xc], w3 = cw[6144 + xc], cb = P.in[I_CONVB][l * 2048 + xc];
    const float* st = P.in[I_SSDC] + (size_t)(l * 128 + b) * 3 * 2048; float r0 = st[xc], r1 = st[2048 + xc], r2 = st[4096 + xc];
    unsigned short rv[4], zv[4] = {0, 0, 0, 0};
#pragma unroll
    for (int tt = 0; tt < 4; ++tt) { rv[tt] = proj[(size_t)(row0 + tt) * NPROJ + C_XBC + xc]; if (isx) zv[tt] = proj[(size_t)(row0 + tt) * NPROJ + C_Z + (4 * g + hh2) * 64 + p2]; }
    float dtr = 0.f, dtb = 0.f, an = 0.f;
    if (tid < 16) { const int hh = tid >> 2, tt = tid & 3; dtr = bf2f(proj[(size_t)(row0 + tt) * NPROJ + C_DT + 4 * g + hh]); dtb = P.in[I_DTB][l * 16 + 4 * g + hh]; an = -__expf(P.in[I_ALOG][l * 16 + 4 * g + hh]); }
    const int p = tid >> 3, ns = tid & 7;
    f32x4 s[4][4];
#pragma unroll
    for (int hh = 0; hh < 4; ++hh) { const float* sp = P.in[I_SSD] + ((size_t)((l * 128 + b) * 16 + 4 * g + hh) * 64 + p) * 128 + 4 * ns;
#pragma unroll
        for (int i = 0; i < 4; ++i) s[hh][i] = *(const f32x4*)(sp + 32 * i); }
#pragma unroll
    for (int tt = 0; tt < 4; ++tt) { const float raw = bf2f(rv[tt]); const float y = r0 * w0 + r1 * w1 + r2 * w2 + raw * w3 + cb; dst[tt * dstride] = silu(y); r0 = r1; r1 = r2; r2 = raw; }
    if (isx) {
#pragma unroll
        for (int tt = 0; tt < 4; ++tt) zs[hh2 * 256 + tt * 64 + p2] = bf2f(zv[tt]); }
    if (tid < 16) { const float dt = softplus(dtr + dtb); dts[tid] = dt; dAs[tid] = __expf(dt * an); }
    __syncthreads();
#pragma unroll
    for (int tt = 0; tt < 4; ++tt) {
        f32x4 Bv[4], Cv[4];
#pragma unroll
        for (int i = 0; i < 4; ++i) { Bv[i] = *(const LAS f32x4*)(Bs + tt * 128 + 32 * i + 4 * ns); Cv[i] = *(const LAS f32x4*)(Cs + tt * 128 + 32 * i + 4 * ns); }
#pragma unroll
        for (int hh = 0; hh < 4; ++hh) { const float dA = dAs[hh * 4 + tt], xdt = xs[hh * 256 + tt * 64 + p] * dts[hh * 4 + tt];
            f32x4 y4 = (f32x4){0.f, 0.f, 0.f, 0.f};
#pragma unroll
            for (int i = 0; i < 4; ++i) { s[hh][i] = s[hh][i] * dA + Bv[i] * xdt; y4 += s[hh][i] * Cv[i]; }
            const float y = sum8((y4[0] + y4[1]) + (y4[2] + y4[3])); if (ns == 0) yb[hh * 256 + tt * 64 + p] = y; }
    }
#pragma unroll
    for (int hh = 0; hh < 4; ++hh) { float* sp = P.out + O_SSSD + ((size_t)((l * 128 + b) * 16 + 4 * g + hh) * 64 + p) * 128 + 4 * ns;
#pragma unroll
        for (int i = 0; i < 4; ++i) *(f32x4*)(sp + 32 * i) = s[hh][i]; }
    __syncthreads();
    { const int pair = (tid >> 4) & 15, q = tid & 15, hh = pair >> 2, tt = pair & 3, h = 4 * g + hh;
      f32x4 v = *(const LAS f32x4*)(yb + pair * 64 + 4 * q); const f32x4 xv4 = *(const LAS f32x4*)(xs + pair * 64 + 4 * q), z4 = *(const LAS f32x4*)(zs + pair * 64 + 4 * q);
      const float Dh = P.in[I_SSDD][l * 16 + h];
      v[0] = (v[0] + Dh * xv4[0]) * silu(z4[0]); v[1] = (v[1] + Dh * xv4[1]) * silu(z4[1]); v[2] = (v[2] + Dh * xv4[2]) * silu(z4[2]); v[3] = (v[3] + Dh * xv4[3]) * silu(z4[3]);
      float sq = (v[0] * v[0] + v[1] * v[1]) + (v[2] * v[2] + v[3] * v[3]);
      sq = sum8(sq); sq = DPP_ADD(sq, 0x140);
      if (tid < 256) { const size_t row = (size_t)(row0 + tt); const f32x4 wv = *(const f32x4*)(P.in[I_SSDNW] + l * 1024 + h * 64 + 4 * q);
          u32x2 o; o.x = cvt_pk_bf16(v[0] * wv[0], v[1] * wv[1]); o.y = cvt_pk_bf16(v[2] * wv[2], v[3] * wv[3]);
          *(u32x2*)((bf16_t*)(P.ws + OFF_XN) + row * DM + h * 64 + 4 * q) = o;
          if (q == 0) ((float*)(P.ws + OFF_SSQ))[row * 16 + h] = sq; } }
    __syncthreads();
}

template <int KT>
__device__ __forceinline__ f32x4 mma_rt(const LAS bf16_t* A, int pa, const LAS bf16_t* Bt, int pb, f32x4 acc, int lane) {
    const LAS bf16_t* ap = A + (lane & 15) * pa + (lane >> 4) * 8; const LAS bf16_t* bp = Bt + (lane & 15) * pb + (lane >> 4) * 8;
#pragma unroll
    for (int kt = 0; kt < KT; ++kt) { const bf16x8 a = *(const LAS bf16x8*)(ap + kt * 32), b = *(const LAS bf16x8*)(bp + kt * 32); acc = __builtin_amdgcn_mfma_f32_16x16x32_bf16(a, b, acc, 0, 0, 0); }
    return acc;
}
__device__ __forceinline__ u32x4 pack8(float a0, float a1, float a2, float a3, float a4, float a5, float a6, float a7) { u32x4 w; w.x = cvt_pk_bf16(a0, a1); w.y = cvt_pk_bf16(a2, a3); w.z = cvt_pk_bf16(a4, a5); w.w = cvt_pk_bf16(a6, a7); return w; }

__device__ __forceinline__ void ssd_mfma_item(const Params& P, int l, int b, int h, LAS unsigned char* L, int tid) {
    constexpr int PC = 136, PT = 72;
    LAS bf16_t* Cl = (LAS bf16_t*)L; LAS bf16_t* Bl = (LAS bf16_t*)(L + 17408); LAS bf16_t* BTl = (LAS bf16_t*)(L + 34816); LAS float* ybuf = (LAS float*)(L + 34816);
    LAS bf16_t* XdT = (LAS bf16_t*)(L + 53248); LAS bf16_t* XwT = (LAS bf16_t*)(L + 62464); LAS bf16_t* Gl = (LAS bf16_t*)(L + 71680); LAS bf16_t* Sl = (LAS bf16_t*)(L + 80896);
    LAS float* xf = (LAS float*)(L + 98304); LAS float* dtl = (LAS float*)(L + 114688); LAS float* acl = dtl + 64;
    const bf16_t* proj = (const bf16_t*)(P.ws + OFF_PROJ);
    const int lane = tid & 63, w = tid >> 6, kq = lane >> 4, lc = lane & 15, g = h >> 2, row0 = b * 2048;
    const float dt_bias = P.in[I_DTB][l * 16 + h], aneg = -__expf(P.in[I_ALOG][l * 16 + h]), Dh = P.in[I_SSDD][l * 16 + h];
    const bool stg = tid < 320;
#define SSD_TASK(TK) const int task_ = (TK) == 0 ? tid : 512 + tid; const bool tv_ = (TK) == 0 || tid < 128; const int oct_ = task_ % 40, rg4_ = task_ / 40; \
        const int kind_ = oct_ < 16 ? 0 : (oct_ < 32 ? 1 : 2); const int ch0_ = kind_ == 0 ? oct_ * 8 : (kind_ == 1 ? (oct_ - 16) * 8 : (oct_ - 32) * 8); \
        const int xc0_ = kind_ == 0 ? 1024 + g * 128 + ch0_ : (kind_ == 1 ? 1536 + g * 128 + ch0_ : h * 64 + ch0_); const int cbase_ = kind_ == 0 ? ch0_ : (kind_ == 1 ? 128 + ch0_ : 256 + ch0_); const int s0_ = rg4_ * 4;
    LAS float* wl = (LAS float*)(L + 115200);
    LAS float* nwl = wl + 1600;
    if (stg) { const int xc = tid < 128 ? 1024 + g * 128 + tid : (tid < 256 ? 1536 + g * 128 + (tid - 128) : h * 64 + (tid - 256));
        const float* cwp = P.in[I_CONVW] + (size_t)l * 4 * 2048 + xc;
        wl[tid] = cwp[0]; wl[320 + tid] = cwp[2048]; wl[640 + tid] = cwp[4096]; wl[960 + tid] = cwp[6144]; wl[1280 + tid] = P.in[I_CONVB][l * 2048 + xc]; }
    else if (tid < 384) nwl[tid - 320] = P.in[I_SSDNW][l * 1024 + h * 64 + (tid - 320)];
    for (int i = tid; i < 64 * PC / 2; i += NTH) ((LAS unsigned*)Sl)[i] = 0u;
    f32x4 accS[4];
#pragma unroll
    for (int i = 0; i < 4; ++i) accS[i] = (f32x4){0.f, 0.f, 0.f, 0.f};
    bf16_t* Assd = (bf16_t*)(P.ws + OFF_XN); float* ssq = (float*)(P.ws + OFF_SSQ);
    u32x4 raw[2][7]; unsigned short dtraw = 0; u32x4 zraw;
#define SSDM_LOAD(C) do { _Pragma("unroll") for (int tk = 0; tk < 2; ++tk) { SSD_TASK(tk) if (tv_) { _Pragma("unroll") for (int r = 0; r < 7; ++r) { const int gr_ = (C) * 64 + s0_ - 3 + r; \
            raw[tk][r] = gr_ >= 0 ? *(const u32x4*)(proj + (size_t)(row0 + gr_) * NPROJ + C_XBC + xc0_) : (u32x4){0u, 0u, 0u, 0u}; } } } \
        if (w == 0) dtraw = proj[(size_t)(row0 + (C) * 64 + lane) * NPROJ + C_DT + h]; \
        zraw = *(const u32x4*)(proj + (size_t)(row0 + (C) * 64 + (tid >> 3)) * NPROJ + C_Z + h * 64 + 8 * (tid & 7)); } while (0)
    SSDM_LOAD(0);
    __syncthreads();
    for (int c = 0; c < 32; ++c) {
        if (w == 0) { const float dt = softplus(bf2f(dtraw) + dt_bias); float a = dt * aneg;
            a = wave_prefix(a, lane);
            dtl[lane] = dt; acl[lane] = a; }
        const u32x4 zcur = zraw;
        __syncthreads();
#pragma unroll
        for (int tk = 0; tk < 2; ++tk) { SSD_TASK(tk)
          if (tv_) {
            float cw[4][8], cbv[8];
#pragma unroll
            for (int k = 0; k < 4; ++k) { const f32x4 a = *(const LAS f32x4*)(wl + k * 320 + cbase_), c4 = *(const LAS f32x4*)(wl + k * 320 + cbase_ + 4);
                cw[k][0] = a[0]; cw[k][1] = a[1]; cw[k][2] = a[2]; cw[k][3] = a[3]; cw[k][4] = c4[0]; cw[k][5] = c4[1]; cw[k][6] = c4[2]; cw[k][7] = c4[3]; }
            { const f32x4 a = *(const LAS f32x4*)(wl + 1280 + cbase_), c4 = *(const LAS f32x4*)(wl + 1280 + cbase_ + 4);
              cbv[0] = a[0]; cbv[1] = a[1]; cbv[2] = a[2]; cbv[3] = a[3]; cbv[4] = c4[0]; cbv[5] = c4[1]; cbv[6] = c4[2]; cbv[7] = c4[3]; }
            {
                float o8[4][8];
#pragma unroll
                for (int i = 0; i < 4; ++i) {
#pragma unroll
                    for (int j = 0; j < 8; ++j) { float y = cbv[j];
#pragma unroll
                        for (int k = 0; k < 4; ++k) { const u32x4 rr = raw[tk][i + k]; const unsigned wd = (j >> 1) == 0 ? rr.x : ((j >> 1) == 1 ? rr.y : ((j >> 1) == 2 ? rr.z : rr.w));
                            y += cw[k][j] * ((j & 1) ? bfhi(wd) : bflo(wd)); }
                        o8[i][j] = silu(y); } }
                const int s0 = s0_, kind = kind_, ch0 = ch0_;
                if (kind == 0) {
#pragma unroll
                    for (int i = 0; i < 4; ++i) *(LAS u32x4*)(Bl + (s0 + i) * PC + ch0) = pack8(o8[i][0], o8[i][1], o8[i][2], o8[i][3], o8[i][4], o8[i][5], o8[i][6], o8[i][7]);
#pragma unroll
                    for (int j = 0; j < 8; ++j) { u32x2 q; q.x = cvt_pk_bf16(o8[0][j], o8[1][j]); q.y = cvt_pk_bf16(o8[2][j], o8[3][j]); *(LAS u32x2*)(BTl + (ch0 + j) * PT + s0) = q; }
                } else if (kind == 1) {
#pragma unroll
                    for (int i = 0; i < 4; ++i) *(LAS u32x4*)(Cl + (s0 + i) * PC + ch0) = pack8(o8[i][0], o8[i][1], o8[i][2], o8[i][3], o8[i][4], o8[i][5], o8[i][6], o8[i][7]);
                } else {
                    const f32x4 d0 = *(const LAS f32x4*)(dtl + s0), a0 = *(const LAS f32x4*)(acl + s0);
                    const float alast = acl[63];
                    float dv[4] = {d0[0], d0[1], d0[2], d0[3]};
                    float ev[4] = {a0[0], a0[1], a0[2], a0[3]};
#pragma unroll
                    for (int i = 0; i < 4; ++i) ev[i] = dv[i] * __expf(alast - ev[i]);
#pragma unroll
                    for (int i = 0; i < 4; ++i) { *(LAS f32x4*)(xf + (s0 + i) * 64 + ch0) = (f32x4){o8[i][0], o8[i][1], o8[i][2], o8[i][3]}; *(LAS f32x4*)(xf + (s0 + i) * 64 + ch0 + 4) = (f32x4){o8[i][4], o8[i][5], o8[i][6], o8[i][7]}; }
#pragma unroll
                    for (int j = 0; j < 8; ++j) { u32x2 q;
                        q.x = cvt_pk_bf16(o8[0][j] * dv[0], o8[1][j] * dv[1]); q.y = cvt_pk_bf16(o8[2][j] * dv[2], o8[3][j] * dv[3]); *(LAS u32x2*)(XdT + (ch0 + j) * PT + s0) = q;
                        q.x = cvt_pk_bf16(o8[0][j] * ev[0], o8[1][j] * ev[1]); q.y = cvt_pk_bf16(o8[2][j] * ev[2], o8[3][j] * ev[3]); *(LAS u32x2*)(XwT + (ch0 + j) * PT + s0) = q; }
                }
            }
          }
        }
        __syncthreads();
        if (c + 1 < 32) SSDM_LOAD(c + 1);
        f32x4 y2[2];
#pragma unroll
        for (int ti = 0; ti < 2; ++ti) { const int tile = 2 * w + ti, qi = tile >> 2, si = tile & 3;
            f32x4 acc = (f32x4){0.f, 0.f, 0.f, 0.f};
            if (si <= qi) acc = mma_rt<4>(Cl + qi * 16 * PC, PC, Bl + si * 16 * PC, PC, acc, lane);
            const int q0 = qi * 16 + kq * 4, s = si * 16 + lc; const f32x4 aq = *(const LAS f32x4*)(acl + q0); const float as = acl[s];
#pragma unroll
            for (int j = 0; j < 4; ++j) { const float gv = (s <= q0 + j) ? acc[j] * __expf(aq[j] - as) : 0.f; Gl[(q0 + j) * PT + s] = f2bf(gv); }
            y2[ti] = mma_rt<4>(Cl + qi * 16 * PC, PC, Sl + si * 16 * PC, PC, (f32x4){0.f, 0.f, 0.f, 0.f}, lane);
        }
        __syncthreads();
        f32x4 yv[2];
#pragma unroll
        for (int ti = 0; ti < 2; ++ti) { const int tile = 2 * w + ti, qi = tile >> 2, pi = tile & 3;
            const f32x4 y1 = mma_rt<2>(Gl + qi * 16 * PT, PT, XdT + pi * 16 * PT, PT, (f32x4){0.f, 0.f, 0.f, 0.f}, lane);
            const f32x4 aq = *(const LAS f32x4*)(acl + qi * 16 + kq * 4);
#pragma unroll
            for (int j = 0; j < 4; ++j) yv[ti][j] = y1[j] + __expf(aq[j]) * y2[ti][j]; }
        { const float dec = __expf(acl[63]);
#pragma unroll
          for (int i = 0; i < 4; ++i) { const int tile = 4 * w + i, pi = tile >> 3, ni = tile & 7;
              accS[i] = accS[i] * dec; accS[i] = mma_rt<2>(XwT + pi * 16 * PT, PT, BTl + ni * 16 * PT, PT, accS[i], lane);
#pragma unroll
              for (int j = 0; j < 4; ++j) Sl[(pi * 16 + kq * 4 + j) * PC + ni * 16 + lc] = f2bf(accS[i][j]); } }
        __syncthreads();
#pragma unroll
        for (int ti = 0; ti < 2; ++ti) { const int tile = 2 * w + ti, qi = tile >> 2, pi = tile & 3;
#pragma unroll
            for (int j = 0; j < 4; ++j) ybuf[(qi * 16 + kq * 4 + j) * 68 + pi * 16 + lc] = yv[ti][j]; }
        __syncthreads();
        { const int tt = tid >> 3, q8 = tid & 7; const size_t row = (size_t)(row0 + c * 64 + tt);
          const f32x4 v0 = *(const LAS f32x4*)(ybuf + tt * 68 + 8 * q8), v1 = *(const LAS f32x4*)(ybuf + tt * 68 + 8 * q8 + 4);
          const f32x4 x0 = *(const LAS f32x4*)(xf + tt * 64 + 8 * q8), x1 = *(const LAS f32x4*)(xf + tt * 64 + 8 * q8 + 4);
          const f32x4 nw0 = *(const LAS f32x4*)(nwl + 8 * q8), nw1 = *(const LAS f32x4*)(nwl + 8 * q8 + 4);
          float o[8];
          o[0] = (v0[0] + Dh * x0[0]) * silu(bflo(zcur.x)); o[1] = (v0[1] + Dh * x0[1]) * silu(bfhi(zcur.x));
          o[2] = (v0[2] + Dh * x0[2]) * silu(bflo(zcur.y)); o[3] = (v0[3] + Dh * x0[3]) * silu(bfhi(zcur.y));
          o[4] = (v1[0] + Dh * x1[0]) * silu(bflo(zcur.z)); o[5] = (v1[1] + Dh * x1[1]) * silu(bfhi(zcur.z));
          o[6] = (v1[2] + Dh * x1[2]) * silu(bflo(zcur.w)); o[7] = (v1[3] + Dh * x1[3]) * silu(bfhi(zcur.w));
          float sq = 0.f;
#pragma unroll
          for (int j = 0; j < 8; ++j) sq += o[j] * o[j];
          sq = sum8(sq);
          *(u32x4*)(Assd + row * DM + h * 64 + 8 * q8) = pack8(o[0] * nw0[0], o[1] * nw0[1], o[2] * nw0[2], o[3] * nw0[3], o[4] * nw1[0], o[5] * nw1[1], o[6] * nw1[2], o[7] * nw1[3]);
          if (q8 == 0) ssq[row * 16 + h] = sq; }
    }
#undef SSDM_LOAD
#undef SSD_TASK
    { int t2 = tid; asm volatile("" : "+v"(t2)); const int lane = t2 & 63, w = t2 >> 6, kq = lane >> 4, lc = lane & 15;
      float* sp = P.out + O_PSSD + (size_t)((l * 8 + b) * 16 + h) * 64 * 128;
#pragma unroll
      for (int i = 0; i < 4; ++i) { const int tile = 4 * w + i, pi = tile >> 3, ni = tile & 7;
#pragma unroll
          for (int j = 0; j < 4; ++j) sp[(size_t)(pi * 16 + kq * 4 + j) * 128 + ni * 16 + lc] = accS[i][j]; } }
    __syncthreads();
}

__device__ __forceinline__ void hg_half(const Params& P, int l, bool prompt, int b, int hd, int vh, LAS unsigned char* L, int tid) {
    const int Lseq = prompt ? 2048 : 4, row0 = prompt ? b * 2048 : MP + b * 4;
    LAS float* fs = (LAS float*)L; LAS float* qs = fs + 4096; LAS float* vs = qs + 4096; LAS float* ob = vs + 2048;
    const bf16_t* proj = (const bf16_t*)(P.ws + OFF_PROJ); float* oraw = (float*)(P.ws + OFF_TCAT);
    int role = 3, col = 0, dstride = 128; LAS float* dst = fs; float lb = 0.f;
    if (tid < 128) { col = C_F + hd * 128 + tid; dst = fs + tid; role = 0;
        if (l > 0) { const float l0 = P.in[I_LB][hd * 128 + tid], l1 = P.in[I_LB][512 + hd * 128 + tid]; lb = 1.f / (1.f + expf(l0 - l1)); } }
    else if (tid < 256) { col = C_Q + hd * 128 + (tid - 128); dst = qs + (tid - 128); role = 1; }
    else if (tid < 320) { col = C_I + hd * 128 + vh * 64 + (tid - 256); dst = vs + (tid - 256); dstride = 64; role = 1; }
    const int v = tid >> 3, ks = tid & 7;
    f32x4 S[4];
    const size_t sbase = ((size_t)hd * 128) * 128 + vh * 64 + v;
    if (prompt) {
#pragma unroll
        for (int i = 0; i < 4; ++i) S[i] = (f32x4){0.f, 0.f, 0.f, 0.f};
    } else { const float* sp = P.in[I_HG] + (size_t)(l * 128 + b) * 4 * 16384 + sbase;
#pragma unroll
        for (int i = 0; i < 4; ++i)
#pragma unroll
            for (int j = 0; j < 4; ++j) S[i][j] = sp[(size_t)(32 * i + 4 * ks + j) * 128]; }
    unsigned short rv[4];
#define HG_LOAD(T0) do { if (role <= 1) { _Pragma("unroll") for (int tt = 0; tt < 4; ++tt) { int r_ = (T0) + tt; r_ = r_ < Lseq ? r_ : Lseq - 1; rv[tt] = proj[(size_t)(row0 + r_) * NPROJ + col]; } } } while (0)
    HG_LOAD(0);
    for (int t0 = 0; t0 < Lseq; t0 += 32) {
        const int len = (Lseq - t0) < 32 ? (Lseq - t0) : 32;
        if (role == 0) {
#pragma unroll
            for (int tt = 0; tt < 4; ++tt) { const float z = bf2f(rv[tt]); dst[tt * 128] = lb + (1.f - lb) * sigm(z); }
        } else if (role == 1) {
#pragma unroll
            for (int tt = 0; tt < 4; ++tt) dst[tt * dstride] = bf2f(rv[tt]);
        }
        __syncthreads();
        if (t0 + 32 < Lseq) HG_LOAD(t0 + 32);
#define HG_LD(Fx, Qx, vvx, TT) do { const int t_ = (TT) & 31; _Pragma("unroll") for (int i = 0; i < 4; ++i) { Fx[i] = *(const LAS f32x4*)(fs + t_ * 128 + 32 * i + 4 * ks); Qx[i] = *(const LAS f32x4*)(qs + t_ * 128 + 32 * i + 4 * ks); } \
            vvx = vs[t_ * 64 + v]; } while (0)
#define HG_STEP(Fx, Qx, vvx, TT) do { f32x4 o4_ = (f32x4){0.f, 0.f, 0.f, 0.f}; \
            _Pragma("unroll") for (int i = 0; i < 4; ++i) { S[i] = Fx[i] * (S[i] - vvx) + vvx; o4_ += S[i] * Qx[i]; } \
            const float o_ = sum8((o4_[0] + o4_[1]) + (o4_[2] + o4_[3])); if (ks == 0) ob[(TT) * 64 + v] = o_; } while (0)
        { f32x4 F0[4], Q0[4], F1[4], Q1[4]; float vv0, vv1;
          HG_LD(F0, Q0, vv0, 0);
          for (int tt = 0; tt < len; tt += 2) {
              HG_LD(F1, Q1, vv1, tt + 1);
              HG_STEP(F0, Q0, vv0, tt);
              HG_LD(F0, Q0, vv0, tt + 2);
              HG_STEP(F1, Q1, vv1, tt + 1);
          } }
        __syncthreads();
        { const int tt = tid >> 4, q = tid & 15;
          if (tt < len) *(f32x4*)(oraw + (size_t)(row0 + t0 + tt) * 512 + hd * 128 + vh * 64 + 4 * q) = *(const LAS f32x4*)(ob + tt * 64 + 4 * q); }
    }
    { float* sp = P.out + (prompt ? O_PHG + (size_t)(l * 8 + b) * 4 * 16384 : O_SHG + (size_t)(l * 128 + b) * 4 * 16384) + sbase;
#pragma unroll
      for (int i = 0; i < 4; ++i)
#pragma unroll
          for (int j = 0; j < 4; ++j) sp[(size_t)(32 * i + 4 * ks + j) * 128] = S[i][j]; }
    __syncthreads();
}
__device__ __forceinline__ void hg_mfma_half(const Params& P, int l, int b, int hd, int vh, LAS unsigned char* L, int tid) {
    constexpr int PC = 136, PT = 72;
    LAS bf16_t* Qt = (LAS bf16_t*)L; LAS bf16_t* Kt = (LAS bf16_t*)(L + 17408); LAS bf16_t* Qs = (LAS bf16_t*)(L + 34816); LAS bf16_t* Al = (LAS bf16_t*)(L + 52224);
    LAS bf16_t* VT = (LAS bf16_t*)(L + 61440); LAS bf16_t* KdT = (LAS bf16_t*)(L + 70656); LAS bf16_t* ST = (LAS bf16_t*)(L + 89088);
    LAS float* tot = (LAS float*)(L + 106496); LAS float* el = (LAS float*)(L + 114688); LAS float* lbl = (LAS float*)(L + 115200); LAS float* plx = (LAS float*)(L + 115712);
    const bf16_t* proj = (const bf16_t*)(P.ws + OFF_PROJ); float* oraw = (float*)(P.ws + OFF_TCAT);
    const int lane = tid & 63, w = tid >> 6, kq = lane >> 4, lc = lane & 15, row0 = b * 2048;
    const bool isf = tid < 256; const int t2 = tid & 255, oct = t2 & 15, rg = t2 >> 4, k0 = oct * 8, s0 = rg * 4;
    const bool hasv = !isf && oct < 8;
    const int colA = (isf ? C_F : C_Q) + hd * 128 + k0, colV = C_I + hd * 128 + vh * 64 + k0;
    if (tid < 128) { float lb = 0.f; if (l > 0) { const float l0 = P.in[I_LB][hd * 128 + tid], l1 = P.in[I_LB][512 + hd * 128 + tid]; lb = 1.f / (1.f + expf(l0 - l1)); } lbl[tid] = lb; }
    for (int i = tid; i < 64 * PC / 2; i += NTH) ((LAS unsigned*)ST)[i] = 0u;
    f32x4 accS[4];
#pragma unroll
    for (int i = 0; i < 4; ++i) accS[i] = (f32x4){0.f, 0.f, 0.f, 0.f};
    u32x4 rawA[4], rawV[4];
#define HGM_LOAD(C) do { _Pragma("unroll") for (int r = 0; r < 4; ++r) { const size_t ro_ = (size_t)(row0 + (C) * 64 + s0 + r) * NPROJ; \
            rawA[r] = *(const u32x4*)(proj + ro_ + colA); if (hasv) rawV[r] = *(const u32x4*)(proj + ro_ + colV); } } while (0)
#define UNP(rr, j) (((j) & 1) ? bfhi(((j) >> 1) == 0 ? (rr).x : (((j) >> 1) == 1 ? (rr).y : (((j) >> 1) == 2 ? (rr).z : (rr).w))) : bflo(((j) >> 1) == 0 ? (rr).x : (((j) >> 1) == 1 ? (rr).y : (((j) >> 1) == 2 ? (rr).z : (rr).w))))
    HGM_LOAD(0);
    __syncthreads();
    for (int c = 0; c < 32; ++c) {
        int tl_ = tid; asm volatile("" : "+v"(tl_));
        const int lane = tl_ & 63, w = tl_ >> 6, kq = lane >> 4, lc = lane & 15;
        const bool isf = tl_ < 256; const int t2 = tl_ & 255, oct = t2 & 15, rg = t2 >> 4, k0 = oct * 8, s0 = rg * 4;
        const bool hasv = !isf && oct < 8;
        const int colA = (isf ? C_F : C_Q) + hd * 128 + k0, colV = C_I + hd * 128 + vh * 64 + k0;
        float pl[4][8], kk[4][8];
        if (isf) {
            const f32x4 la = *(const LAS f32x4*)(lbl + k0), lb4 = *(const LAS f32x4*)(lbl + k0 + 4);
            const float lbv[8] = {la[0], la[1], la[2], la[3], lb4[0], lb4[1], lb4[2], lb4[3]};
#pragma unroll
            for (int j = 0; j < 8; ++j) { float run = 0.f;
#pragma unroll
                for (int i = 0; i < 4; ++i) { const float z = UNP(rawA[i], j); const float t = __expf(-z), r = __builtin_amdgcn_rcpf(1.f + t);
                    const float f = lbv[j] + (1.f - lbv[j]) * r; kk[i][j] = (1.f - lbv[j]) * t * r; run += __logf(f); pl[i][j] = run; } }
            *(LAS f32x4*)(tot + rg * 128 + k0) = (f32x4){pl[3][0], pl[3][1], pl[3][2], pl[3][3]}; *(LAS f32x4*)(tot + rg * 128 + k0 + 4) = (f32x4){pl[3][4], pl[3][5], pl[3][6], pl[3][7]};
#pragma unroll
            for (int i = 0; i < 4; ++i) { *(LAS f32x4*)(plx + (s0 + i) * 128 + k0) = (f32x4){pl[i][0], pl[i][1], pl[i][2], pl[i][3]}; *(LAS f32x4*)(plx + (s0 + i) * 128 + k0 + 4) = (f32x4){pl[i][4], pl[i][5], pl[i][6], pl[i][7]}; }
        } else {
#pragma unroll
            for (int i = 0; i < 4; ++i)
#pragma unroll
                for (int j = 0; j < 8; ++j) { pl[i][j] = 0.f; kk[i][j] = 0.f; }
            if (hasv) {
#pragma unroll
                for (int j = 0; j < 8; ++j) { u32x2 q; q.x = cvt_pk_bf16(UNP(rawV[0], j), UNP(rawV[1], j)); q.y = cvt_pk_bf16(UNP(rawV[2], j), UNP(rawV[3], j)); *(LAS u32x2*)(VT + (k0 + j) * PT + s0) = q; } }
        }
        __syncthreads();
        { float base[8], ref[8], bl[8];
#pragma unroll
          for (int j = 0; j < 8; ++j) { base[j] = 0.f; ref[j] = 0.f; bl[j] = 0.f; }
#pragma unroll
          for (int r = 0; r < 16; ++r) { const f32x4 t0 = *(const LAS f32x4*)(tot + r * 128 + k0), t1 = *(const LAS f32x4*)(tot + r * 128 + k0 + 4);
              const float tv[8] = {t0[0], t0[1], t0[2], t0[3], t1[0], t1[1], t1[2], t1[3]};
#pragma unroll
              for (int j = 0; j < 8; ++j) { if (r < rg) base[j] += tv[j]; if (r < 8) ref[j] += tv[j]; bl[j] += tv[j]; } }
          if (isf) {
              float kt[4][8], kd[4][8];
#pragma unroll
              for (int j = 0; j < 8; ++j) { const float e1 = __expf(bl[j] - ref[j]);
#pragma unroll
                  for (int i = 0; i < 4; ++i) { kt[i][j] = kk[i][j] * __expf(ref[j] - (base[j] + pl[i][j])); kd[i][j] = kt[i][j] * e1; } }
#pragma unroll
              for (int i = 0; i < 4; ++i) *(LAS u32x4*)(Kt + (s0 + i) * PC + k0) = pack8(kt[i][0], kt[i][1], kt[i][2], kt[i][3], kt[i][4], kt[i][5], kt[i][6], kt[i][7]);
#pragma unroll
              for (int j = 0; j < 8; ++j) { u32x2 q; q.x = cvt_pk_bf16(kd[0][j], kd[1][j]); q.y = cvt_pk_bf16(kd[2][j], kd[3][j]); *(LAS u32x2*)(KdT + (k0 + j) * PT + s0) = q; }
              if (rg == 0) { *(LAS f32x4*)(el + k0) = (f32x4){__expf(bl[0]), __expf(bl[1]), __expf(bl[2]), __expf(bl[3])}; *(LAS f32x4*)(el + k0 + 4) = (f32x4){__expf(bl[4]), __expf(bl[5]), __expf(bl[6]), __expf(bl[7])}; }
          } else {
              float e2[8];
#pragma unroll
              for (int j = 0; j < 8; ++j) e2[j] = __expf(ref[j]);
#pragma unroll
              for (int i = 0; i < 4; ++i) { float qt[8], qs[8];
                  const f32x4 p0 = *(const LAS f32x4*)(plx + (s0 + i) * 128 + k0), p1 = *(const LAS f32x4*)(plx + (s0 + i) * 128 + k0 + 4);
                  const float pv[8] = {p0[0], p0[1], p0[2], p0[3], p1[0], p1[1], p1[2], p1[3]};
#pragma unroll
                  for (int j = 0; j < 8; ++j) { const float qv = UNP(rawA[i], j); qt[j] = qv * __expf(base[j] + pv[j] - ref[j]); qs[j] = qt[j] * e2[j]; }
                  *(LAS u32x4*)(Qt + (s0 + i) * PC + k0) = pack8(qt[0], qt[1], qt[2], qt[3], qt[4], qt[5], qt[6], qt[7]);
                  *(LAS u32x4*)(Qs + (s0 + i) * PC + k0) = pack8(qs[0], qs[1], qs[2], qs[3], qs[4], qs[5], qs[6], qs[7]); }
          } }
        __syncthreads();
        if (c + 1 < 32) HGM_LOAD(c + 1);
        f32x4 o2[2];
#pragma unroll
        for (int ti = 0; ti < 2; ++ti) { const int tile = 2 * w + ti, qi = tile >> 2, si = tile & 3;
            f32x4 acc = (f32x4){0.f, 0.f, 0.f, 0.f};
            if (si <= qi) acc = mma_rt<4>(Qt + qi * 16 * PC, PC, Kt + si * 16 * PC, PC, acc, lane);
            const int q0 = qi * 16 + kq * 4, s = si * 16 + lc;
#pragma unroll
            for (int j = 0; j < 4; ++j) Al[(q0 + j) * PT + s] = f2bf((s <= q0 + j) ? acc[j] : 0.f);
            o2[ti] = mma_rt<4>(Qs + qi * 16 * PC, PC, ST + si * 16 * PC, PC, (f32x4){0.f, 0.f, 0.f, 0.f}, lane);
        }
        __syncthreads();
#pragma unroll
        for (int ti = 0; ti < 2; ++ti) { const int tile = 2 * w + ti, qi = tile >> 2, vi = tile & 3;
            const f32x4 o1 = mma_rt<2>(Al + qi * 16 * PT, PT, VT + vi * 16 * PT, PT, o2[ti], lane);
            float* op = oraw + (size_t)(row0 + c * 64 + qi * 16 + kq * 4) * 512 + hd * 128 + vh * 64 + vi * 16 + lc;
#pragma unroll
            for (int j = 0; j < 4; ++j) op[(size_t)j * 512] = o1[j]; }
#pragma unroll
        for (int i = 0; i < 4; ++i) { const int tile = 4 * w + i, vi = tile >> 3, ki = tile & 7;
            const float dec = el[ki * 16 + lc];
            accS[i] = accS[i] * dec; accS[i] = mma_rt<2>(VT + vi * 16 * PT, PT, KdT + ki * 16 * PT, PT, accS[i], lane);
#pragma unroll
            for (int j = 0; j < 4; ++j) ST[(vi * 16 + kq * 4 + j) * PC + ki * 16 + lc] = f2bf(accS[i][j]); }
        __syncthreads();
    }
#undef HGM_LOAD
#undef UNP
    { int t2 = tid; asm volatile("" : "+v"(t2)); const int lane = t2 & 63, w = t2 >> 6, kq = lane >> 4, lc = lane & 15;
      float* sp = P.out + O_PHG + (size_t)((l * 8 + b) * 4 + hd) * 16384 + vh * 64;
#pragma unroll
      for (int i = 0; i < 4; ++i) { const int tile = 4 * w + i, vi = tile >> 3, ki = tile & 7;
#pragma unroll
          for (int j = 0; j < 4; ++j) sp[(size_t)(ki * 16 + lc) * 128 + vi * 16 + kq * 4 + j] = accS[i][j]; } }
    __syncthreads();
}

__device__ __forceinline__ void hg_norm(const Params& P, int l, int row0, int nrows, int hd, int tid) {
    const int sub = tid & 7, rg = tid >> 3;
    const bf16_t* proj = (const bf16_t*)(P.ws + OFF_PROJ); const float* oraw = (const float*)(P.ws + OFF_TCAT); bf16_t* Ahg = (bf16_t*)(P.ws + OFF_AHG);
    const float* nwp = P.in[I_HGNW] + l * 512 + hd * 128 + 16 * sub;
    f32x4 nw[4];
#pragma unroll
    for (int i = 0; i < 4; ++i) nw[i] = *(const f32x4*)(nwp + 4 * i);
    for (int r = rg; r < ((nrows + 63) & ~63); r += 64) { const int rr = r < nrows ? r : nrows - 1; const size_t row = (size_t)(row0 + rr);
        const float* op = oraw + row * 512 + hd * 128 + 16 * sub;
        f32x4 o[4]; float ss = 0.f;
#pragma unroll
        for (int i = 0; i < 4; ++i) { o[i] = *(const f32x4*)(op + 4 * i); ss += (o[i][0] * o[i][0] + o[i][1] * o[i][1]) + (o[i][2] * o[i][2] + o[i][3] * o[i][3]); }
        const u32x4 g0 = *(const u32x4*)(proj + row * NPROJ + C_G + hd * 128 + 16 * sub), g1 = *(const u32x4*)(proj + row * NPROJ + C_G + hd * 128 + 16 * sub + 8);
        ss = sum8(ss);
        const float rstd = 1.f / sqrtf(ss * (1.f / 128.f) + EPSN);
        u32x4 w0, w1;
        w0.x = cvt_pk_bf16(o[0][0] * rstd * nw[0][0] * silu(bflo(g0.x)), o[0][1] * rstd * nw[0][1] * silu(bfhi(g0.x)));
        w0.y = cvt_pk_bf16(o[0][2] * rstd * nw[0][2] * silu(bflo(g0.y)), o[0][3] * rstd * nw[0][3] * silu(bfhi(g0.y)));
        w0.z = cvt_pk_bf16(o[1][0] * rstd * nw[1][0] * silu(bflo(g0.z)), o[1][1] * rstd * nw[1][1] * silu(bfhi(g0.z)));
        w0.w = cvt_pk_bf16(o[1][2] * rstd * nw[1][2] * silu(bflo(g0.w)), o[1][3] * rstd * nw[1][3] * silu(bfhi(g0.w)));
        w1.x = cvt_pk_bf16(o[2][0] * rstd * nw[2][0] * silu(bflo(g1.x)), o[2][1] * rstd * nw[2][1] * silu(bfhi(g1.x)));
        w1.y = cvt_pk_bf16(o[2][2] * rstd * nw[2][2] * silu(bflo(g1.y)), o[2][3] * rstd * nw[2][3] * silu(bfhi(g1.y)));
        w1.z = cvt_pk_bf16(o[3][0] * rstd * nw[3][0] * silu(bflo(g1.z)), o[3][1] * rstd * nw[3][1] * silu(bfhi(g1.z)));
        w1.w = cvt_pk_bf16(o[3][2] * rstd * nw[3][2] * silu(bflo(g1.w)), o[3][3] * rstd * nw[3][3] * silu(bfhi(g1.w)));
        if (r < nrows) { *(u32x4*)(Ahg + row * 512 + hd * 128 + 16 * sub) = w0; *(u32x4*)(Ahg + row * 512 + hd * 128 + 16 * sub + 8) = w1; }
    }
}

__device__ __forceinline__ void s5_item(const Params& P, int l, bool prompt, int bq, int g, LAS unsigned char* L, int tid) {
    const int lane = tid & 63, w = tid >> 6, n = lane, jc = lane & 15, tq = lane >> 4;
    LAS float* us = (LAS float*)(L + w * 14336); LAS bf16_t* Xc = (LAS bf16_t*)(L + w * 14336 + 1024); LAS float* BUl = (LAS float*)(L + w * 14336 + 5376); LAS float* hl = (LAS float*)(L + 8 * 14336);
    const bf16_t* proj = (const bf16_t*)(P.ws + OFF_PROJ); bf16_t* Aglu = (bf16_t*)(P.ws + OFF_AGLU);
    const int lg = l * 32 + g;
    const float delta = expf(P.in[I_S5LDT][lg]), lr = P.in[I_S5LR][lg * 64 + n], li = P.in[I_S5LI][lg * 64 + n];
    const float mag = expf(lr * delta), ab_re = mag * cosf(li * delta), ab_im = mag * sinf(li * delta);
    const float den = lr * lr + li * li, nr = ab_re - 1.f, co_re = (nr * lr + ab_im * li) / den, co_im = (ab_im * lr - nr * li) / den;
    bf16x8 Bu[8];
#pragma unroll
    for (int tile = 0; tile < 4; ++tile) { const int nn = tile * 16 + jc; const float cr = __shfl(co_re, nn), ci = __shfl(co_im, nn);
        u32x4 pr = (u32x4){0u, 0u, 0u, 0u}, pi = (u32x4){0u, 0u, 0u, 0u};
        if (tq < 2) { const f32x4* br4 = (const f32x4*)(P.in[I_S5BR] + ((size_t)lg * 64 + nn) * 16 + tq * 8); const f32x4* bi4 = (const f32x4*)(P.in[I_S5BI] + ((size_t)lg * 64 + nn) * 16 + tq * 8);
            const f32x4 a0 = br4[0], a1 = br4[1], c0 = bi4[0], c1 = bi4[1];
            pr = pack8(cr * a0[0] - ci * c0[0], cr * a0[1] - ci * c0[1], cr * a0[2] - ci * c0[2], cr * a0[3] - ci * c0[3], cr * a1[0] - ci * c1[0], cr * a1[1] - ci * c1[1], cr * a1[2] - ci * c1[2], cr * a1[3] - ci * c1[3]);
            pi = pack8(cr * c0[0] + ci * a0[0], cr * c0[1] + ci * a0[1], cr * c0[2] + ci * a0[2], cr * c0[3] + ci * a0[3], cr * c1[0] + ci * a1[0], cr * c1[1] + ci * a1[1], cr * c1[2] + ci * a1[2], cr * c1[3] + ci * a1[3]); }
        Bu[tile] = __builtin_bit_cast(bf16x8, pr); Bu[4 + tile] = __builtin_bit_cast(bf16x8, pi); }
    bf16x8 Breg[4];
    { const float* cr = P.in[I_S5CR] + ((size_t)lg * 16 + jc) * 64; const float* ci = P.in[I_S5CI] + ((size_t)lg * 16 + jc) * 64;
#pragma unroll
      for (int kt = 0; kt < 4; ++kt) { const float* src = (kt < 2 ? cr : ci) + (kt & 1) * 32 + tq * 8; const float sg = kt < 2 ? 1.f : -1.f;
          const f32x4 a = *(const f32x4*)src, c = *(const f32x4*)(src + 4);
          Breg[kt] = __builtin_bit_cast(bf16x8, pack8(sg * a[0], sg * a[1], sg * a[2], sg * a[3], sg * c[0], sg * c[1], sg * c[2], sg * c[3])); } }
    const float dj = P.in[I_S5D][l * 512 + g * 16 + jc];
    const int b = prompt ? bq : bq * 8 + w;
    const int rowseg = prompt ? b * 2048 + w * 256 : MP + b * 4;
    const int nchunk = prompt ? 16 : 1, clen = prompt ? 16 : 4;
    const int tA = jc < clen ? jc : clen - 1;
#define S5_LDA(CH) ((tq < 2) ? *(const u32x4*)(proj + (size_t)(rowseg + (CH) * 16 + tA) * NPROJ + C_U + g * 16 + tq * 8) : (u32x4){0u, 0u, 0u, 0u})
#define S5_BU(AF) do { const bf16x8 a_ = __builtin_bit_cast(bf16x8, (AF)); _Pragma("unroll") for (int tile = 0; tile < 8; ++tile) { \
        const f32x4 d_ = __builtin_amdgcn_mfma_f32_16x16x32_bf16(a_, Bu[tile], (f32x4){0.f, 0.f, 0.f, 0.f}, 0, 0, 0); \
        _Pragma("unroll") for (int j = 0; j < 4; ++j) BUl[(tq * 4 + j) * 132 + tile * 16 + jc] = d_[j]; } } while (0)
    float xr = 0.f, xi = 0.f;
    if (prompt) {
        u32x4 af = S5_LDA(0);
        for (int ch = 0; ch < nchunk; ++ch) {
            S5_BU(af);
            __syncthreads();
            if (ch + 1 < nchunk) af = S5_LDA(ch + 1);
            for (int tt = 0; tt < 16; ++tt) { const float bur = BUl[tt * 132 + n], bui = BUl[tt * 132 + 64 + n];
                const float nxr = ab_re * xr - ab_im * xi + bur, nxi = ab_re * xi + ab_im * xr + bui; xr = nxr; xi = nxi; }
            __syncthreads();
        }
        hl[(w * 64 + n) * 2] = xr; hl[(w * 64 + n) * 2 + 1] = xi;
        float pr_ = ab_re, pi_ = ab_im;
#pragma unroll
        for (int q = 0; q < 8; ++q) { const float a = pr_ * pr_ - pi_ * pi_, c = 2.f * pr_ * pi_; pr_ = a; pi_ = c; }
        __syncthreads();
        xr = 0.f; xi = 0.f;
        for (int ww = 0; ww < w; ++ww) { const float hr = hl[(ww * 64 + n) * 2], hi = hl[(ww * 64 + n) * 2 + 1]; const float a = pr_ * xr - pi_ * xi + hr, c = pr_ * xi + pi_ * xr + hi; xr = a; xi = c; }
    } else { xr = P.in[I_S5R][((size_t)(l * 128 + b) * 32 + g) * 64 + n]; xi = P.in[I_S5I][((size_t)(l * 128 + b) * 32 + g) * 64 + n]; }
    u32x2 uu2; { const int t = (lane >> 2) < clen ? (lane >> 2) : clen - 1; uu2 = *(const u32x2*)(proj + (size_t)(rowseg + t) * NPROJ + C_U + g * 16 + (lane & 3) * 4); }
    u32x4 af2 = S5_LDA(0);
    for (int ch = 0; ch < nchunk; ++ch) {
        { const int t = lane >> 2, q4 = lane & 3;
          *(LAS f32x4*)(us + t * 16 + q4 * 4) = (f32x4){bflo(uu2.x), bfhi(uu2.x), bflo(uu2.y), bfhi(uu2.y)}; }
        S5_BU(af2);
        __syncthreads();
        if (ch + 1 < nchunk) { uu2 = *(const u32x2*)(proj + (size_t)(rowseg + (ch + 1) * 16 + (lane >> 2)) * NPROJ + C_U + g * 16 + (lane & 3) * 4); af2 = S5_LDA(ch + 1); }
        for (int tt = 0; tt < clen; ++tt) { const float bur = BUl[tt * 132 + n], bui = BUl[tt * 132 + 64 + n];
            const float nxr = ab_re * xr - ab_im * xi + bur, nxi = ab_re * xi + ab_im * xr + bui; xr = nxr; xi = nxi;
            Xc[tt * 136 + n] = f2bf(xr); Xc[tt * 136 + 64 + n] = f2bf(xi); }
        __syncthreads();
        f32x4 acc = (f32x4){0.f, 0.f, 0.f, 0.f};
#pragma unroll
        for (int kt = 0; kt < 4; ++kt) { const bf16x8 a = *(const LAS bf16x8*)(Xc + jc * 136 + kt * 32 + tq * 8); acc = __builtin_amdgcn_mfma_f32_16x16x32_bf16(a, Breg[kt], acc, 0, 0, 0); }
#pragma unroll
        for (int j = 0; j < 4; ++j) { const int t = tq * 4 + j;
            if (t < clen) { const float y = acc[j] + dj * us[t * 16 + jc]; Aglu[(size_t)(rowseg + ch * 16 + t) * 512 + g * 16 + jc] = f2bf(gelu_tanh(y)); } }
        __syncthreads();
    }
#undef S5_LDA
#undef S5_BU
    if (prompt) { if (w == 7) { P.out[O_PS5R + ((size_t)(l * 8 + b) * 32 + g) * 64 + n] = xr; P.out[O_PS5I + ((size_t)(l * 8 + b) * 32 + g) * 64 + n] = xi; } }
    else { P.out[O_SS5R + ((size_t)(l * 128 + b) * 32 + g) * 64 + n] = xr; P.out[O_SS5I + ((size_t)(l * 128 + b) * 32 + g) * 64 + n] = xi; }
}

__device__ __forceinline__ void convstate_item(const Params& P, int l, int sq, int tid) {
    const bf16_t* proj = (const bf16_t*)(P.ws + OFF_PROJ);
    const bool pr = sq < 8; const int b = pr ? sq : sq - 8;
    const int rbase = pr ? b * 2048 + 2045 : MP + b * 4 + 1;
    float* dst = P.out + (pr ? O_PSSDC + (size_t)(l * 8 + b) * 3 * 2048 : O_SSSDC + (size_t)(l * 128 + b) * 3 * 2048);
    for (int e = tid; e < 768; e += NTH) { const int j = e >> 8, oc = e & 255;
        const u32x4 v = *(const u32x4*)(proj + (size_t)(rbase + j) * NPROJ + C_XBC + oc * 8);
        *(f32x4*)(dst + j * 2048 + oc * 8) = (f32x4){bflo(v.x), bfhi(v.x), bflo(v.y), bfhi(v.y)};
        *(f32x4*)(dst + j * 2048 + oc * 8 + 4) = (f32x4){bflo(v.z), bfhi(v.z), bflo(v.w), bfhi(v.w)}; }
}

constexpr int IT_SSDP = 128, IT_HGP = 64, IT_S5P = 256, IT_SSDS = 512, IT_HGS = 512, IT_S5S = 512, IT_CS = 136, IT_HGN = 128;
constexpr int IT_TOTAL = IT_SSDP + IT_HGP + IT_S5P + IT_SSDS + IT_HGS + IT_S5S + IT_CS + IT_HGN;
__device__ __forceinline__ void mix_phase(const Params& P, int l, LAS unsigned char* L, int tid_in, int rep = 0, int lo = 0, int hi = 1 << 30) {
    int tid = tid_in;
    unsigned* ctl = (unsigned*)(P.ws + OFF_CTL);
    volatile LAS int* misc = (volatile LAS int*)(L + MISC_OFF);
    for (;;) {
        if (tid == 0) misc[0] = (int)atomicAdd(ctl + l + 2 * rep, 1u);
        __syncthreads();
        int it = misc[0] + lo;
        __syncthreads();
        if (it >= IT_TOTAL || it >= hi) break;
        asm volatile("" : "+v"(tid));
        if (it < IT_SSDP) { ssd_mfma_item(P, l, it >> 4, it & 15, L, tid); continue; } it -= IT_SSDP;
        if (it < IT_HGP) { const int b = it >> 3, hd = (it >> 1) & 3, vh = it & 1;
            hg_mfma_half(P, l, b, hd, vh, L, tid);
            asm volatile("s_waitcnt vmcnt(0)" ::: "memory"); __syncthreads();
            if (tid == 0) { __builtin_amdgcn_fence(__ATOMIC_RELEASE, "agent"); asm volatile("s_waitcnt vmcnt(0)" ::: "memory"); (void)atomicAdd(ctl + 16 + rep * 64 + l * 32 + b * 4 + hd, 1u); }
            continue; } it -= IT_HGP;
        if (it < IT_S5P) { s5_item(P, l, true, it >> 5, it & 31, L, tid); continue; } it -= IT_S5P;
        if (it < IT_SSDS) { ssd_s4_item(P, l, it >> 2, it & 3, L, tid); continue; } it -= IT_SSDS;
        if (it < IT_HGS) { const int b = it >> 2, hd = it & 3;
            hg_half(P, l, false, b, hd, 0, L, tid); hg_half(P, l, false, b, hd, 1, L, tid);
            asm volatile("s_waitcnt vmcnt(0)" ::: "memory"); __syncthreads();
            hg_norm(P, l, MP + b * 4, 4, hd, tid);
            continue; } it -= IT_HGS;
        if (it < IT_S5S) { s5_item(P, l, false, it >> 5, it & 31, L, tid); continue; } it -= IT_S5S;
        if (it < IT_CS) { convstate_item(P, l, it, tid); continue; } it -= IT_CS;
        { const int bh = it >> 2, rq = it & 3;
          if (tid == 0) { unsigned* c = ctl + 16 + rep * 64 + l * 32 + bh; unsigned sp = 0;
              while (__hip_atomic_load(c, __ATOMIC_RELAXED, __HIP_MEMORY_SCOPE_AGENT) < 2u && ++sp < (1u << 24)) __builtin_amdgcn_s_sleep(8); }
          __syncthreads();
          __builtin_amdgcn_fence(__ATOMIC_ACQUIRE, "agent"); asm volatile("s_waitcnt vmcnt(0)" ::: "memory");
          hg_norm(P, l, (bh >> 2) * 2048 + rq * 512, 512, bh & 3, tid); }
    }
}

__device__ __forceinline__ void small_res_gemm(const bf16_t* A, const bf16_t* Bt, int K, const Params& P, int from_in, int tid, int bid) {
    const int lane = tid & 63, w = tid >> 6, kq = lane >> 4, lc = lane & 15;
    for (int t = bid; t < 256; t += gridDim.x) {
        const int rt = t >> 4, ct = t & 15, r0 = MP + rt * 32 + (w >> 2) * 16, c0 = ct * 64 + (w & 3) * 16;
        const bf16_t* ap = A + (size_t)(r0 + lc) * K + kq * 8; const bf16_t* bp = Bt + (size_t)(c0 + lc) * K + kq * 8;
        f32x4 acc = (f32x4){0.f, 0.f, 0.f, 0.f};
        { bf16x8 a0[8], b0[8], a1[8], b1[8]; const int nb = K >> 8;
#define SG_LD(AX, BX, I) do { _Pragma("unroll") for (int i_ = 0; i_ < 8; ++i_) { AX[i_] = *(const bf16x8*)(ap + (I) * 256 + i_ * 32); BX[i_] = *(const bf16x8*)(bp + (I) * 256 + i_ * 32); } } while (0)
#define SG_MM(AX, BX) do { _Pragma("unroll") for (int i_ = 0; i_ < 8; ++i_) acc = __builtin_amdgcn_mfma_f32_16x16x32_bf16(AX[i_], BX[i_], acc, 0, 0, 0); } while (0)
          SG_LD(a0, b0, 0);
          for (int i = 0; i < nb; i += 2) {
              if (i + 1 < nb) SG_LD(a1, b1, i + 1);
              SG_MM(a0, b0);
              if (i + 2 < nb) SG_LD(a0, b0, i + 2);
              if (i + 1 < nb) SG_MM(a1, b1);
          }
#undef SG_LD
#undef SG_MM
        }
#pragma unroll
        for (int j = 0; j < 4; ++j) { const int r = r0 + kq * 4 + j, c = c0 + lc;
            const float base = from_in ? P.in[I_XS][(size_t)(r - MP) * DM + c] : P.out[(size_t)r * DM + c];
            P.out[(size_t)r * DM + c] = base + acc[j]; }
    }
}

template <int MODE>
__device__ __forceinline__ void small_sg_gemm(const bf16_t* A, const bf16_t* Bt, int K, const Params& P, int tid, int bid) {
    const int lane = tid & 63, w = tid >> 6, kq = lane >> 4, lc = lane & 15;
    for (int t = bid; t < 256; t += gridDim.x) {
        const int rt = t >> 4, ct = t & 15, r0 = MP + rt * 32 + (w >> 2) * 16, c0 = ct * 64 + (w & 3) * 16;
        const bf16_t* ap = A + (size_t)(r0 + lc) * K + kq * 8; const bf16_t* bp = Bt + (size_t)(c0 + lc) * K + kq * 8;
        f32x4 acc = (f32x4){0.f, 0.f, 0.f, 0.f};
        { bf16x8 a0[8], b0[8], a1[8], b1[8]; const int nb = K >> 8;
#define SG_LD(AX, BX, I) do { _Pragma("unroll") for (int i_ = 0; i_ < 8; ++i_) { AX[i_] = *(const bf16x8*)(ap + (I) * 256 + i_ * 32); BX[i_] = *(const bf16x8*)(bp + (I) * 256 + i_ * 32); } } while (0)
#define SG_MM(AX, BX) do { _Pragma("unroll") for (int i_ = 0; i_ < 8; ++i_) acc = __builtin_amdgcn_mfma_f32_16x16x32_bf16(AX[i_], BX[i_], acc, 0, 0, 0); } while (0)
          SG_LD(a0, b0, 0);
          for (int i = 0; i < nb; i += 2) {
              if (i + 1 < nb) SG_LD(a1, b1, i + 1);
              SG_MM(a0, b0);
              if (i + 2 < nb) SG_LD(a0, b0, i + 2);
              if (i + 1 < nb) SG_MM(a1, b1);
          }
#undef SG_LD
#undef SG_MM
        }
#pragma unroll
        for (int j = 0; j < 4; ++j) { const int r = r0 + kq * 4 + j, c = c0 + lc;
            const bf16_t* proj = (const bf16_t*)(P.ws + OFF_PROJ); bf16_t* mp = (bf16_t*)(P.ws + OFF_TCAT) + (size_t)r * 1024 + c;
            float val = sigm(bf2f(proj[(size_t)r * NPROJ + C_GATE + MODE * 1024 + c])) * acc[j];
            if (MODE == 1) { const f32x4* sp = (const f32x4*)((const float*)(P.ws + OFF_SSQ) + (size_t)r * 16); const f32x4 s0 = sp[0], s1 = sp[1], s2 = sp[2], s3 = sp[3];
                const float tot = ((s0[0] + s0[1]) + (s0[2] + s0[3])) + ((s1[0] + s1[1]) + (s1[2] + s1[3])) + ((s2[0] + s2[1]) + (s2[2] + s2[3])) + ((s3[0] + s3[1]) + (s3[2] + s3[3]));
                val *= 1.f / sqrtf(tot * (1.f / 1024.f) + EPSN); *mp = f2bf(val); }
            else *mp = f2bf(bf2f(*mp) + val); }
    }
}

__device__ __forceinline__ void small_g1_tail(const bf16_t* A, const bf16_t* Bt, bf16_t* proj, int tid, int bid) {
    const int lane = tid & 63, w = tid >> 6, kq = lane >> 4, lc = lane & 15;
    const bf16_t* bp = Bt + (size_t)(8704 + lc) * 1024 + kq * 8;
    for (int t = bid * 8 + w; t < MT / 16; t += gridDim.x * 8) {
        const bf16_t* ap = A + (size_t)(t * 16 + lc) * 1024 + kq * 8;
        f32x4 acc = (f32x4){0.f, 0.f, 0.f, 0.f};
        bf16x8 a0[8], b0[8], a1[8], b1[8];
#define SG_LD(AX, BX, I) do { _Pragma("unroll") for (int i_ = 0; i_ < 8; ++i_) { AX[i_] = *(const bf16x8*)(ap + (I) * 256 + i_ * 32); BX[i_] = *(const bf16x8*)(bp + (I) * 256 + i_ * 32); } } while (0)
#define SG_MM(AX, BX) do { _Pragma("unroll") for (int i_ = 0; i_ < 8; ++i_) acc = __builtin_amdgcn_mfma_f32_16x16x32_bf16(AX[i_], BX[i_], acc, 0, 0, 0); } while (0)
        SG_LD(a0, b0, 0); SG_LD(a1, b1, 1); SG_MM(a0, b0); SG_LD(a0, b0, 2); SG_MM(a1, b1); SG_LD(a1, b1, 3); SG_MM(a0, b0); SG_MM(a1, b1);
#undef SG_LD
#undef SG_MM
#pragma unroll
        for (int j = 0; j < 4; ++j) proj[(size_t)(t * 16 + kq * 4 + j) * NPROJ + 8704 + lc] = f2bf(acc[j]);
    }
}

template <int MODE>
__device__ __forceinline__ void small_gemm_ks(const bf16_t* A, const bf16_t* Bt, const int K, const Params& P, int from_in, LAS unsigned char* L, int tid, int bid) {
    const int lane = tid & 63, w = tid >> 6, kq = lane >> 4, lc = lane & 15;
    LAS float* red = (LAS float*)L;
    const int ks = K >> 3, nst = ks >> 5;
    for (int t = bid; t < 256; t += gridDim.x) {
        const int rbase = MP + (t >> 4) * 32, cbase = (t & 15) * 64;
        const bf16_t* ap = A + (size_t)(rbase + lc) * K + w * ks + kq * 8; const bf16_t* bp = Bt + (size_t)(cbase + lc) * K + w * ks + kq * 8;
        f32x4 acc[2][4];
#pragma unroll
        for (int i = 0; i < 2; ++i)
#pragma unroll
            for (int j = 0; j < 4; ++j) acc[i][j] = (f32x4){0.f, 0.f, 0.f, 0.f};
        for (int s0 = 0; s0 < nst; s0 += 6) {
            bf16x8 a[6][2], b[6][4];
#pragma unroll
            for (int i = 0; i < 6; ++i) if (s0 + i < nst) {
#pragma unroll
                for (int r = 0; r < 2; ++r) a[i][r] = *(const bf16x8*)(ap + (size_t)r * 16 * K + (s0 + i) * 32);
#pragma unroll
                for (int c = 0; c < 4; ++c) b[i][c] = *(const bf16x8*)(bp + (size_t)c * 16 * K + (s0 + i) * 32); }
#pragma unroll
            for (int i = 0; i < 6; ++i) if (s0 + i < nst) {
#pragma unroll
                for (int r = 0; r < 2; ++r)
#pragma unroll
                    for (int c = 0; c < 4; ++c) acc[r][c] = __builtin_amdgcn_mfma_f32_16x16x32_bf16(a[i][r], b[i][c], acc[r][c], 0, 0, 0); }
        }
#pragma unroll
        for (int r = 0; r < 2; ++r)
#pragma unroll
            for (int c = 0; c < 4; ++c) *(LAS f32x4*)(red + ((w * 8 + r * 4 + c) * 64 + lane) * 4) = acc[r][c];
        __syncthreads();
        f32x4 sum = (f32x4){0.f, 0.f, 0.f, 0.f};
#pragma unroll
        for (int ww = 0; ww < 8; ++ww) sum += *(const LAS f32x4*)(red + ((ww * 8 + w) * 64 + lane) * 4);
        const int r0 = rbase + (w >> 2) * 16, c0 = cbase + (w & 3) * 16;
#pragma unroll
        for (int j = 0; j < 4; ++j) { const int r = r0 + kq * 4 + j, c = c0 + lc;
            if (MODE == 0) { const float base = from_in ? P.in[I_XS][(size_t)(r - MP) * DM + c] : P.out[(size_t)r * DM + c]; P.out[(size_t)r * DM + c] = base + sum[j]; }
            else { const bf16_t* proj = (const bf16_t*)(P.ws + OFF_PROJ); bf16_t* mp = (bf16_t*)(P.ws + OFF_TCAT) + (size_t)r * 1024 + c;
                float val = sigm(bf2f(proj[(size_t)r * NPROJ + C_GATE + MODE * 1024 + c])) * sum[j];
                if (MODE == 1) { const f32x4* sp = (const f32x4*)((const float*)(P.ws + OFF_SSQ) + (size_t)r * 16); const f32x4 s0 = sp[0], s1 = sp[1], s2 = sp[2], s3 = sp[3];
                    const float tot = ((s0[0] + s0[1]) + (s0[2] + s0[3])) + ((s1[0] + s1[1]) + (s1[2] + s1[3])) + ((s2[0] + s2[1]) + (s2[2] + s2[3])) + ((s3[0] + s3[1]) + (s3[2] + s3[3]));
                    val *= 1.f / sqrtf(tot * (1.f / 1024.f) + EPSN); *mp = f2bf(val); }
                else *mp = f2bf(bf2f(*mp) + val); } }
        __syncthreads();
    }
}

#define XB_TMO      128
#define XB_XCNT(j)  (256  + 64 * (j))
#define XB_XSUB(j)  (1280 + 64 * (j))
#define XB_XGEN(j)  (2304 + 64 * (j))
#define XB_TOP      3328
#define XB_TOPGEN   3392
#define XCD_BAR_WORDS 3456
#define XB_SPIN_CAP (1u << 18)
__device__ __forceinline__ unsigned xb_ld(unsigned* p)              { return __hip_atomic_load(p, __ATOMIC_RELAXED, __HIP_MEMORY_SCOPE_AGENT); }
__device__ __forceinline__ unsigned xb_add(unsigned* p, unsigned v) { return __hip_atomic_fetch_add(p, v, __ATOMIC_RELAXED, __HIP_MEMORY_SCOPE_AGENT); }
__device__ __forceinline__ unsigned xb_xcc_id() { return (unsigned)__builtin_amdgcn_s_getreg((3 << 11) | 20) & 0xFu; }
#define XB_SPIN(cond, bar) do { unsigned _sp = 0; while (cond) { __builtin_amdgcn_s_sleep(1); \
    if ((++_sp & 255u) == 0u) { if (xb_ld(&(bar)[XB_TMO])) break; if (_sp > XB_SPIN_CAP) { atomicAdd(&(bar)[XB_TMO], 1u); break; } } } } while (0)
__device__ __forceinline__ void xcd_barrier_post(unsigned* bar, int tid) { if (tid == 0) (void)xb_add(&bar[XB_XCNT(xb_xcc_id())], 1u); }
__device__ __forceinline__ void xcd_barrier_complete(unsigned* bar, unsigned x, unsigned& nloc, unsigned& nx) {
    const unsigned G = gridDim.x;
    unsigned sum, cnt, mine, sp = 0u;
    for (;;) {
        sum = 0u; cnt = 0u; mine = 0u;
#pragma unroll
        for (unsigned j = 0; j < 16; ++j) { const unsigned c = xb_ld(&bar[XB_XCNT(j)]); sum += c; cnt += (c > 0u) ? 1u : 0u; mine = (j == x) ? c : mine; }
        if (sum == G) break;
        __builtin_amdgcn_s_sleep(1);
        if ((++sp & 255u) == 0u) { if (xb_ld(&bar[XB_TMO])) break; if (sp > XB_SPIN_CAP) { atomicAdd(&bar[XB_TMO], 1u); break; } }
    }
    nloc = mine > 0u ? mine : 1u; nx = cnt > 0u ? cnt : 1u;
}
__device__ __forceinline__ void xcd_barrier(unsigned* bar, volatile LAS unsigned* st, int tid) {
    asm volatile("s_waitcnt vmcnt(0)" ::: "memory");
    __syncthreads();
    if (tid == 0) {
        const unsigned x = xb_xcc_id();
        __builtin_amdgcn_s_waitcnt(0);
        unsigned nloc = st[0], nx = st[1];
        if (nloc == 0u) { xcd_barrier_complete(bar, x, nloc, nx); st[0] = nloc; st[1] = nx; }
        const unsigned old = xb_add(&bar[XB_XSUB(x)], 1u);
        const unsigned gen = old / nloc;
        if (old + 1u == (gen + 1u) * nloc) {
            __builtin_amdgcn_fence(__ATOMIC_RELEASE, "agent");
            asm volatile("s_waitcnt vmcnt(0)" ::: "memory");
            const unsigned og = xb_add(&bar[XB_TOP], 1u);
            const unsigned tg = og / nx;
            if (og + 1u == (tg + 1u) * nx) xb_add(&bar[XB_TOPGEN], 1u);
            else XB_SPIN(xb_ld(&bar[XB_TOPGEN]) == tg, bar);
            __builtin_amdgcn_fence(__ATOMIC_ACQUIRE, "agent");
            xb_add(&bar[XB_XGEN(x)], 1u);
            asm volatile("s_waitcnt vmcnt(0)" ::: "memory");
        } else {
            XB_SPIN(xb_ld(&bar[XB_XGEN(x)]) == gen, bar);
            __builtin_amdgcn_fence(__ATOMIC_ACQUIRE, "agent");
            asm volatile("s_waitcnt vmcnt(0)" ::: "memory");
        }
    }
    __syncthreads();
}

__global__ void __launch_bounds__(NTH, 2) mega(Params P) {
    extern __shared__ __attribute__((aligned(16))) unsigned char lds_raw[];
    LAS unsigned char* L = (LAS unsigned char*)lds_raw;
    cg::grid_group grid = cg::this_grid();
    const int G = gridDim.x;
    const int wave_s = __builtin_amdgcn_readfirstlane((int)threadIdx.x >> 6);
#define TIDL() ({ int ln_; asm volatile("v_mbcnt_lo_u32_b32 %0, -1, 0\n\tv_mbcnt_hi_u32_b32 %0, -1, %0" : "=v"(ln_)); int t_ = wave_s * 64 + ln_; t_; })
#define BIDL() ({ int b_ = blockIdx.x; asm volatile("" : "+s"(b_)); b_; })
    const int tid0 = TIDL();
    unsigned char* ws = P.ws;
    unsigned* barw = (unsigned*)(ws + OFF_BAR);
    volatile LAS unsigned* xst = (volatile LAS unsigned*)(L + MISC_OFF + 16);
    if (tid0 == 0) { xst[0] = 0u; xst[1] = 0u; }
    __syncthreads();
    xcd_barrier_post(barw, tid0);
    if (ws == nullptr) grid.sync();
#define GSYNC() xcd_barrier(barw, xst, TIDL())
#ifndef DUP
#define DUP 0
#endif
#pragma unroll 1
    for (int l = 0; l < 2; ++l) {
        convert_weights(P, l, L, TIDL());
        if (DUP & 4) convert_weights(P, l, L, TIDL());
        norm_rows_bf16(P, l == 0, P.in[I_N1W] + l * 1024, (bf16_t*)(ws + OFF_XN), TIDL());
        GSYNC();
        small_g1_tail((const bf16_t*)(ws + OFF_XN), (const bf16_t*)(ws + W_IN), (bf16_t*)(ws + OFF_PROJ), TIDL(), BIDL());
        { Gemm g{(const bf16_t*)(ws + OFF_XN), (const bf16_t*)(ws + W_IN), MT, 8704, 1024}; StaticOrder S; S.init(MT, 8704, G, BIDL());
          EpiStoreBf16 E{(bf16_t*)(ws + OFF_PROJ), NPROJ}; gemm_phase(L, g, S, E, TIDL()); if (DUP & 2) gemm_phase(L, g, S, E, TIDL()); }
        GSYNC();
        mix_phase(P, l, L, TIDL());
        GSYNC();
        if (DUP & 1) { mix_phase(P, l, L, TIDL(), 1); GSYNC(); }
        if (DUP & 64) { mix_phase(P, l, L, TIDL(), 1, IT_SSDP + IT_HGP, IT_SSDP + IT_HGP + IT_S5P); GSYNC(); }
        if (DUP & 1024) { mix_phase(P, l, L, TIDL(), 1, 0, IT_SSDP); GSYNC(); }
        if (DUP & 2048) { mix_phase(P, l, L, TIDL(), 1, IT_SSDP, IT_SSDP + IT_HGP); GSYNC(); }
        if (DUP & 128) { mix_phase(P, l, L, TIDL(), 1, IT_SSDP + IT_HGP + IT_S5P, IT_TOTAL); GSYNC(); }
        small_gemm_ks<1>((const bf16_t*)(ws + OFF_XN), (const bf16_t*)(ws + W_SSD), 1024, P, 0, L, TIDL(), BIDL());
        { Gemm g{(const bf16_t*)(ws + OFF_XN), (const bf16_t*)(ws + W_SSD), MP, 1024, 1024}; StaticOrder S; S.init(MP, 1024, G, BIDL());
          EpiSG<true, false> E{(const bf16_t*)(ws + OFF_PROJ), (bf16_t*)(ws + OFF_TCAT), (const float*)(ws + OFF_SSQ), 1}; gemm_phase(L, g, S, E, TIDL()); }
        GSYNC();
        { Gemm g{(const bf16_t*)(ws + OFF_AGLU), (const bf16_t*)(ws + W_GLU), MT, 2048, 512}; StaticOrder S; S.init(MT, 2048, G, BIDL());
          EpiGlu E{(const bf16_t*)(ws + OFF_PROJ), (bf16_t*)(ws + OFF_TCAT)}; gemm_phase(L, g, S, E, TIDL()); }
        GSYNC();
        small_gemm_ks<2>((const bf16_t*)(ws + OFF_AHG), (const bf16_t*)(ws + W_HG), 512, P, 0, L, TIDL(), BIDL());
        { Gemm g{(const bf16_t*)(ws + OFF_AHG), (const bf16_t*)(ws + W_HG), MP, 1024, 512}; StaticOrder S; S.init(MP, 1024, G, BIDL());
          EpiSG<false, true> E{(const bf16_t*)(ws + OFF_PROJ), (bf16_t*)(ws + OFF_TCAT), nullptr, 2}; gemm_phase(L, g, S, E, TIDL()); }
        GSYNC();
        small_gemm_ks<0>((const bf16_t*)(ws + OFF_TCAT), (const bf16_t*)(ws + W_O3), 1024, P, l == 0, L, TIDL(), BIDL());
        { Gemm g{(const bf16_t*)(ws + OFF_TCAT), (const bf16_t*)(ws + W_O3), MP, 1024, 1024}; StaticOrder S; S.init(MP, 1024, G, BIDL());
          EpiRes E{P.in[I_XP], P.in[I_XS], P.out, l == 0}; gemm_phase(L, g, S, E, TIDL()); }
        GSYNC();
        norm_rows_bf16(P, 0, P.in[I_N2W] + l * 1024, (bf16_t*)(ws + OFF_XN), TIDL());
        GSYNC();
        { Gemm g{(const bf16_t*)(ws + OFF_XN), (const bf16_t*)(ws + W_UP), MT, NUP, 1024}; StaticOrder S; S.init(MT, NUP, G, BIDL());
          EpiStoreBf16 E{(bf16_t*)(ws + OFF_PROJ), NUP}; gemm_phase(L, g, S, E, TIDL()); if (DUP & 8) gemm_phase(L, g, S, E, TIDL()); }
        GSYNC();
        ffn_conv_phase(P, l, TIDL());
        if (DUP & 32) ffn_conv_phase(P, l, TIDL());
        if (DUP & 512) { for (int q_ = 0; q_ < 10; ++q_) GSYNC(); }
        if (DUP & 256) norm_rows_bf16(P, 0, P.in[I_N2W] + l * 1024, (bf16_t*)(ws + OFF_AGLU), TIDL());
        GSYNC();
        small_gemm_ks<0>((const bf16_t*)(ws + OFF_TCAT), (const bf16_t*)(ws + W_DN), DFF, P, 0, L, TIDL(), BIDL());
        { Gemm g{(const bf16_t*)(ws + OFF_TCAT), (const bf16_t*)(ws + W_DN), MP, 1024, DFF}; StaticOrder S; S.init(MP, 1024, G, BIDL());
          EpiRes E{P.in[I_XP], P.in[I_XS], P.out, 0}; gemm_phase(L, g, S, E, TIDL()); }
        GSYNC();
    }
    final_norm(P, TIDL());
}

extern "C" void kernel_launch(void* const* d_in, const int* in_sizes, int n_in, void* d_out, int out_size, void* d_ws, size_t ws_size, hipStream_t stream) {
    static int grid_blocks = 0;
    if (grid_blocks == 0) {
        if (n_in != 36 || ws_size < WS_END) { fprintf(stderr, "kernel_launch: unexpected n_in %d / ws_size %zu\n", n_in, ws_size); grid_blocks = -1; return; }
        int dev = 0, cus = 0, per_cu = 0;
        hipGetDevice(&dev);
        hipDeviceGetAttribute(&cus, hipDeviceAttributeMultiprocessorCount, dev);
        hipFuncSetAttribute((const void*)mega, hipFuncAttributeMaxDynamicSharedMemorySize, LDS_BYTES);
        hipOccupancyMaxActiveBlocksPerMultiprocessor(&per_cu, (const void*)mega, NTH, LDS_BYTES);
        if (per_cu < 1) per_cu = 1;
        grid_blocks = cus * 1;
        (void)hipGetLastError();
    }
    if (grid_blocks < 0) return;
    Params p{};
    for (int i = 0; i < 36; ++i) p.in[i] = (const float*)d_in[i];
    p.out = (float*)d_out; p.ws = (unsigned char*)d_ws;
    void* args[] = {&p};
    (void)hipMemsetAsync((unsigned char*)d_ws + OFF_CTL, 0, WS_END - OFF_CTL, stream);
    hipError_t e = hipLaunchCooperativeKernel((const void*)mega, dim3(grid_blocks), dim3(NTH), args, LDS_BYTES, stream);
    if (e != hipSuccess) fprintf(stderr, "cooperative launch failed: %s (grid %d)\n", hipGetErrorString(e), grid_blocks);
}
```

```cpp
#include <hip/hip_runtime.h>
#include <hip/hip_cooperative_groups.h>
#include <cstdio>
namespace cg = cooperative_groups;

#define LAS __attribute__((address_space(3)))
typedef float f32x2 __attribute__((ext_vector_type(2)));
typedef unsigned u32x2 __attribute__((ext_vector_type(2)));

constexpr int MP = 16384, MS = 512, MT = MP + MS;
constexpr int DM = 1024, NPROJ = 8960, NPROJ_REAL = 8720, DFF = 2816, NUP = 5632;
constexpr int C_U = 0, C_Z = 512, C_XBC = 1536, C_DT = 3584, C_Q = 3600, C_F = 4112, C_I = 4624, C_G = 5136, C_GATE = 5648;
constexpr float EPSN = 1e-6f;
constexpr size_t W_IN = 0, W_GLU = 18350080, W_SSD = 20447232, W_HG = 22544384, W_O3 = 23592960, W_UP = 29884416, W_DN = 41418752;
constexpr size_t OFF_XN = 47185920, OFF_PROJ = 81788928, OFF_AGLU = 384565248, OFF_AHG = 401866752, OFF_SSQ = 419168256, OFF_TCAT = 420249600, OFF_CTL = 524058624, OFF_BAR = 524062720, WS_END = 524079104;
constexpr size_t O_PS5R = 17301504, O_PS5I = 17334272, O_PSSD = 17367040, O_PSSDC = 19464192, O_PHG = 19562496, O_PFFC = 20611072;
constexpr size_t O_SS5R = 20701184, O_SS5I = 21225472, O_SSSD = 21749760, O_SSSDC = 55304192, O_SHG = 56877056, O_SFFC = 73654272;
constexpr int MISC_OFF = 151552, LDS_BYTES = MISC_OFF + 256;

struct Params {
    const float* in[36];
    float* out;
    unsigned char* ws;
};
enum { I_XP = 0, I_XS, I_S5R, I_S5I, I_SSD, I_SSDC, I_HG, I_FFC, I_N1W, I_WIN, I_S5LDT, I_S5LR, I_S5LI, I_S5BR, I_S5BI, I_S5CR, I_S5CI, I_S5D, I_S5GLU,
       I_CONVW, I_CONVB, I_DTB, I_ALOG, I_SSDD, I_SSDNW, I_SSDWO, I_LB, I_HGNW, I_HGWO, I_WO, I_N2W, I_WUP, I_FCW, I_FCB, I_WDN, I_NFW };

namespace pg8 {
#define PG8_LAS __attribute__((address_space(3)))
typedef unsigned short bf16_t;
typedef short bf16x8 __attribute__((ext_vector_type(8)));
typedef float f32x4 __attribute__((ext_vector_type(4)));
typedef unsigned u32x4 __attribute__((ext_vector_type(4)));
constexpr int BM = 256, BK = 64, HALF = 128, HTB = HALF * BK * 2  , STAGE_BYTES = 8 * HTB, NXCD = 8, WGM = 8;

__host__ __device__ __forceinline__ int lds_byte(int r, int c) { const int st = (r >> 4) * 2 + (c >> 5), rr = r & 15, cc = c & 31, ob = rr * 64 + cc * 2; return st * 1024 + (ob ^ (((ob >> 9) & 1) << 5)); }
__host__ __device__ __forceinline__ void stage_rc(int b, int& R, int& C) { const int st = b / 1024, sb = b % 1024, swz = sb ^ (((sb >> 9) & 1) << 5); R = (st >> 1) * 16 + swz / 64; C = (st & 1) * 32 + (swz % 64) / 2; }
__host__ __device__ __forceinline__ int perm32(int rho) { const int n = rho >> 4, i = rho & 15; return 8 * (i >> 2) + 4 * n + (i & 3); }

struct Unit { int pm, pn; };
struct Gemm { const bf16_t* A; const bf16_t* Bt; int M, N, K; };

struct StaticOrder {
    int nM, nN, nwg, G, c;
    __host__ __device__ void init(int M, int N, int G_, int c_) { nM = M / BM; nN = N / BM; nwg = nM * nN; G = G_; c = c_; }
    __host__ __device__ bool next(int i, Unit& u) const {
        const long L = (long)i * G + c; if (L >= nwg) return false;
        int wgid = (int)L; { const int q = nwg / NXCD, r = nwg % NXCD, xcd = wgid % NXCD, off = wgid / NXCD; wgid = (xcd < r ? xcd * (q + 1) : r * (q + 1) + (xcd - r) * q) + off; }
        const int nig = WGM * nN, gid = wgid / nig, fm = gid * WGM, gsz = (nM - fm) < WGM ? (nM - fm) : WGM;
        u.pm = fm + ((wgid % nig) % gsz); u.pn = (wgid % nig) / gsz; return true;
    }
    __device__ __forceinline__ void a_ready(const Unit&) const {}
    __device__ __forceinline__ void done(const Unit&) const {}
};
typedef __bf16 bf16x2_t __attribute__((ext_vector_type(2)));
__device__ __forceinline__ unsigned cvt_pk_bf16(float lo, float hi) { f32x2 v = {lo, hi}; bf16x2_t h = __builtin_convertvector(v, bf16x2_t); return __builtin_bit_cast(unsigned, h); }
__device__ __forceinline__ float bf2f(unsigned b) { return __builtin_bit_cast(float, b << 16); }
__device__ __forceinline__ float bflo(unsigned w) { return __builtin_bit_cast(float, w << 16); }
__device__ __forceinline__ float bfhi(unsigned w) { return __builtin_bit_cast(float, w & 0xffff0000u); }
__device__ __forceinline__ bf16_t f2bf(float f) { return __builtin_bit_cast(bf16_t, (__bf16)f); }
__device__ __forceinline__ float sigm(float x) { return __builtin_amdgcn_rcpf(1.f + __expf(-x)); }
__device__ __forceinline__ float silu(float x) { return x * __builtin_amdgcn_rcpf(1.f + __expf(-x)); }
__device__ __forceinline__ float gelu_tanh(float x) { const float u = 0.7978845608028654f * (x + 0.044715f * x * x * x); const float th = 1.f - 2.f * __builtin_amdgcn_rcpf(__expf(2.f * u) + 1.f); return 0.5f * x * (1.f + th); }
__device__ __forceinline__ float dpp_f(float v, int ctrl_sel) { return v; }
#define DPP_ADD(v, CTRL) ((v) + __builtin_bit_cast(float, __builtin_amdgcn_update_dpp(0, __builtin_bit_cast(int, (v)), (CTRL), 0xF, 0xF, true)))
__device__ __forceinline__ float sum8(float v) { v = DPP_ADD(v, 0xB1); v = DPP_ADD(v, 0x4E); v = DPP_ADD(v, 0x141); return v; }
__device__ __forceinline__ float wave_sum(float v) {
    v = DPP_ADD(v, 0xB1); v = DPP_ADD(v, 0x4E); v = DPP_ADD(v, 0x141); v = DPP_ADD(v, 0x140);
    const float a = __builtin_bit_cast(float, __builtin_amdgcn_readlane(__builtin_bit_cast(int, v), 0)), b = __builtin_bit_cast(float, __builtin_amdgcn_readlane(__builtin_bit_cast(int, v), 16));
    const float c = __builtin_bit_cast(float, __builtin_amdgcn_readlane(__builtin_bit_cast(int, v), 32)), d = __builtin_bit_cast(float, __builtin_amdgcn_readlane(__builtin_bit_cast(int, v), 48));
    return (a + b) + (c + d);
}
__device__ __forceinline__ float wave_prefix(float v, int lane) {
    v = DPP_ADD(v, 0x111); v = DPP_ADD(v, 0x112); v = DPP_ADD(v, 0x114); v = DPP_ADD(v, 0x118);
    const float t0 = __builtin_bit_cast(float, __builtin_amdgcn_readlane(__builtin_bit_cast(int, v), 15)), t1 = __builtin_bit_cast(float, __builtin_amdgcn_readlane(__builtin_bit_cast(int, v), 31));
    const float t2 = __builtin_bit_cast(float, __builtin_amdgcn_readlane(__builtin_bit_cast(int, v), 47));
    const int r = lane >> 4;
    return v + (r >= 1 ? t0 : 0.f) + (r >= 2 ? t1 : 0.f) + (r >= 3 ? t2 : 0.f);
}

struct EpiStoreBf16 {
    static constexpr bool PERM = true, AFTER_DRAIN = false;
    bf16_t* O; int ldc;
    __device__ __forceinline__ void operator()(const f32x4 (&acc)[2][2][4][2], const Unit& u, int wr, int wc, int fr, int fq) const {
        const int row0 = u.pm * BM + wr * 64 + fr, col0 = u.pn * BM + wc * 32 + 8 * fq;
#pragma unroll
        for (int ai = 0; ai < 2; ++ai)
#pragma unroll
            for (int m = 0; m < 4; ++m) { bf16_t* rowp = O + (size_t)(row0 + ai * HALF + m * 16) * ldc + col0;
#pragma unroll
                for (int bj = 0; bj < 2; ++bj) { const f32x4 v0 = acc[ai][bj][m][0], v1 = acc[ai][bj][m][1];
                    u32x4 w; w.x = cvt_pk_bf16(v0[0], v0[1]); w.y = cvt_pk_bf16(v0[2], v0[3]); w.z = cvt_pk_bf16(v1[0], v1[1]); w.w = cvt_pk_bf16(v1[2], v1[3]);
                    *(u32x4*)(rowp + bj * HALF) = w; } }
    }
};
struct EpiGlu {
    static constexpr bool PERM = true, AFTER_DRAIN = false;
    const bf16_t* proj; bf16_t* tcat;
    __device__ __forceinline__ void operator()(const f32x4 (&acc)[2][2][4][2], const Unit& u, int wr, int wc, int fr, int fq) const {
        const int row0 = u.pm * BM + wr * 64 + fr, oc = u.pn * 128 + wc * 32 + 8 * fq;
#pragma unroll
        for (int ai = 0; ai < 2; ++ai) {
            u32x4 gl[4], od[4];
#pragma unroll
            for (int m = 0; m < 4; ++m) { const size_t r = (size_t)(row0 + ai * HALF + m * 16); gl[m] = *(const u32x4*)(proj + r * NPROJ + C_GATE + oc); od[m] = *(const u32x4*)(tcat + r * 1024 + oc); }
            __builtin_amdgcn_sched_barrier(0);
#pragma unroll
            for (int m = 0; m < 4; ++m) { const size_t r = (size_t)(row0 + ai * HALF + m * 16);
                const f32x4 a0 = acc[ai][0][m][0], a1 = acc[ai][0][m][1], g0 = acc[ai][1][m][0], g1 = acc[ai][1][m][1];
                float t[8];
                t[0] = sigm(bflo(gl[m].x)) * a0[0] * sigm(g0[0]) + bflo(od[m].x); t[1] = sigm(bfhi(gl[m].x)) * a0[1] * sigm(g0[1]) + bfhi(od[m].x);
                t[2] = sigm(bflo(gl[m].y)) * a0[2] * sigm(g0[2]) + bflo(od[m].y); t[3] = sigm(bfhi(gl[m].y)) * a0[3] * sigm(g0[3]) + bfhi(od[m].y);
                t[4] = sigm(bflo(gl[m].z)) * a1[0] * sigm(g1[0]) + bflo(od[m].z); t[5] = sigm(bfhi(gl[m].z)) * a1[1] * sigm(g1[1]) + bfhi(od[m].z);
                t[6] = sigm(bflo(gl[m].w)) * a1[2] * sigm(g1[2]) + bflo(od[m].w); t[7] = sigm(bfhi(gl[m].w)) * a1[3] * sigm(g1[3]) + bfhi(od[m].w);
                u32x4 w; w.x = cvt_pk_bf16(t[0], t[1]); w.y = cvt_pk_bf16(t[2], t[3]); w.z = cvt_pk_bf16(t[4], t[5]); w.w = cvt_pk_bf16(t[6], t[7]);
                *(u32x4*)(tcat + r * 1024 + oc) = w; }
            __builtin_amdgcn_sched_barrier(0);
        }
    }
};
template <bool RSTD, bool RMW> struct EpiSG {
    static constexpr bool PERM = true, AFTER_DRAIN = false;
    const bf16_t* proj; bf16_t* tcat; const float* ssq; int br;
    __device__ __forceinline__ void operator()(const f32x4 (&acc)[2][2][4][2], const Unit& u, int wr, int wc, int fr, int fq) const {
        const int row0 = u.pm * BM + wr * 64 + fr, col0 = u.pn * BM + wc * 32 + 8 * fq;
#pragma unroll
        for (int ai = 0; ai < 2; ++ai) {
            float sc[4] = {1.f, 1.f, 1.f, 1.f};
            if (RSTD) { f32x4 sv[4][4];
#pragma unroll
                for (int m = 0; m < 4; ++m) { const f32x4* sp = (const f32x4*)(ssq + (size_t)(row0 + ai * HALF + m * 16) * 16); sv[m][0] = sp[0]; sv[m][1] = sp[1]; sv[m][2] = sp[2]; sv[m][3] = sp[3]; }
                __builtin_amdgcn_sched_barrier(0);
#pragma unroll
                for (int m = 0; m < 4; ++m) { const f32x4 q = (sv[m][0] + sv[m][1]) + (sv[m][2] + sv[m][3]); sc[m] = 1.f / sqrtf(((q[0] + q[1]) + (q[2] + q[3])) * (1.f / 1024.f) + EPSN); } }
            u32x4 gl[4][2], od[4][2];
#pragma unroll
            for (int m = 0; m < 4; ++m)
#pragma unroll
                for (int bj = 0; bj < 2; ++bj) { const size_t r = (size_t)(row0 + ai * HALF + m * 16); const int c = col0 + bj * HALF;
                    gl[m][bj] = *(const u32x4*)(proj + r * NPROJ + C_GATE + br * 1024 + c); if (RMW) od[m][bj] = *(const u32x4*)(tcat + r * 1024 + c); }
            __builtin_amdgcn_sched_barrier(0);
#pragma unroll
            for (int m = 0; m < 4; ++m)
#pragma unroll
                for (int bj = 0; bj < 2; ++bj) { const size_t r = (size_t)(row0 + ai * HALF + m * 16); const int c = col0 + bj * HALF;
                    const f32x4 v0 = acc[ai][bj][m][0], v1 = acc[ai][bj][m][1]; const u32x4 g = gl[m][bj]; const float s = sc[m];
                    float t[8] = { sigm(bflo(g.x)) * s * v0[0], sigm(bfhi(g.x)) * s * v0[1], sigm(bflo(g.y)) * s * v0[2], sigm(bfhi(g.y)) * s * v0[3],
                                   sigm(bflo(g.z)) * s * v1[0], sigm(bfhi(g.z)) * s * v1[1], sigm(bflo(g.w)) * s * v1[2], sigm(bfhi(g.w)) * s * v1[3] };
                    if (RMW) { const u32x4 o = od[m][bj];
                        t[0] += bflo(o.x); t[1] += bfhi(o.x); t[2] += bflo(o.y); t[3] += bfhi(o.y); t[4] += bflo(o.z); t[5] += bfhi(o.z); t[6] += bflo(o.w); t[7] += bfhi(o.w); }
                    u32x4 w; w.x = cvt_pk_bf16(t[0], t[1]); w.y = cvt_pk_bf16(t[2], t[3]); w.z = cvt_pk_bf16(t[4], t[5]); w.w = cvt_pk_bf16(t[6], t[7]);
                    *(u32x4*)(tcat + r * 1024 + c) = w; }
            __builtin_amdgcn_sched_barrier(0);
        }
    }
};
struct EpiRes {
    static constexpr bool PERM = false, AFTER_DRAIN = false;
    const float* xp; const float* xs; float* xres; int from_in;
    __device__ __forceinline__ void operator()(const f32x4 (&acc)[2][2][4][2], const Unit& u, int wr, int wc, int fr, int fq) const {
        const int row0 = u.pm * BM + wr * 64 + fr, col0 = u.pn * BM + wc * 32 + 4 * fq;
#pragma unroll
        for (int ai = 0; ai < 2; ++ai) {
            f32x4 bs[4][2][2];
#pragma unroll
            for (int m = 0; m < 4; ++m) { const int r = row0 + ai * HALF + m * 16;
                const float* src = from_in ? (r < MP ? xp + (size_t)r * DM : xs + (size_t)(r - MP) * DM) + col0 : xres + (size_t)r * DM + col0;
#pragma unroll
                for (int bj = 0; bj < 2; ++bj)
#pragma unroll
                    for (int n = 0; n < 2; ++n) bs[m][bj][n] = *(const f32x4*)(src + bj * HALF + n * 16); }
            __builtin_amdgcn_sched_barrier(0);
#pragma unroll
            for (int m = 0; m < 4; ++m) { float* dst = xres + (size_t)(row0 + ai * HALF + m * 16) * DM + col0;
#pragma unroll
                for (int bj = 0; bj < 2; ++bj)
#pragma unroll
                    for (int n = 0; n < 2; ++n) *(f32x4*)(dst + bj * HALF + n * 16) = bs[m][bj][n] + acc[ai][bj][m][n]; }
            __builtin_amdgcn_sched_barrier(0);
        }
    }
};

template <class Epi, class Sched>
__device__ __forceinline__ void gemm_phase(PG8_LAS unsigned char* lds, const Gemm g, const Sched& S, const Epi& E, int tid_in) {
    int tid = tid_in; asm volatile("" : "+v"(tid));
    const int wid = __builtin_amdgcn_readfirstlane(tid >> 6), lane = tid & 63, wr = wid >> 2, wc = wid & 3, fr = lane & 15, fq = lane >> 4;
    const int K = g.K, nt = K / BK;
    unsigned voffA[2], voffB[2];
#pragma unroll
    for (int i = 0; i < 2; ++i) { int R, C; stage_rc(tid * 16 + i * 8192, R, C); const int Rb = Epi::PERM ? ((R & ~31) + perm32(R & 31)) : R;
        voffA[i] = (unsigned)(R * K + C) * 2u; voffB[i] = (unsigned)(Rb * K + C) * 2u; }
    const size_t kstep = (size_t)(BK * 2);
    const size_t hstep = (size_t)HALF * K * 2;
    const size_t tstep = 2 * hstep;
    const unsigned ldsw = (unsigned)wid * 1024u;
    const int aoff = lds_byte(wr * 64 + fr, fq * 8), boff = lds_byte(wc * 32 + fr, fq * 8);
#define PG8_SA(b, h) (((b) * 2 + (h)) * HTB)
#define PG8_SB(b, h) ((4 + (b) * 2 + (h)) * HTB)
#define PG8_STAGE(bufoff, gbase, voff) do { _Pragma("unroll") for (int _i = 0; _i < 2; ++_i) \
        __builtin_amdgcn_global_load_lds((const unsigned*)((const char*)(gbase) + (voff)[_i]), (PG8_LAS unsigned*)(lds + (bufoff) + ldsw + _i * 8192), 16, 0, 0); } while (0)
#define PG8_LDA(dst, b, h) do { _Pragma("unroll") for (int m = 0; m < 4; ++m) _Pragma("unroll") for (int k = 0; k < 2; ++k) dst[m][k] = *(const PG8_LAS bf16x8*)(lds + PG8_SA(b, h) + aoff + m * 2048 + k * 1024); } while (0)
#define PG8_LDB(dst, b, h) do { _Pragma("unroll") for (int n = 0; n < 2; ++n) _Pragma("unroll") for (int k = 0; k < 2; ++k) dst[n][k] = *(const PG8_LAS bf16x8*)(lds + PG8_SB(b, h) + boff + n * 2048 + k * 1024); } while (0)
#define PG8_MMA(ai, bj, At, Bt) do { __builtin_amdgcn_s_setprio(1); _Pragma("unroll") for (int m = 0; m < 4; ++m) _Pragma("unroll") for (int n = 0; n < 2; ++n) _Pragma("unroll") for (int k = 0; k < 2; ++k) \
        acc[ai][bj][m][n] = __builtin_amdgcn_mfma_f32_16x16x32_bf16(Bt[n][k], At[m][k], acc[ai][bj][m][n], 0, 0, 0); __builtin_amdgcn_s_setprio(0); } while (0)
#define PG8_WAIT_V(n) asm volatile("s_waitcnt vmcnt(" #n ")" ::: "memory")
#define PG8_WAIT_L(n) asm volatile("s_waitcnt lgkmcnt(" #n ")" ::: "memory")
#define PG8_BAR __builtin_amdgcn_s_barrier()
#define PG8_SCHED __builtin_amdgcn_sched_barrier(0)
    Unit cur, nxt; int ui = 0;
    if (!S.next(0, cur)) return;
    f32x4 acc[2][2][4][2];
#pragma unroll
    for (int a = 0; a < 2; ++a)
#pragma unroll
        for (int b = 0; b < 2; ++b)
#pragma unroll
            for (int m = 0; m < 4; ++m)
#pragma unroll
                for (int n = 0; n < 2; ++n) acc[a][b][m][n] = (f32x4){0.f, 0.f, 0.f, 0.f};
    bf16x8 At[4][2], B0[2][2], B1[2][2];
    const char* cA = (const char*)g.A + (size_t)cur.pm * tstep; const char* cB = (const char*)g.Bt + (size_t)cur.pn * tstep;
    S.a_ready(cur);
    PG8_STAGE(PG8_SB(0, 0), cB, voffB); PG8_STAGE(PG8_SA(0, 0), cA, voffA); PG8_STAGE(PG8_SB(0, 1), cB + hstep, voffB); PG8_STAGE(PG8_SA(0, 1), cA + hstep, voffA);
    if (wr == 1) PG8_BAR;
    PG8_WAIT_V(4); PG8_BAR;
    PG8_STAGE(PG8_SB(1, 0), cB + kstep, voffB); PG8_STAGE(PG8_SA(1, 0), cA + kstep, voffA); PG8_STAGE(PG8_SB(1, 1), cB + hstep + kstep, voffB);
    PG8_WAIT_V(6); PG8_BAR;
    for (;;) {
        const bool has_next = S.next(ui + 1, nxt);
        const char* nA = has_next ? (const char*)g.A + (size_t)nxt.pm * tstep : cA; const char* nB = has_next ? (const char*)g.Bt + (size_t)nxt.pn * tstep : cB;
        for (int t = 0; t < nt; t += 2) {
            const bool last = (t == nt - 2);
            const char* a1 = cA + (size_t)(t + 1) * kstep;
            const char* a2 = last ? nA : cA + (size_t)(t + 2) * kstep; const char* b2 = last ? nB : cB + (size_t)(t + 2) * kstep;
            const char* a3 = a2 + kstep; const char* b3 = b2 + kstep;
            if (last && has_next) S.a_ready(nxt);
            PG8_LDB(B0, 0, 0); PG8_SCHED; PG8_LDA(At, 0, 0); PG8_STAGE(PG8_SA(1, 1), a1 + hstep, voffA);
            PG8_WAIT_L(8); PG8_BAR; PG8_WAIT_L(0); PG8_MMA(0, 0, At, B0); PG8_BAR; PG8_SCHED;
            PG8_LDB(B1, 0, 1); PG8_STAGE(PG8_SB(0, 0), b2, voffB);
            PG8_BAR; PG8_WAIT_L(0); PG8_MMA(0, 1, At, B1); PG8_BAR;
            PG8_LDA(At, 0, 1); PG8_STAGE(PG8_SA(0, 0), a2, voffA);
            PG8_BAR; PG8_WAIT_L(0); PG8_MMA(1, 0, At, B0); PG8_BAR; PG8_SCHED;
            PG8_STAGE(PG8_SB(0, 1), b2 + hstep, voffB);
            PG8_WAIT_V(6); PG8_BAR; PG8_MMA(1, 1, At, B1); PG8_BAR;
            PG8_LDB(B0, 1, 0); PG8_SCHED; PG8_LDA(At, 1, 0); PG8_STAGE(PG8_SA(0, 1), a2 + hstep, voffA);
            PG8_WAIT_L(8); PG8_BAR; PG8_WAIT_L(0); PG8_MMA(0, 0, At, B0); PG8_BAR; PG8_SCHED;
            PG8_LDB(B1, 1, 1); PG8_STAGE(PG8_SB(1, 0), b3, voffB);
            PG8_BAR; PG8_WAIT_L(0); PG8_MMA(0, 1, At, B1); PG8_BAR;
            PG8_LDA(At, 1, 1); PG8_STAGE(PG8_SA(1, 0), a3, voffA);
            PG8_BAR; PG8_WAIT_L(0); PG8_MMA(1, 0, At, B0); PG8_BAR; PG8_SCHED;
            PG8_STAGE(PG8_SB(1, 1), b3 + hstep, voffB);
            PG8_WAIT_V(6); PG8_BAR; PG8_MMA(1, 1, At, B1); PG8_BAR;
        }
        if constexpr (!Epi::AFTER_DRAIN) { E(acc, cur, wr, wc, fr, fq); S.done(cur); }
        if (!has_next) break;
#pragma unroll
        for (int a = 0; a < 2; ++a)
#pragma unroll
            for (int b = 0; b < 2; ++b)
#pragma unroll
                for (int m = 0; m < 4; ++m)
#pragma unroll
                    for (int n = 0; n < 2; ++n) acc[a][b][m][n] = (f32x4){0.f, 0.f, 0.f, 0.f};
        cur = nxt; cA = nA; cB = nB; ++ui;
    }
    PG8_WAIT_V(0);
    if (wr == 0) PG8_BAR;
    PG8_BAR;
    if constexpr (Epi::AFTER_DRAIN) { E.fused(acc, cur, wr, wc, fr, fq, lds, wid, lane); S.done(cur); }
#undef PG8_SA
#undef PG8_SB
#undef PG8_STAGE
#undef PG8_LDA
#undef PG8_LDB
#undef PG8_MMA
#undef PG8_WAIT_V
#undef PG8_WAIT_L
#undef PG8_BAR
#undef PG8_SCHED
}
}
using namespace pg8;
__device__ __forceinline__ u32x4 pack8(float a0, float a1, float a2, float a3, float a4, float a5, float a6, float a7) { u32x4 w; w.x = cvt_pk_bf16(a0, a1); w.y = cvt_pk_bf16(a2, a3); w.z = cvt_pk_bf16(a4, a5); w.w = cvt_pk_bf16(a6, a7); return w; }
constexpr int NTH = 512;

template <int MODE>
__device__ __forceinline__ void cvt_wt(const float* W, int K, int N, int Nphys, bf16_t* WT, int ldk, int koff, LAS float* scr, int tid, int rot) {
    const int nnb = Nphys / 64, ntile = (K / 64) * nnb;
    int bx_ = blockIdx.x; asm volatile("" : "+s"(bx_));
    for (int it = (bx_ + rot) % (int)gridDim.x; it < ntile; it += gridDim.x) {
        const int kb = it / nnb, nb = it % nnb, k0 = kb * 64, n0 = nb * 64;
        int src0 = n0;
        if (MODE == 2) { const int blk = n0 >> 8, within = n0 & 255; src0 = (within >> 7) * 1024 + blk * 128 + (within & 127); }
        const int c = tid & 63;
#pragma unroll
        for (int i = 0; i < 8; ++i) { const int kk = (tid >> 6) + 8 * i;
            float v = 0.f; if (MODE != 1 || src0 + c < N) v = W[(size_t)(k0 + kk) * N + src0 + c];
            scr[kk * 65 + c] = v; }
        __syncthreads();
        { const int n = tid >> 3, ch = tid & 7; const LAS float* s = scr + (8 * ch) * 65 + n;
          u32x4 o; o.x = cvt_pk_bf16(s[0], s[65]); o.y = cvt_pk_bf16(s[130], s[195]); o.z = cvt_pk_bf16(s[260], s[325]); o.w = cvt_pk_bf16(s[390], s[455]);
          *(u32x4*)(WT + (size_t)(n0 + n) * ldk + koff + k0 + 8 * ch) = o; }
        __syncthreads();
    }
}
__device__ __forceinline__ void convert_weights(const Params& P, int l, LAS unsigned char* L, int tid) {
    LAS float* scr = (LAS float*)L; unsigned char* ws = P.ws;
    cvt_wt<1>(P.in[I_WIN] + (size_t)l * 1024 * NPROJ_REAL, 1024, NPROJ_REAL, NPROJ, (bf16_t*)(ws + W_IN), 1024, 0, scr, tid, 0);
    cvt_wt<2>(P.in[I_S5GLU] + (size_t)l * 512 * 2048, 512, 2048, 2048, (bf16_t*)(ws + W_GLU), 512, 0, scr, tid, 192);
    cvt_wt<0>(P.in[I_SSDWO] + (size_t)l * 1024 * 1024, 1024, 1024, 1024, (bf16_t*)(ws + W_SSD), 1024, 0, scr, tid, 192);
    cvt_wt<0>(P.in[I_HGWO] + (size_t)l * 512 * 1024, 512, 1024, 1024, (bf16_t*)(ws + W_HG), 512, 0, scr, tid, 192);
    cvt_wt<0>(P.in[I_WO] + (size_t)l * 1024 * 1024, 1024, 1024, 1024, (bf16_t*)(ws + W_O3), 1024, 0, scr, tid, 64);
    cvt_wt<0>(P.in[I_WUP] + (size_t)l * 1024 * NUP, 1024, NUP, NUP, (bf16_t*)(ws + W_UP), 1024, 0, scr, tid, 128);
    cvt_wt<0>(P.in[I_WDN] + (size_t)l * DFF * 1024, DFF, 1024, 1024, (bf16_t*)(ws + W_DN), DFF, 0, scr, tid, 0);
}

__device__ __forceinline__ void norm_rows_bf16(const Params& P, int from_in, const float* w, bf16_t* out, int tid) {
    const int lane = tid & 63, gw = blockIdx.x * 8 + (tid >> 6), ngw = gridDim.x * 8;
    f32x4 wv[4];
#pragma unroll
    for (int j = 0; j < 4; ++j) wv[j] = ((const f32x4*)w)[lane + 64 * j];
    for (int row0 = gw; row0 < MT; row0 += 2 * ngw) {
        f32x4 v[2][4]; float ss[2] = {0.f, 0.f};
#pragma unroll
        for (int u = 0; u < 2; ++u) { const int row = (row0 + u * ngw < MT) ? row0 + u * ngw : row0;
            const float* xr = from_in ? (row < MP ? P.in[I_XP] + (size_t)row * DM : P.in[I_XS] + (size_t)(row - MP) * DM) : P.out + (size_t)row * DM;
#pragma unroll
            for (int j = 0; j < 4; ++j) v[u][j] = ((const f32x4*)xr)[lane + 64 * j]; }
#pragma unroll
        for (int u = 0; u < 2; ++u) {
#pragma unroll
            for (int j = 0; j < 4; ++j) ss[u] += (v[u][j][0] * v[u][j][0] + v[u][j][1] * v[u][j][1]) + (v[u][j][2] * v[u][j][2] + v[u][j][3] * v[u][j][3]);
            const float rstd = 1.f / sqrtf(wave_sum(ss[u]) * (1.f / 1024.f) + EPSN);
            if (u == 0 || row0 + ngw < MT) { u32x2* o = (u32x2*)(out + (size_t)(row0 + u * ngw) * DM);
#pragma unroll
                for (int j = 0; j < 4; ++j) { u32x2 q; q.x = cvt_pk_bf16(v[u][j][0] * rstd * wv[j][0], v[u][j][1] * rstd * wv[j][1]); q.y = cvt_pk_bf16(v[u][j][2] * rstd * wv[j][2], v[u][j][3] * rstd * wv[j][3]); o[lane + 64 * j] = q; } } }
    }
}
__device__ __forceinline__ void final_norm(const Params& P, int tid) {
    const int lane = tid & 63, gw = blockIdx.x * 8 + (tid >> 6), ngw = gridDim.x * 8;
    const float* w = P.in[I_NFW];
    f32x4 wv[4];
#pragma unroll
    for (int j = 0; j < 4; ++j) wv[j] = ((const f32x4*)w)[lane + 64 * j];
    for (int row0 = gw; row0 < MT; row0 += 2 * ngw) {
        f32x4 v[2][4];
#pragma unroll
        for (int u = 0; u < 2; ++u) { const int row = (row0 + u * ngw < MT) ? row0 + u * ngw : row0; const float* xr = P.out + (size_t)row * DM;
#pragma unroll
            for (int j = 0; j < 4; ++j) v[u][j] = ((const f32x4*)xr)[lane + 64 * j]; }
#pragma unroll
        for (int u = 0; u < 2; ++u) { float ss = 0.f;
#pragma unroll
            for (int j = 0; j < 4; ++j) ss += (v[u][j][0] * v[u][j][0] + v[u][j][1] * v[u][j][1]) + (v[u][j][2] * v[u][j][2] + v[u][j][3] * v[u][j][3]);
            const float rstd = 1.f / sqrtf(wave_sum(ss) * (1.f / 1024.f) + EPSN);
            if (u == 0 || row0 + ngw < MT) { float* xr = P.out + (size_t)(row0 + u * ngw) * DM;
#pragma unroll
                for (int j = 0; j < 4; ++j) ((f32x4*)xr)[lane + 64 * j] = v[u][j] * rstd * wv[j]; } }
    }
}

__device__ __forceinline__ void ffn_conv_phase(const Params& P, int l, int tid) {
    const bf16_t* up = (const bf16_t*)(P.ws + OFF_PROJ); bf16_t* hff = (bf16_t*)(P.ws + OFF_TCAT);
    const float* cw = P.in[I_FCW] + (size_t)l * 3 * DFF; const float* cb = P.in[I_FCB] + (size_t)l * DFF;
    const int nun = (2048 + 128) * 352;
    for (int un = blockIdx.x * NTH + tid; un < nun; un += gridDim.x * NTH) {
        const int run = un / 352, c0 = (un - run * 352) * 8;
        const bool pr = run < 2048; const int nrow = pr ? 8 : 4, r0 = pr ? run * 8 : MP + (run - 2048) * 4, b = pr ? run >> 8 : run - 2048, t0 = pr ? (run & 255) * 8 : 0;
        u32x4 ar[8], gr[8];
#pragma unroll
        for (int i = 0; i < 8; ++i) { const int rr = r0 + (i < nrow ? i : nrow - 1); ar[i] = *(const u32x4*)(up + (size_t)rr * NUP + c0); gr[i] = *(const u32x4*)(up + (size_t)rr * NUP + DFF + c0); }
        float x0[8], x1[8];
        if (pr) {
            if (t0 > 0) { const u32x4 ua = *(const u32x4*)(up + (size_t)(r0 - 2) * NUP + c0), ub = *(const u32x4*)(up + (size_t)(r0 - 1) * NUP + c0);
                x0[0] = bflo(ua.x); x0[1] = bfhi(ua.x); x0[2] = bflo(ua.y); x0[3] = bfhi(ua.y); x0[4] = bflo(ua.z); x0[5] = bfhi(ua.z); x0[6] = bflo(ua.w); x0[7] = bfhi(ua.w);
                x1[0] = bflo(ub.x); x1[1] = bfhi(ub.x); x1[2] = bflo(ub.y); x1[3] = bfhi(ub.y); x1[4] = bflo(ub.z); x1[5] = bfhi(ub.z); x1[6] = bflo(ub.w); x1[7] = bfhi(ub.w);
            } else {
#pragma unroll
                for (int i = 0; i < 8; ++i) { x0[i] = 0.f; x1[i] = 0.f; } }
        } else { const float* st = P.in[I_FFC] + (size_t)(l * 128 + b) * 2 * DFF + c0;
            const f32x4 s0 = *(const f32x4*)st, s1 = *(const f32x4*)(st + 4), s2 = *(const f32x4*)(st + DFF), s3 = *(const f32x4*)(st + DFF + 4);
            x0[0] = s0[0]; x0[1] = s0[1]; x0[2] = s0[2]; x0[3] = s0[3]; x0[4] = s1[0]; x0[5] = s1[1]; x0[6] = s1[2]; x0[7] = s1[3];
            x1[0] = s2[0]; x1[1] = s2[1]; x1[2] = s2[2]; x1[3] = s2[3]; x1[4] = s3[0]; x1[5] = s3[1]; x1[6] = s3[2]; x1[7] = s3[3]; }
        float w0[8], w1[8], w2[8], bv[8];
        { const f32x4 a0 = *(const f32x4*)(cw + c0), a1 = *(const f32x4*)(cw + c0 + 4), b0 = *(const f32x4*)(cw + DFF + c0), b1 = *(const f32x4*)(cw + DFF + c0 + 4);
          const f32x4 d0 = *(const f32x4*)(cw + 2 * DFF + c0), d1 = *(const f32x4*)(cw + 2 * DFF + c0 + 4), e0 = *(const f32x4*)(cb + c0), e1 = *(const f32x4*)(cb + c0 + 4);
#pragma unroll
          for (int i = 0; i < 4; ++i) { w0[i] = a0[i]; w0[4 + i] = a1[i]; w1[i] = b0[i]; w1[4 + i] = b1[i]; w2[i] = d0[i]; w2[4 + i] = d1[i]; bv[i] = e0[i]; bv[4 + i] = e1[i]; } }
#pragma unroll
        for (int i = 0; i < 8; ++i) if (i < nrow) {
            const u32x4 a2 = ar[i], gg = gr[i];
            const float x2[8] = { bflo(a2.x), bfhi(a2.x), bflo(a2.y), bfhi(a2.y), bflo(a2.z), bfhi(a2.z), bflo(a2.w), bfhi(a2.w) };
            const float gv[8] = { bflo(gg.x), bfhi(gg.x), bflo(gg.y), bfhi(gg.y), bflo(gg.z), bfhi(gg.z), bflo(gg.w), bfhi(gg.w) };
            float hv[8];
#pragma unroll
            for (int j = 0; j < 8; ++j) { const float cv = x0[j] * w0[j] + x1[j] * w1[j] + x2[j] * w2[j] + bv[j]; hv[j] = silu(cv) * gv[j]; }
            *(u32x4*)(hff + (size_t)(r0 + i) * DFF + c0) = pack8(hv[0], hv[1], hv[2], hv[3], hv[4], hv[5], hv[6], hv[7]);
            const int t = t0 + i;
            if (pr && t >= 2046) { float* d = P.out + O_PFFC + ((size_t)(l * 8 + b) * 2 + (t - 2046)) * DFF + c0;
                *(f32x4*)d = (f32x4){x2[0], x2[1], x2[2], x2[3]}; *(f32x4*)(d + 4) = (f32x4){x2[4], x2[5], x2[6], x2[7]}; }
            if (!pr && i >= 2) { float* d = P.out + O_SFFC + ((size_t)(l * 128 + b) * 2 + (i - 2)) * DFF + c0;
                *(f32x4*)d = (f32x4){x2[0], x2[1], x2[2], x2[3]}; *(f32x4*)(d + 4) = (f32x4){x2[4], x2[5], x2[6], x2[7]}; }
#pragma unroll
            for (int j = 0; j < 8; ++j) { x0[j] = x1[j]; x1[j] = x2[j]; }
        }
    }
}

__device__ __forceinline__ float softplus(float x) { const float t = __expf(x); const float sm = t * (1.f - t * (0.5f - t * 0.33333334f)); return x > 20.f ? x : (t < 0.03f ? sm : __logf(1.f + t)); }

__device__ __forceinline__ void ssd_item(const Params& P, int l, bool prompt, int b, int h, LAS unsigned char* L, int tid) {
    const int Lseq = prompt ? 2048 : 4, row0 = prompt ? b * 2048 : MP + b * 4, g = h >> 2;
    LAS float* Bs = (LAS float*)L; LAS float* Cs = Bs + 4096; LAS float* xs = Cs + 4096; LAS float* zs = xs + 2048; LAS float* yb = zs + 2048; LAS float* dts = yb + 2048; LAS float* dAs = dts + 32;
    const bf16_t* proj = (const bf16_t*)(P.ws + OFF_PROJ);
    int role = 3, col = 0, xc = 0, dstride = 64; LAS float* dst = xs;
    if (tid < 128) { xc = 1024 + g * 128 + tid; dst = Bs + tid; dstride = 128; role = 0; }
    else if (tid < 256) { xc = 1536 + g * 128 + (tid - 128); dst = Cs + (tid - 128); dstride = 128; role = 0; }
    else if (tid < 320) { xc = h * 64 + (tid - 256); dst = xs + (tid - 256); dstride = 64; role = 0; }
    else if (tid < 384) { col = C_Z + h * 64 + (tid - 320); dst = zs + (tid - 320); dstride = 64; role = 1; }
    else if (tid < 416) role = 2;
    if (role == 0) col = C_XBC + xc;
    float w0 = 0.f, w1 = 0.f, w2 = 0.f, w3 = 0.f, cb = 0.f, r0 = 0.f, r1 = 0.f, r2 = 0.f;
    if (role == 0) { const float* cw = P.in[I_CONVW] + (size_t)l * 4 * 2048; w0 = cw[xc]; w1 = cw[2048 + xc]; w2 = cw[4096 + xc]; w3 = cw[6144 + xc]; cb = P.in[I_CONVB][l * 2048 + xc];
        if (!prompt) { const float* st = P.in[I_SSDC] + (size_t)(l * 128 + b) * 3 * 2048; r0 = st[xc]; r1 = st[2048 + xc]; r2 = st[4096 + xc]; } }
    const float dt_bias = P.in[I_DTB][l * 16 + h], aneg = -__expf(P.in[I_ALOG][l * 16 + h]), Dh = P.in[I_SSDD][l * 16 + h];
    const int p = tid >> 3, ns = tid & 7;
    f32x4 s[4];
    if (prompt) {
#pragma unroll
        for (int i = 0; i < 4; ++i) s[i] = (f32x4){0.f, 0.f, 0.f, 0.f};
    } else { const float* sp = P.in[I_SSD] + ((size_t)((l * 128 + b) * 16 + h) * 64 + p) * 128 + 4 * ns;
#pragma unroll
        for (int i = 0; i < 4; ++i) s[i] = *(const f32x4*)(sp + 32 * i); }
    bf16_t* Assd = (bf16_t*)(P.ws + OFF_XN); float* ssq = (float*)(P.ws + OFF_SSQ);
    const float* nw = P.in[I_SSDNW] + l * 1024 + h * 64;
    unsigned short rv[4];
#define SSD_LOAD(T0) do { if (role <= 1) { _Pragma("unroll") for (int tt = 0; tt < 4; ++tt) { int r_ = (T0) + tt; r_ = r_ < Lseq ? r_ : Lseq - 1; rv[tt] = proj[(size_t)(row0 + r_) * NPROJ + col]; } } \
        else if (role == 2) { int r_ = (T0) + (tid - 384); r_ = r_ < Lseq ? r_ : Lseq - 1; rv[0] = proj[(size_t)(row0 + r_) * NPROJ + C_DT + h]; } } while (0)
    SSD_LOAD(0);
    for (int t0 = 0; t0 < Lseq; t0 += 32) {
        const int len = (Lseq - t0) < 32 ? (Lseq - t0) : 32;
        if (role == 0) {
#pragma unroll
            for (int tt = 0; tt < 4; ++tt) { const float raw = bf2f(rv[tt]); const float y = r0 * w0 + r1 * w1 + r2 * w2 + raw * w3 + cb; dst[tt * dstride] = silu(y); r0 = r1; r1 = r2; r2 = raw; }
        } else if (role == 1) {
#pragma unroll
            for (int tt = 0; tt < 4; ++tt) dst[tt * dstride] = bf2f(rv[tt]);
        } else if (role == 2) { const int tt = tid - 384;
            const float raw = bf2f(rv[0]); const float dt = softplus(raw + dt_bias); dts[tt] = dt; dAs[tt] = __expf(dt * aneg); }
        __syncthreads();
        if (t0 + 32 < Lseq) SSD_LOAD(t0 + 32);
#define SSD_LD(Bx, Cx, dAx, dtx, xvx, TT) do { const int t_ = (TT) & 31; _Pragma("unroll") for (int i = 0; i < 4; ++i) { Bx[i] = *(const LAS f32x4*)(Bs + t_ * 128 + 32 * i + 4 * ns); Cx[i] = *(const LAS f32x4*)(Cs + t_ * 128 + 32 * i + 4 * ns); } \
            dAx = dAs[t_]; dtx = dts[t_]; xvx = xs[t_ * 64 + p]; } while (0)
#define SSD_STEP(Bx, Cx, dAx, dtx, xvx, TT) do { const float xdt_ = xvx * dtx; f32x4 y4_ = (f32x4){0.f, 0.f, 0.f, 0.f}; \
            _Pragma("unroll") for (int i = 0; i < 4; ++i) { s[i] = s[i] * dAx + Bx[i] * xdt_; y4_ += s[i] * Cx[i]; } \
            const float y_ = sum8((y4_[0] + y4_[1]) + (y4_[2] + y4_[3])); if (ns == 0) yb[(TT) * 64 + p] = y_; } while (0)
        { f32x4 B0[4], C0[4], B1[4], C1[4]; float dA0, dt0, xv0, dA1, dt1, xv1;
          SSD_LD(B0, C0, dA0, dt0, xv0, 0);
          for (int tt = 0; tt < len; tt += 2) {
              SSD_LD(B1, C1, dA1, dt1, xv1, tt + 1);
              SSD_STEP(B0, C0, dA0, dt0, xv0, tt);
              SSD_LD(B0, C0, dA0, dt0, xv0, tt + 2);
              SSD_STEP(B1, C1, dA1, dt1, xv1, tt + 1);
          } }
        __syncthreads();
        { const int tt = tid >> 4, q = tid & 15; f32x4 v = *(const LAS f32x4*)(yb + tt * 64 + 4 * q);
          { const f32x4 xv4 = *(const LAS f32x4*)(xs + tt * 64 + 4 * q), z4 = *(const LAS f32x4*)(zs + tt * 64 + 4 * q);
            v[0] = (v[0] + Dh * xv4[0]) * silu(z4[0]); v[1] = (v[1] + Dh * xv4[1]) * silu(z4[1]); v[2] = (v[2] + Dh * xv4[2]) * silu(z4[2]); v[3] = (v[3] + Dh * xv4[3]) * silu(z4[3]); }
          float sq = (v[0] * v[0] + v[1] * v[1]) + (v[2] * v[2] + v[3] * v[3]);
          sq = sum8(sq); sq = DPP_ADD(sq, 0x140);
          if (tt < len) { const size_t row = (size_t)(row0 + t0 + tt); const f32x4 wv = *(const f32x4*)(nw + 4 * q);
              u32x2 o; o.x = cvt_pk_bf16(v[0] * wv[0], v[1] * wv[1]); o.y = cvt_pk_bf16(v[2] * wv[2], v[3] * wv[3]);
              *(u32x2*)(Assd + row * DM + h * 64 + 4 * q) = o;
              if (q == 0) ssq[row * 16 + h] = sq; } }
    }
    { float* sp = P.out + (prompt ? O_PSSD + ((size_t)((l * 8 + b) * 16 + h) * 64 + p) * 128 : O_SSSD + ((size_t)((l * 128 + b) * 16 + h) * 64 + p) * 128) + 4 * ns;
#pragma unroll
      for (int i = 0; i < 4; ++i) *(f32x4*)(sp + 32 * i) = s[i]; }
    __syncthreads();
}

__device__ __forceinline__ void ssd_s4_item(const Params& P, int l, int b, int g, LAS unsigned char* L, int tid) {
    const int row0 = MP + b * 4;
    LAS float* Bs = (LAS float*)L; LAS float* Cs = Bs + 512; LAS float* xs = Cs + 512; LAS float* zs = xs + 1024; LAS float* yb = zs + 1024; LAS float* dts = yb + 1024; LAS float* dAs = dts + 16;
    const bf16_t* proj = (const bf16_t*)(P.ws + OFF_PROJ);
    const bool isx = tid >= 256; const int hh2 = (tid - 256) >> 6, p2 = (tid - 256) & 63;
    const int xc = !isx ? (tid < 128 ? 1024 + g * 128 + tid : 1536 + g * 128 + (tid - 128)) : (4 * g + hh2) * 64 + p2;
    LAS float* dst = !isx ? (tid < 128 ? Bs + tid : Cs + (tid - 128)) : xs + hh2 * 256 + p2;
    const int dstride = !isx ? 128 : 64;
    const float* cw = P.in[I_CONVW] + (size_t)l * 4 * 2048; const float w0 = cw[xc], w1 = cw[2048 + xc], w2 = cw[4096 + xc], w3 = cw[6144 + xc], cb = P.in[I_CONVB][l * 2048 + xc];
    const float* st = P.in[I_SSDC] + (size_t)(l * 128 + b) * 3 * 2048; float r0 = st[xc], r1 = st[2048 + xc], r2 = st[4096 + xc];
    unsigned short rv[4], zv[4] = {0, 0, 0, 0};
#pragma unroll
    for (int tt = 0; tt < 4; ++tt) { rv[tt] = proj[(size_t)(row0 + tt) * NPROJ + C_XBC + xc]; if (isx) zv[tt] = proj[(size_t)(row0 + tt) * NPROJ + C_Z + (4 * g + hh2) * 64 + p2]; }
    float dtr = 0.f, dtb = 0.f, an = 0.f;
    if (tid < 16) { const int hh = tid >> 2, tt = tid & 3; dtr = bf2f(proj[(size_t)(row0 + tt) * NPROJ + C_DT + 4 * g + hh]); dtb = P.in[I_DTB][l * 16 + 4 * g + hh]; an = -__expf(P.in[I_ALOG][l * 16 + 4 * g + hh]); }
    const int p = tid >> 3, ns = tid & 7;
    f32x4 s[4][4];
#pragma unroll
    for (int hh = 0; hh < 4; ++hh) { const float* sp = P.in[I_SSD] + ((size_t)((l * 128 + b) * 16 + 4 * g + hh) * 64 + p) * 128 + 4 * ns;
#pragma unroll
        for (int i = 0; i < 4; ++i) s[hh][i] = *(const f32x4*)(sp + 32 * i); }
#pragma unroll
    for (int tt = 0; tt < 4; ++tt) { const float raw = bf2f(rv[tt]); const float y = r0 * w0 + r1 * w1 + r2 * w2 + raw * w3 + cb; dst[tt * dstride] = silu(y); r0 = r1; r1 = r2; r2 = raw; }
    if (isx) {
#pragma unroll
        for (int tt = 0; tt < 4; ++tt) zs[hh2 * 256 + tt * 64 + p2] = bf2f(zv[tt]); }
    if (tid < 16) { const float dt = softplus(dtr + dtb); dts[tid] = dt; dAs[tid] = __expf(dt * an); }
    __syncthreads();
#pragma unroll
    for (int tt = 0; tt < 4; ++tt) {
        f32x4 Bv[4], Cv[4];
#pragma unroll
        for (int i = 0; i < 4; ++i) { Bv[i] = *(const LAS f32x4*)(Bs + tt * 128 + 32 * i + 4 * ns); Cv[i] = *(const LAS f32x4*)(Cs + tt * 128 + 32 * i + 4 * ns); }
#pragma unroll
        for (int hh = 0; hh < 4; ++hh) { const float dA = dAs[hh * 4 + tt], xdt = xs[hh * 256 + tt * 64 + p] * dts[hh * 4 + tt];
            f32x4 y4 = (f32x4){0.f, 0.f, 0.f, 0.f};
#pragma unroll
            for (int i = 0; i < 4; ++i) { s[hh][i] = s[hh][i] * dA + Bv[i] * xdt; y4 += s[hh][i] * Cv[i]; }
            const float y = sum8((y4[0] + y4[1]) + (y4[2] + y4[3])); if (ns == 0) yb[hh * 256 + tt * 64 + p] = y; }
    }
#pragma unroll
    for (int hh = 0; hh < 4; ++hh) { float* sp = P.out + O_SSSD + ((size_t)((l * 128 + b) * 16 + 4 * g + hh) * 64 + p) * 128 + 4 * ns;
#pragma unroll
        for (int i = 0; i < 4; ++i) *(f32x4*)(sp + 32 * i) = s[hh][i]; }
    __syncthreads();
    { const int pair = (tid >> 4) & 15, q = tid & 15, hh = pair >> 2, tt = pair & 3, h = 4 * g + hh;
      f32x4 v = *(const LAS f32x4*)(yb + pair * 64 + 4 * q); const f32x4 xv4 = *(const LAS f32x4*)(xs + pair * 64 + 4 * q), z4 = *(const LAS f32x4*)(zs + pair * 64 + 4 * q);
      const float Dh = P.in[I_SSDD][l * 16 + h];
      v[0] = (v[0] + Dh * xv4[0]) * silu(z4[0]); v[1] = (v[1] + Dh * xv4[1]) * silu(z4[1]); v[2] = (v[2] + Dh * xv4[2]) * silu(z4[2]); v[3] = (v[3] + Dh * xv4[3]) * silu(z4[3]);
      float sq = (v[0] * v[0] + v[1] * v[1]) + (v[2] * v[2] + v[3] * v[3]);
      sq = sum8(sq); sq = DPP_ADD(sq, 0x140);
      if (tid < 256) { const size_t row = (size_t)(row0 + tt); const f32x4 wv = *(const f32x4*)(P.in[I_SSDNW] + l * 1024 + h * 64 + 4 * q);
          u32x2 o; o.x = cvt_pk_bf16(v[0] * wv[0], v[1] * wv[1]); o.y = cvt_pk_bf16(v[2] * wv[2], v[3] * wv[3]);
          *(u32x2*)((bf16_t*)(P.ws + OFF_XN) + row * DM + h * 64 + 4 * q) = o;
          if (q == 0) ((float*)(P.ws + OFF_SSQ))[row * 16 + h] = sq; } }
    __syncthreads();
}

template <int KT>
__device__ __forceinline__ f32x4 mma_rt(const LAS bf16_t* A, int pa, const LAS bf16_t* Bt, int pb, f32x4 acc, int lane) {
    const LAS bf16_t* ap = A + (lane & 15) * pa + (lane >> 4) * 8; const LAS bf16_t* bp = Bt + (lane & 15) * pb + (lane >> 4) * 8;
#pragma unroll
    for (int kt = 0; kt < KT; ++kt) { const bf16x8 a = *(const LAS bf16x8*)(ap + kt * 32), b = *(const LAS bf16x8*)(bp + kt * 32); acc = __builtin_amdgcn_mfma_f32_16x16x32_bf16(a, b, acc, 0, 0, 0); }
    return acc;
}

__device__ __forceinline__ void ssd_mfma_item(const Params& P, int l, int b, int h, LAS unsigned char* L, int tid) {
    constexpr int PC = 136, PT = 72;
    LAS bf16_t* Cl = (LAS bf16_t*)L; LAS bf16_t* Bl = (LAS bf16_t*)(L + 17408); LAS bf16_t* BTl = (LAS bf16_t*)(L + 34816); LAS float* ybuf = (LAS float*)(L + 34816);
    LAS bf16_t* XdT = (LAS bf16_t*)(L + 53248); LAS bf16_t* XwT = (LAS bf16_t*)(L + 62464); LAS bf16_t* Gl = (LAS bf16_t*)(L + 71680); LAS bf16_t* Sl = (LAS bf16_t*)(L + 80896);
    LAS float* xf = (LAS float*)(L + 98304); LAS float* dtl = (LAS float*)(L + 114688); LAS float* acl = dtl + 64;
    const bf16_t* proj = (const bf16_t*)(P.ws + OFF_PROJ);
    const int lane = tid & 63, w = tid >> 6, kq = lane >> 4, lc = lane & 15, g = h >> 2, row0 = b * 2048;
    const float dt_bias = P.in[I_DTB][l * 16 + h], aneg = -__expf(P.in[I_ALOG][l * 16 + h]), Dh = P.in[I_SSDD][l * 16 + h];
    const bool stg = tid < 320;
#define SSD_TASK(TK) const int task_ = (TK) == 0 ? tid : 512 + tid; const bool tv_ = (TK) == 0 || tid < 128; const int oct_ = task_ % 40, rg4_ = task_ / 40; \
        const int kind_ = oct_ < 16 ? 0 : (oct_ < 32 ? 1 : 2); const int ch0_ = kind_ == 0 ? oct_ * 8 : (kind_ == 1 ? (oct_ - 16) * 8 : (oct_ - 32) * 8); \
        const int xc0_ = kind_ == 0 ? 1024 + g * 128 + ch0_ : (kind_ == 1 ? 1536 + g * 128 + ch0_ : h * 64 + ch0_); const int cbase_ = kind_ == 0 ? ch0_ : (kind_ == 1 ? 128 + ch0_ : 256 + ch0_); const int s0_ = rg4_ * 4;
    LAS float* wl = (LAS float*)(L + 115200);
    LAS float* nwl = wl + 1600;
    if (stg) { const int xc = tid < 128 ? 1024 + g * 128 + tid : (tid < 256 ? 1536 + g * 128 + (tid - 128) : h * 64 + (tid - 256));
        const float* cwp = P.in[I_CONVW] + (size_t)l * 4 * 2048 + xc;
        wl[tid] = cwp[0]; wl[320 + tid] = cwp[2048]; wl[640 + tid] = cwp[4096]; wl[960 + tid] = cwp[6144]; wl[1280 + tid] = P.in[I_CONVB][l * 2048 + xc]; }
    else if (tid < 384) nwl[tid - 320] = P.in[I_SSDNW][l * 1024 + h * 64 + (tid - 320)];
    for (int i = tid; i < 64 * PC / 2; i += NTH) ((LAS unsigned*)Sl)[i] = 0u;
    f32x4 accS[4];
#pragma unroll
    for (int i = 0; i < 4; ++i) accS[i] = (f32x4){0.f, 0.f, 0.f, 0.f};
    bf16_t* Assd = (bf16_t*)(P.ws + OFF_XN); float* ssq = (float*)(P.ws + OFF_SSQ);
    u32x4 raw[2][7]; unsigned short dtraw = 0; u32x4 zraw;
#define SSDM_LOAD(C) do { _Pragma("unroll") for (int tk = 0; tk < 2; ++tk) { SSD_TASK(tk) if (tv_) { _Pragma("unroll") for (int r = 0; r < 7; ++r) { const int gr_ = (C) * 64 + s0_ - 3 + r; \
            raw[tk][r] = gr_ >= 0 ? *(const u32x4*)(proj + (size_t)(row0 + gr_) * NPROJ + C_XBC + xc0_) : (u32x4){0u, 0u, 0u, 0u}; } } } \
        if (w == 0) dtraw = proj[(size_t)(row0 + (C) * 64 + lane) * NPROJ + C_DT + h]; \
        zraw = *(const u32x4*)(proj + (size_t)(row0 + (C) * 64 + (tid >> 3)) * NPROJ + C_Z + h * 64 + 8 * (tid & 7)); } while (0)
    SSDM_LOAD(0);
    __syncthreads();
    for (int c = 0; c < 32; ++c) {
        if (w == 0) { const float dt = softplus(bf2f(dtraw) + dt_bias); float a = dt * aneg;
            a = wave_prefix(a, lane);
            dtl[lane] = dt; acl[lane] = a; }
        const u32x4 zcur = zraw;
        __syncthreads();
#pragma unroll
        for (int tk = 0; tk < 2; ++tk) { SSD_TASK(tk)
          if (tv_) {
            float cw[4][8], cbv[8];
#pragma unroll
            for (int k = 0; k < 4; ++k) { const f32x4 a = *(const LAS f32x4*)(wl + k * 320 + cbase_), c4 = *(const LAS f32x4*)(wl + k * 320 + cbase_ + 4);
                cw[k][0] = a[0]; cw[k][1] = a[1]; cw[k][2] = a[2]; cw[k][3] = a[3]; cw[k][4] = c4[0]; cw[k][5] = c4[1]; cw[k][6] = c4[2]; cw[k][7] = c4[3]; }
            { const f32x4 a = *(const LAS f32x4*)(wl + 1280 + cbase_), c4 = *(const LAS f32x4*)(wl + 1280 + cbase_ + 4);
              cbv[0] = a[0]; cbv[1] = a[1]; cbv[2] = a[2]; cbv[3] = a[3]; cbv[4] = c4[0]; cbv[5] = c4[1]; cbv[6] = c4[2]; cbv[7] = c4[3]; }
            {
                float o8[4][8];
#pragma unroll
                for (int i = 0; i < 4; ++i) {
#pragma unroll
                    for (int j = 0; j < 8; ++j) { float y = cbv[j];
#pragma unroll
                        for (int k = 0; k < 4; ++k) { const u32x4 rr = raw[tk][i + k]; const unsigned wd = (j >> 1) == 0 ? rr.x : ((j >> 1) == 1 ? rr.y : ((j >> 1) == 2 ? rr.z : rr.w));
                            y += cw[k][j] * ((j & 1) ? bfhi(wd) : bflo(wd)); }
                        o8[i][j] = silu(y); } }
                const int s0 = s0_, kind = kind_, ch0 = ch0_;
                if (kind == 0) {
#pragma unroll
                    for (int i = 0; i < 4; ++i) *(LAS u32x4*)(Bl + (s0 + i) * PC + ch0) = pack8(o8[i][0], o8[i][1], o8[i][2], o8[i][3], o8[i][4], o8[i][5], o8[i][6], o8[i][7]);
#pragma unroll
                    for (int j = 0; j < 8; ++j) { u32x2 q; q.x = cvt_pk_bf16(o8[0][j], o8[1][j]); q.y = cvt_pk_bf16(o8[2][j], o8[3][j]); *(LAS u32x2*)(BTl + (ch0 + j) * PT + s0) = q; }
                } else if (kind == 1) {
#pragma unroll
                    for (int i = 0; i < 4; ++i) *(LAS u32x4*)(Cl + (s0 + i) * PC + ch0) = pack8(o8[i][0], o8[i][1], o8[i][2], o8[i][3], o8[i][4], o8[i][5], o8[i][6], o8[i][7]);
                } else {
                    const f32x4 d0 = *(const LAS f32x4*)(dtl + s0), a0 = *(const LAS f32x4*)(acl + s0);
                    const float alast = acl[63];
                    float dv[4] = {d0[0], d0[1], d0[2], d0[3]};
                    float ev[4] = {a0[0], a0[1], a0[2], a0[3]};
#pragma unroll
                    for (int i = 0; i < 4; ++i) ev[i] = dv[i] * __expf(alast - ev[i]);
#pragma unroll
                    for (int i = 0; i < 4; ++i) { *(LAS f32x4*)(xf + (s0 + i) * 64 + ch0) = (f32x4){o8[i][0], o8[i][1], o8[i][2], o8[i][3]}; *(LAS f32x4*)(xf + (s0 + i) * 64 + ch0 + 4) = (f32x4){o8[i][4], o8[i][5], o8[i][6], o8[i][7]}; }
#pragma unroll
                    for (int j = 0; j < 8; ++j) { u32x2 q;
                        q.x = cvt_pk_bf16(o8[0][j] * dv[0], o8[1][j] * dv[1]); q.y = cvt_pk_bf16(o8[2][j] * dv[2], o8[3][j] * dv[3]); *(LAS u32x2*)(XdT + (ch0 + j) * PT + s0) = q;
                        q.x = cvt_pk_bf16(o8[0][j] * ev[0], o8[1][j] * ev[1]); q.y = cvt_pk_bf16(o8[2][j] * ev[2], o8[3][j] * ev[3]); *(LAS u32x2*)(XwT + (ch0 + j) * PT + s0) = q; }
                }
            }
          }
        }
        __syncthreads();
        if (c + 1 < 32) SSDM_LOAD(c + 1);
        f32x4 y2[2];
#pragma unroll
        for (int ti = 0; ti < 2; ++ti) { const int tile = 2 * w + ti, qi = tile >> 2, si = tile & 3;
            f32x4 acc = (f32x4){0.f, 0.f, 0.f, 0.f};
            if (si <= qi) acc = mma_rt<4>(Cl + qi * 16 * PC, PC, Bl + si * 16 * PC, PC, acc, lane);
            const int q0 = qi * 16 + kq * 4, s = si * 16 + lc; const f32x4 aq = *(const LAS f32x4*)(acl + q0); const float as = acl[s];
#pragma unroll
            for (int j = 0; j < 4; ++j) { const float gv = (s <= q0 + j) ? acc[j] * __expf(aq[j] - as) : 0.f; Gl[(q0 + j) * PT + s] = f2bf(gv); }
            y2[ti] = mma_rt<4>(Cl + qi * 16 * PC, PC, Sl + si * 16 * PC, PC, (f32x4){0.f, 0.f, 0.f, 0.f}, lane);
        }
        __syncthreads();
        f32x4 yv[2];
#pragma unroll
        for (int ti = 0; ti < 2; ++ti) { const int tile = 2 * w + ti, qi = tile >> 2, pi = tile & 3;
            const f32x4 y1 = mma_rt<2>(Gl + qi * 16 * PT, PT, XdT + pi * 16 * PT, PT, (f32x4){0.f, 0.f, 0.f, 0.f}, lane);
            const f32x4 aq = *(const LAS f32x4*)(acl + qi * 16 + kq * 4);
#pragma unroll
            for (int j = 0; j < 4; ++j) yv[ti][j] = y1[j] + __expf(aq[j]) * y2[ti][j]; }
        { const float dec = __expf(acl[63]);
#pragma unroll
          for (int i = 0; i < 4; ++i) { const int tile = 4 * w + i, pi = tile >> 3, ni = tile & 7;
              accS[i] = accS[i] * dec; accS[i] = mma_rt<2>(XwT + pi * 16 * PT, PT, BTl + ni * 16 * PT, PT, accS[i], lane);
#pragma unroll
              for (int j = 0; j < 4; ++j) Sl[(pi * 16 + kq * 4 + j) * PC + ni * 16 + lc] = f2bf(accS[i][j]); } }
        __syncthreads();
#pragma unroll
        for (int ti = 0; ti < 2; ++ti) { const int tile = 2 * w + ti, qi = tile >> 2, pi = tile & 3;
#pragma unroll
            for (int j = 0; j < 4; ++j) ybuf[(qi * 16 + kq * 4 + j) * 68 + pi * 16 + lc] = yv[ti][j]; }
        __syncthreads();
        { const int tt = tid >> 3, q8 = tid & 7; const size_t row = (size_t)(row0 + c * 64 + tt);
          const f32x4 v0 = *(const LAS f32x4*)(ybuf + tt * 68 + 8 * q8), v1 = *(const LAS f32x4*)(ybuf + tt * 68 + 8 * q8 + 4);
          const f32x4 x0 = *(const LAS f32x4*)(xf + tt * 64 + 8 * q8), x1 = *(const LAS f32x4*)(xf + tt * 64 + 8 * q8 + 4);
          const f32x4 nw0 = *(const LAS f32x4*)(nwl + 8 * q8), nw1 = *(const LAS f32x4*)(nwl + 8 * q8 + 4);
          float o[8];
          o[0] = (v0[0] + Dh * x0[0]) * silu(bflo(zcur.x)); o[1] = (v0[1] + Dh * x0[1]) * silu(bfhi(zcur.x));
          o[2] = (v0[2] + Dh * x0[2]) * silu(bflo(zcur.y)); o[3] = (v0[3] + Dh * x0[3]) * silu(bfhi(zcur.y));
          o[4] = (v1[0] + Dh * x1[0]) * silu(bflo(zcur.z)); o[5] = (v1[1] + Dh * x1[1]) * silu(bfhi(zcur.z));
          o[6] = (v1[2] + Dh * x1[2]) * silu(bflo(zcur.w)); o[7] = (v1[3] + Dh * x1[3]) * silu(bfhi(zcur.w));
          float sq = 0.f;
#pragma unroll
          for (int j = 0; j < 8; ++j) sq += o[j] * o[j];
          sq = sum8(sq);
          *(u32x4*)(Assd + row * DM + h * 64 + 8 * q8) = pack8(o[0] * nw0[0], o[1] * nw0[1], o[2] * nw0[2], o[3] * nw0[3], o[4] * nw1[0], o[5] * nw1[1], o[6] * nw1[2], o[7] * nw1[3]);
          if (q8 == 0) ssq[row * 16 + h] = sq; }
    }
#undef SSDM_LOAD
#undef SSD_TASK
    { int t2 = tid; asm volatile("" : "+v"(t2)); const int lane = t2 & 63, w = t2 >> 6, kq = lane >> 4, lc = lane & 15;
      float* sp = P.out + O_PSSD + (size_t)((l * 8 + b) * 16 + h) * 64 * 128;
#pragma unroll
      for (int i = 0; i < 4; ++i) { const int tile = 4 * w + i, pi = tile >> 3, ni = tile & 7;
#pragma unroll
          for (int j = 0; j < 4; ++j) sp[(size_t)(pi * 16 + kq * 4 + j) * 128 + ni * 16 + lc] = accS[i][j]; } }
    __syncthreads();
}

__device__ __forceinline__ void hg_half(const Params& P, int l, bool prompt, int b, int hd, int vh, LAS unsigned char* L, int tid) {
    const int Lseq = prompt ? 2048 : 4, row0 = prompt ? b * 2048 : MP + b * 4;
    LAS float* fs = (LAS float*)L; LAS float* qs = fs + 4096; LAS float* vs = qs + 4096; LAS float* ob = vs + 2048;
    const bf16_t* proj = (const bf16_t*)(P.ws + OFF_PROJ); float* oraw = (float*)(P.ws + OFF_TCAT);
    int role = 3, col = 0, dstride = 128; LAS float* dst = fs; float lb = 0.f;
    if (tid < 128) { col = C_F + hd * 128 + tid; dst = fs + tid; role = 0;
        if (l > 0) { const float l0 = P.in[I_LB][hd * 128 + tid], l1 = P.in[I_LB][512 + hd * 128 + tid]; lb = 1.f / (1.f + expf(l0 - l1)); } }
    else if (tid < 256) { col = C_Q + hd * 128 + (tid - 128); dst = qs + (tid - 128); role = 1; }
    else if (tid < 320) { col = C_I + hd * 128 + vh * 64 + (tid - 256); dst = vs + (tid - 256); dstride = 64; role = 1; }
    const int v = tid >> 3, ks = tid & 7;
    f32x4 S[4];
    const size_t sbase = ((size_t)hd * 128) * 128 + vh * 64 + v;
    if (prompt) {
#pragma unroll
        for (int i = 0; i < 4; ++i) S[i] = (f32x4){0.f, 0.f, 0.f, 0.f};
    } else { const float* sp = P.in[I_HG] + (size_t)(l * 128 + b) * 4 * 16384 + sbase;
#pragma unroll
        for (int i = 0; i < 4; ++i)
#pragma unroll
            for (int j = 0; j < 4; ++j) S[i][j] = sp[(size_t)(32 * i + 4 * ks + j) * 128]; }
    unsigned short rv[4];
#define HG_LOAD(T0) do { if (role <= 1) { _Pragma("unroll") for (int tt = 0; tt < 4; ++tt) { int r_ = (T0) + tt; r_ = r_ < Lseq ? r_ : Lseq - 1; rv[tt] = proj[(size_t)(row0 + r_) * NPROJ + col]; } } } while (0)
    HG_LOAD(0);
    for (int t0 = 0; t0 < Lseq; t0 += 32) {
        const int len = (Lseq - t0) < 32 ? (Lseq - t0) : 32;
        if (role == 0) {
#pragma unroll
            for (int tt = 0; tt < 4; ++tt) { const float z = bf2f(rv[tt]); dst[tt * 128] = lb + (1.f - lb) * sigm(z); }
        } else if (role == 1) {
#pragma unroll
            for (int tt = 0; tt < 4; ++tt) dst[tt * dstride] = bf2f(rv[tt]);
        }
        __syncthreads();
        if (t0 + 32 < Lseq) HG_LOAD(t0 + 32);
#define HG_LD(Fx, Qx, vvx, TT) do { const int t_ = (TT) & 31; _Pragma("unroll") for (int i = 0; i < 4; ++i) { Fx[i] = *(const LAS f32x4*)(fs + t_ * 128 + 32 * i + 4 * ks); Qx[i] = *(const LAS f32x4*)(qs + t_ * 128 + 32 * i + 4 * ks); } \
            vvx = vs[t_ * 64 + v]; } while (0)
#define HG_STEP(Fx, Qx, vvx, TT) do { f32x4 o4_ = (f32x4){0.f, 0.f, 0.f, 0.f}; \
            _Pragma("unroll") for (int i = 0; i < 4; ++i) { S[i] = Fx[i] * (S[i] - vvx) + vvx; o4_ += S[i] * Qx[i]; } \
            const float o_ = sum8((o4_[0] + o4_[1]) + (o4_[2] + o4_[3])); if (ks == 0) ob[(TT) * 64 + v] = o_; } while (0)
        { f32x4 F0[4], Q0[4], F1[4], Q1[4]; float vv0, vv1;
          HG_LD(F0, Q0, vv0, 0);
          for (int tt = 0; tt < len; tt += 2) {
              HG_LD(F1, Q1, vv1, tt + 1);
              HG_STEP(F0, Q0, vv0, tt);
              HG_LD(F0, Q0, vv0, tt + 2);
              HG_STEP(F1, Q1, vv1, tt + 1);
          } }
        __syncthreads();
        { const int tt = tid >> 4, q = tid & 15;
          if (tt < len) *(f32x4*)(oraw + (size_t)(row0 + t0 + tt) * 512 + hd * 128 + vh * 64 + 4 * q) = *(const LAS f32x4*)(ob + tt * 64 + 4 * q); }
    }
    { float* sp = P.out + (prompt ? O_PHG + (size_t)(l * 8 + b) * 4 * 16384 : O_SHG + (size_t)(l * 128 + b) * 4 * 16384) + sbase;
#pragma unroll
      for (int i = 0; i < 4; ++i)
#pragma unroll
          for (int j = 0; j < 4; ++j) sp[(size_t)(32 * i + 4 * ks + j) * 128] = S[i][j]; }
    __syncthreads();
}
__device__ __forceinline__ void hg_mfma_half(const Params& P, int l, int b, int hd, int vh, LAS unsigned char* L, int tid) {
    constexpr int PC = 136, PT = 72;
    LAS bf16_t* Qt = (LAS bf16_t*)L; LAS bf16_t* Kt = (LAS bf16_t*)(L + 17408); LAS bf16_t* Qs = (LAS bf16_t*)(L + 34816); LAS bf16_t* Al = (LAS bf16_t*)(L + 52224);
    LAS bf16_t* VT = (LAS bf16_t*)(L + 61440); LAS bf16_t* KdT = (LAS bf16_t*)(L + 70656); LAS bf16_t* ST = (LAS bf16_t*)(L + 89088);
    LAS float* tot = (LAS float*)(L + 106496); LAS float* el = (LAS float*)(L + 114688); LAS float* lbl = (LAS float*)(L + 115200); LAS float* plx = (LAS float*)(L + 115712);
    const bf16_t* proj = (const bf16_t*)(P.ws + OFF_PROJ); float* oraw = (float*)(P.ws + OFF_TCAT);
    const int lane = tid & 63, w = tid >> 6, kq = lane >> 4, lc = lane & 15, row0 = b * 2048;
    const bool isf = tid < 256; const int t2 = tid & 255, oct = t2 & 15, rg = t2 >> 4, k0 = oct * 8, s0 = rg * 4;
    const bool hasv = !isf && oct < 8;
    const int colA = (isf ? C_F : C_Q) + hd * 128 + k0, colV = C_I + hd * 128 + vh * 64 + k0;
    if (tid < 128) { float lb = 0.f; if (l > 0) { const float l0 = P.in[I_LB][hd * 128 + tid], l1 = P.in[I_LB][512 + hd * 128 + tid]; lb = 1.f / (1.f + expf(l0 - l1)); } lbl[tid] = lb; }
    for (int i = tid; i < 64 * PC / 2; i += NTH) ((LAS unsigned*)ST)[i] = 0u;
    f32x4 accS[4];
#pragma unroll
    for (int i = 0; i < 4; ++i) accS[i] = (f32x4){0.f, 0.f, 0.f, 0.f};
    u32x4 rawA[4], rawV[4];
#define HGM_LOAD(C) do { _Pragma("unroll") for (int r = 0; r < 4; ++r) { const size_t ro_ = (size_t)(row0 + (C) * 64 + s0 + r) * NPROJ; \
            rawA[r] = *(const u32x4*)(proj + ro_ + colA); if (hasv) rawV[r] = *(const u32x4*)(proj + ro_ + colV); } } while (0)
#define UNP(rr, j) (((j) & 1) ? bfhi(((j) >> 1) == 0 ? (rr).x : (((j) >> 1) == 1 ? (rr).y : (((j) >> 1) == 2 ? (rr).z : (rr).w))) : bflo(((j) >> 1) == 0 ? (rr).x : (((j) >> 1) == 1 ? (rr).y : (((j) >> 1) == 2 ? (rr).z : (rr).w))))
    HGM_LOAD(0);
    __syncthreads();
    for (int c = 0; c < 32; ++c) {
        int tl_ = tid; asm volatile("" : "+v"(tl_));
        const int lane = tl_ & 63, w = tl_ >> 6, kq = lane >> 4, lc = lane & 15;
        const bool isf = tl_ < 256; const int t2 = tl_ & 255, oct = t2 & 15, rg = t2 >> 4, k0 = oct * 8, s0 = rg * 4;
        const bool hasv = !isf && oct < 8;
        const int colA = (isf ? C_F : C_Q) + hd * 128 + k0, colV = C_I + hd * 128 + vh * 64 + k0;
        float pl[4][8], kk[4][8];
        if (isf) {
            const f32x4 la = *(const LAS f32x4*)(lbl + k0), lb4 = *(const LAS f32x4*)(lbl + k0 + 4);
            const float lbv[8] = {la[0], la[1], la[2], la[3], lb4[0], lb4[1], lb4[2], lb4[3]};
#pragma unroll
            for (int j = 0; j < 8; ++j) { float run = 0.f;
#pragma unroll
                for (int i = 0; i < 4; ++i) { const float z = UNP(rawA[i], j); const float t = __expf(-z), r = __builtin_amdgcn_rcpf(1.f + t);
                    const float f = lbv[j] + (1.f - lbv[j]) * r; kk[i][j] = (1.f - lbv[j]) * t * r; run += __logf(f); pl[i][j] = run; } }
            *(LAS f32x4*)(tot + rg * 128 + k0) = (f32x4){pl[3][0], pl[3][1], pl[3][2], pl[3][3]}; *(LAS f32x4*)(tot + rg * 128 + k0 + 4) = (f32x4){pl[3][4], pl[3][5], pl[3][6], pl[3][7]};
#pragma unroll
            for (int i = 0; i < 4; ++i) { *(LAS f32x4*)(plx + (s0 + i) * 128 + k0) = (f32x4){pl[i][0], pl[i][1], pl[i][2], pl[i][3]}; *(LAS f32x4*)(plx + (s0 + i) * 128 + k0 + 4) = (f32x4){pl[i][4], pl[i][5], pl[i][6], pl[i][7]}; }
        } else {
#pragma unroll
            for (int i = 0; i < 4; ++i)
#pragma unroll
                for (int j = 0; j < 8; ++j) { pl[i][j] = 0.f; kk[i][j] = 0.f; }
            if (hasv) {
#pragma unroll
                for (int j = 0; j < 8; ++j) { u32x2 q; q.x = cvt_pk_bf16(UNP(rawV[0], j), UNP(rawV[1], j)); q.y = cvt_pk_bf16(UNP(rawV[2], j), UNP(rawV[3], j)); *(LAS u32x2*)(VT + (k0 + j) * PT + s0) = q; } }
        }
        __syncthreads();
        { float base[8], ref[8], bl[8];
#pragma unroll
          for (int j = 0; j < 8; ++j) { base[j] = 0.f; ref[j] = 0.f; bl[j] = 0.f; }
#pragma unroll
          for (int r = 0; r < 16; ++r) { const f32x4 t0 = *(const LAS f32x4*)(tot + r * 128 + k0), t1 = *(const LAS f32x4*)(tot + r * 128 + k0 + 4);
              const float tv[8] = {t0[0], t0[1], t0[2], t0[3], t1[0], t1[1], t1[2], t1[3]};
#pragma unroll
              for (int j = 0; j < 8; ++j) { if (r < rg) base[j] += tv[j]; if (r < 8) ref[j] += tv[j]; bl[j] += tv[j]; } }
          if (isf) {
              float kt[4][8], kd[4][8];
#pragma unroll
              for (int j = 0; j < 8; ++j) { const float e1 = __expf(bl[j] - ref[j]);
#pragma unroll
                  for (int i = 0; i < 4; ++i) { kt[i][j] = kk[i][j] * __expf(ref[j] - (base[j] + pl[i][j])); kd[i][j] = kt[i][j] * e1; } }
#pragma unroll
              for (int i = 0; i < 4; ++i) *(LAS u32x4*)(Kt + (s0 + i) * PC + k0) = pack8(kt[i][0], kt[i][1], kt[i][2], kt[i][3], kt[i][4], kt[i][5], kt[i][6], kt[i][7]);
#pragma unroll
              for (int j = 0; j < 8; ++j) { u32x2 q; q.x = cvt_pk_bf16(kd[0][j], kd[1][j]); q.y = cvt_pk_bf16(kd[2][j], kd[3][j]); *(LAS u32x2*)(KdT + (k0 + j) * PT + s0) = q; }
              if (rg == 0) { *(LAS f32x4*)(el + k0) = (f32x4){__expf(bl[0]), __expf(bl[1]), __expf(bl[2]), __expf(bl[3])}; *(LAS f32x4*)(el + k0 + 4) = (f32x4){__expf(bl[4]), __expf(bl[5]), __expf(bl[6]), __expf(bl[7])}; }
          } else {
              float e2[8];
#pragma unroll
              for (int j = 0; j < 8; ++j) e2[j] = __expf(ref[j]);
#pragma unroll
              for (int i = 0; i < 4; ++i) { float qt[8], qs[8];
                  const f32x4 p0 = *(const LAS f32x4*)(plx + (s0 + i) * 128 + k0), p1 = *(const LAS f32x4*)(plx + (s0 + i) * 128 + k0 + 4);
                  const float pv[8] = {p0[0], p0[1], p0[2], p0[3], p1[0], p1[1], p1[2], p1[3]};
#pragma unroll
                  for (int j = 0; j < 8; ++j) { const float qv = UNP(rawA[i], j); qt[j] = qv * __expf(base[j] + pv[j] - ref[j]); qs[j] = qt[j] * e2[j]; }
                  *(LAS u32x4*)(Qt + (s0 + i) * PC + k0) = pack8(qt[0], qt[1], qt[2], qt[3], qt[4], qt[5], qt[6], qt[7]);
                  *(LAS u32x4*)(Qs + (s0 + i) * PC + k0) = pack8(qs[0], qs[1], qs[2], qs[3], qs[4], qs[5], qs[6], qs[7]); }
          } }
        __syncthreads();
        if (c + 1 < 32) HGM_LOAD(c + 1);
        f32x4 o2[2];
#pragma unroll
        for (int ti = 0; ti < 2; ++ti) { const int tile = 2 * w + ti, qi = tile >> 2, si = tile & 3;
            f32x4 acc = (f32x4){0.f, 0.f, 0.f, 0.f};
            if (si <= qi) acc = mma_rt<4>(Qt + qi * 16 * PC, PC, Kt + si * 16 * PC, PC, acc, lane);
            const int q0 = qi * 16 + kq * 4, s = si * 16 + lc;
#pragma unroll
            for (int j = 0; j < 4; ++j) Al[(q0 + j) * PT + s] = f2bf((s <= q0 + j) ? acc[j] : 0.f);
            o2[ti] = mma_rt<4>(Qs + qi * 16 * PC, PC, ST + si * 16 * PC, PC, (f32x4){0.f, 0.f, 0.f, 0.f}, lane);
        }
        __syncthreads();
#pragma unroll
        for (int ti = 0; ti < 2; ++ti) { const int tile = 2 * w + ti, qi = tile >> 2, vi = tile & 3;
            const f32x4 o1 = mma_rt<2>(Al + qi * 16 * PT, PT, VT + vi * 16 * PT, PT, o2[ti], lane);
            float* op = oraw + (size_t)(row0 + c * 64 + qi * 16 + kq * 4) * 512 + hd * 128 + vh * 64 + vi * 16 + lc;
#pragma unroll
            for (int j = 0; j < 4; ++j) op[(size_t)j * 512] = o1[j]; }
#pragma unroll
        for (int i = 0; i < 4; ++i) { const int tile = 4 * w + i, vi = tile >> 3, ki = tile & 7;
            const float dec = el[ki * 16 + lc];
            accS[i] = accS[i] * dec; accS[i] = mma_rt<2>(VT + vi * 16 * PT, PT, KdT + ki * 16 * PT, PT, accS[i], lane);
#pragma unroll
            for (int j = 0; j < 4; ++j) ST[(vi * 16 + kq * 4 + j) * PC + ki * 16 + lc] = f2bf(accS[i][j]); }
        __syncthreads();
    }
#undef HGM_LOAD
#undef UNP
    { int t2 = tid; asm volatile("" : "+v"(t2)); const int lane = t2 & 63, w = t2 >> 6, kq = lane >> 4, lc = lane & 15;
      float* sp = P.out + O_PHG + (size_t)((l * 8 + b) * 4 + hd) * 16384 + vh * 64;
#pragma unroll
      for (int i = 0; i < 4; ++i) { const int tile = 4 * w + i, vi = tile >> 3, ki = tile & 7;
#pragma unroll
          for (int j = 0; j < 4; ++j) sp[(size_t)(ki * 16 + lc) * 128 + vi * 16 + kq * 4 + j] = accS[i][j]; } }
    __syncthreads();
}

__device__ __forceinline__ void hg_norm(const Params& P, int l, int row0, int nrows, int hd, int tid) {
    const int sub = tid & 7, rg = tid >> 3;
    const bf16_t* proj = (const bf16_t*)(P.ws + OFF_PROJ); const float* oraw = (const float*)(P.ws + OFF_TCAT); bf16_t* Ahg = (bf16_t*)(P.ws + OFF_AHG);
    const float* nwp = P.in[I_HGNW] + l * 512 + hd * 128 + 16 * sub;
    f32x4 nw[4];
#pragma unroll
    for (int i = 0; i < 4; ++i) nw[i] = *(const f32x4*)(nwp + 4 * i);
    for (int r = rg; r < ((nrows + 63) & ~63); r += 64) { const int rr = r < nrows ? r : nrows - 1; const size_t row = (size_t)(row0 + rr);
        const float* op = oraw + row * 512 + hd * 128 + 16 * sub;
        f32x4 o[4]; float ss = 0.f;
#pragma unroll
        for (int i = 0; i < 4; ++i) { o[i] = *(const f32x4*)(op + 4 * i); ss += (o[i][0] * o[i][0] + o[i][1] * o[i][1]) + (o[i][2] * o[i][2] + o[i][3] * o[i][3]); }
        const u32x4 g0 = *(const u32x4*)(proj + row * NPROJ + C_G + hd * 128 + 16 * sub), g1 = *(const u32x4*)(proj + row * NPROJ + C_G + hd * 128 + 16 * sub + 8);
        ss = sum8(ss);
        const float rstd = 1.f / sqrtf(ss * (1.f / 128.f) + EPSN);
        u32x4 w0, w1;
        w0.x = cvt_pk_bf16(o[0][0] * rstd * nw[0][0] * silu(bflo(g0.x)), o[0][1] * rstd * nw[0][1] * silu(bfhi(g0.x)));
        w0.y = cvt_pk_bf16(o[0][2] * rstd * nw[0][2] * silu(bflo(g0.y)), o[0][3] * rstd * nw[0][3] * silu(bfhi(g0.y)));
        w0.z = cvt_pk_bf16(o[1][0] * rstd * nw[1][0] * silu(bflo(g0.z)), o[1][1] * rstd * nw[1][1] * silu(bfhi(g0.z)));
        w0.w = cvt_pk_bf16(o[1][2] * rstd * nw[1][2] * silu(bflo(g0.w)), o[1][3] * rstd * nw[1][3] * silu(bfhi(g0.w)));
        w1.x = cvt_pk_bf16(o[2][0] * rstd * nw[2][0] * silu(bflo(g1.x)), o[2][1] * rstd * nw[2][1] * silu(bfhi(g1.x)));
        w1.y = cvt_pk_bf16(o[2][2] * rstd * nw[2][2] * silu(bflo(g1.y)), o[2][3] * rstd * nw[2][3] * silu(bfhi(g1.y)));
        w1.z = cvt_pk_bf16(o[3][0] * rstd * nw[3][0] * silu(bflo(g1.z)), o[3][1] * rstd * nw[3][1] * silu(bfhi(g1.z)));
        w1.w = cvt_pk_bf16(o[3][2] * rstd * nw[3][2] * silu(bflo(g1.w)), o[3][3] * rstd * nw[3][3] * silu(bfhi(g1.w)));
        if (r < nrows) { *(u32x4*)(Ahg + row * 512 + hd * 128 + 16 * sub) = w0; *(u32x4*)(Ahg + row * 512 + hd * 128 + 16 * sub + 8) = w1; }
    }
}

__device__ __forceinline__ void s5_item(const Params& P, int l, bool prompt, int bq, int g, LAS unsigned char* L, int tid) {
    const int lane = tid & 63, w = tid >> 6, n = lane, jc = lane & 15, tq = lane >> 4;
    LAS float* us = (LAS float*)(L + w * 14336); LAS bf16_t* Xc = (LAS bf16_t*)(L + w * 14336 + 1024); LAS float* BUl = (LAS float*)(L + w * 14336 + 5376); LAS float* hl = (LAS float*)(L + 8 * 14336);
    const bf16_t* proj = (const bf16_t*)(P.ws + OFF_PROJ); bf16_t* Aglu = (bf16_t*)(P.ws + OFF_AGLU);
    const int lg = l * 32 + g;
    const float delta = expf(P.in[I_S5LDT][lg]), lr = P.in[I_S5LR][lg * 64 + n], li = P.in[I_S5LI][lg * 64 + n];
    const float mag = expf(lr * delta), ab_re = mag * cosf(li * delta), ab_im = mag * sinf(li * delta);
    const float den = lr * lr + li * li, nr = ab_re - 1.f, co_re = (nr * lr + ab_im * li) / den, co_im = (ab_im * lr - nr * li) / den;
    bf16x8 Bu[8];
#pragma unroll
    for (int tile = 0; tile < 4; ++tile) { const int nn = tile * 16 + jc; const float cr = __shfl(co_re, nn), ci = __shfl(co_im, nn);
        u32x4 pr = (u32x4){0u, 0u, 0u, 0u}, pi = (u32x4){0u, 0u, 0u, 0u};
        if (tq < 2) { const f32x4* br4 = (const f32x4*)(P.in[I_S5BR] + ((size_t)lg * 64 + nn) * 16 + tq * 8); const f32x4* bi4 = (const f32x4*)(P.in[I_S5BI] + ((size_t)lg * 64 + nn) * 16 + tq * 8);
            const f32x4 a0 = br4[0], a1 = br4[1], c0 = bi4[0], c1 = bi4[1];
            pr = pack8(cr * a0[0] - ci * c0[0], cr * a0[1] - ci * c0[1], cr * a0[2] - ci * c0[2], cr * a0[3] - ci * c0[3], cr * a1[0] - ci * c1[0], cr * a1[1] - ci * c1[1], cr * a1[2] - ci * c1[2], cr * a1[3] - ci * c1[3]);
            pi = pack8(cr * c0[0] + ci * a0[0], cr * c0[1] + ci * a0[1], cr * c0[2] + ci * a0[2], cr * c0[3] + ci * a0[3], cr * c1[0] + ci * a1[0], cr * c1[1] + ci * a1[1], cr * c1[2] + ci * a1[2], cr * c1[3] + ci * a1[3]); }
        Bu[tile] = __builtin_bit_cast(bf16x8, pr); Bu[4 + tile] = __builtin_bit_cast(bf16x8, pi); }
    bf16x8 Breg[4];
    { const float* cr = P.in[I_S5CR] + ((size_t)lg * 16 + jc) * 64; const float* ci = P.in[I_S5CI] + ((size_t)lg * 16 + jc) * 64;
#pragma unroll
      for (int kt = 0; kt < 4; ++kt) { const float* src = (kt < 2 ? cr : ci) + (kt & 1) * 32 + tq * 8; const float sg = kt < 2 ? 1.f : -1.f;
          const f32x4 a = *(const f32x4*)src, c = *(const f32x4*)(src + 4);
          Breg[kt] = __builtin_bit_cast(bf16x8, pack8(sg * a[0], sg * a[1], sg * a[2], sg * a[3], sg * c[0], sg * c[1], sg * c[2], sg * c[3])); } }
    const float dj = P.in[I_S5D][l * 512 + g * 16 + jc];
    const int b = prompt ? bq : bq * 8 + w;
    const int rowseg = prompt ? b * 2048 + w * 256 : MP + b * 4;
    const int nchunk = prompt ? 16 : 1, clen = prompt ? 16 : 4;
    const int tA = jc < clen ? jc : clen - 1;
#define S5_LDA(CH) ((tq < 2) ? *(const u32x4*)(proj + (size_t)(rowseg + (CH) * 16 + tA) * NPROJ + C_U + g * 16 + tq * 8) : (u32x4){0u, 0u, 0u, 0u})
#define S5_BU(AF) do { const bf16x8 a_ = __builtin_bit_cast(bf16x8, (AF)); _Pragma("unroll") for (int tile = 0; tile < 8; ++tile) { \
        const f32x4 d_ = __builtin_amdgcn_mfma_f32_16x16x32_bf16(a_, Bu[tile], (f32x4){0.f, 0.f, 0.f, 0.f}, 0, 0, 0); \
        _Pragma("unroll") for (int j = 0; j < 4; ++j) BUl[(tq * 4 + j) * 132 + tile * 16 + jc] = d_[j]; } } while (0)
    float xr = 0.f, xi = 0.f;
    if (prompt) {
        u32x4 af = S5_LDA(0);
        for (int ch = 0; ch < nchunk; ++ch) {
            S5_BU(af);
            __syncthreads();
            if (ch + 1 < nchunk) af = S5_LDA(ch + 1);
            for (int tt = 0; tt < 16; ++tt) { const float bur = BUl[tt * 132 + n], bui = BUl[tt * 132 + 64 + n];
                const float nxr = ab_re * xr - ab_im * xi + bur, nxi = ab_re * xi + ab_im * xr + bui; xr = nxr; xi = nxi; }
            __syncthreads();
        }
        hl[(w * 64 + n) * 2] = xr; hl[(w * 64 + n) * 2 + 1] = xi;
        float pr_ = ab_re, pi_ = ab_im;
#pragma unroll
        for (int q = 0; q < 8; ++q) { const float a = pr_ * pr_ - pi_ * pi_, c = 2.f * pr_ * pi_; pr_ = a; pi_ = c; }
        __syncthreads();
        xr = 0.f; xi = 0.f;
        for (int ww = 0; ww < w; ++ww) { const float hr = hl[(ww * 64 + n) * 2], hi = hl[(ww * 64 + n) * 2 + 1]; const float a = pr_ * xr - pi_ * xi + hr, c = pr_ * xi + pi_ * xr + hi; xr = a; xi = c; }
    } else { xr = P.in[I_S5R][((size_t)(l * 128 + b) * 32 + g) * 64 + n]; xi = P.in[I_S5I][((size_t)(l * 128 + b) * 32 + g) * 64 + n]; }
    u32x2 uu2; { const int t = (lane >> 2) < clen ? (lane >> 2) : clen - 1; uu2 = *(const u32x2*)(proj + (size_t)(rowseg + t) * NPROJ + C_U + g * 16 + (lane & 3) * 4); }
    u32x4 af2 = S5_LDA(0);
    for (int ch = 0; ch < nchunk; ++ch) {
        { const int t = lane >> 2, q4 = lane & 3;
          *(LAS f32x4*)(us + t * 16 + q4 * 4) = (f32x4){bflo(uu2.x), bfhi(uu2.x), bflo(uu2.y), bfhi(uu2.y)}; }
        S5_BU(af2);
        __syncthreads();
        if (ch + 1 < nchunk) { uu2 = *(const u32x2*)(proj + (size_t)(rowseg + (ch + 1) * 16 + (lane >> 2)) * NPROJ + C_U + g * 16 + (lane & 3) * 4); af2 = S5_LDA(ch + 1); }
        for (int tt = 0; tt < clen; ++tt) { const float bur = BUl[tt * 132 + n], bui = BUl[tt * 132 + 64 + n];
            const float nxr = ab_re * xr - ab_im * xi + bur, nxi = ab_re * xi + ab_im * xr + bui; xr = nxr; xi = nxi;
            Xc[tt * 136 + n] = f2bf(xr); Xc[tt * 136 + 64 + n] = f2bf(xi); }
        __syncthreads();
        f32x4 acc = (f32x4){0.f, 0.f, 0.f, 0.f};
#pragma unroll
        for (int kt = 0; kt < 4; ++kt) { const bf16x8 a = *(const LAS bf16x8*)(Xc + jc * 136 + kt * 32 + tq * 8); acc = __builtin_amdgcn_mfma_f32_16x16x32_bf16(a, Breg[kt], acc, 0, 0, 0); }
#pragma unroll
        for (int j = 0; j < 4; ++j) { const int t = tq * 4 + j;
            if (t < clen) { const float y = acc[j] + dj * us[t * 16 + jc]; Aglu[(size_t)(rowseg + ch * 16 + t) * 512 + g * 16 + jc] = f2bf(gelu_tanh(y)); } }
        __syncthreads();
    }
#undef S5_LDA
#undef S5_BU
    if (prompt) { if (w == 7) { P.out[O_PS5R + ((size_t)(l * 8 + b) * 32 + g) * 64 + n] = xr; P.out[O_PS5I + ((size_t)(l * 8 + b) * 32 + g) * 64 + n] = xi; } }
    else { P.out[O_SS5R + ((size_t)(l * 128 + b) * 32 + g) * 64 + n] = xr; P.out[O_SS5I + ((size_t)(l * 128 + b) * 32 + g) * 64 + n] = xi; }
}

__device__ __forceinline__ void convstate_item(const Params& P, int l, int sq, int tid) {
    const bf16_t* proj = (const bf16_t*)(P.ws + OFF_PROJ);
    const bool pr = sq < 8; const int b = pr ? sq : sq - 8;
    const int rbase = pr ? b * 2048 + 2045 : MP + b * 4 + 1;
    float* dst = P.out + (pr ? O_PSSDC + (size_t)(l * 8 + b) * 3 * 2048 : O_SSSDC + (size_t)(l * 128 + b) * 3 * 2048);
    for (int e = tid; e < 768; e += NTH) { const int j = e >> 8, oc = e & 255;
        const u32x4 v = *(const u32x4*)(proj + (size_t)(rbase + j) * NPROJ + C_XBC + oc * 8);
        *(f32x4*)(dst + j * 2048 + oc * 8) = (f32x4){bflo(v.x), bfhi(v.x), bflo(v.y), bfhi(v.y)};
        *(f32x4*)(dst + j * 2048 + oc * 8 + 4) = (f32x4){bflo(v.z), bfhi(v.z), bflo(v.w), bfhi(v.w)}; }
}

constexpr int IT_SSDP = 128, IT_HGP = 64, IT_S5P = 256, IT_SSDS = 512, IT_HGS = 512, IT_S5S = 512, IT_CS = 136, IT_HGN = 128;
constexpr int IT_TOTAL = IT_SSDP + IT_HGP + IT_S5P + IT_SSDS + IT_HGS + IT_S5S + IT_CS + IT_HGN;
__device__ __forceinline__ void mix_phase(const Params& P, int l, LAS unsigned char* L, int tid_in, int rep = 0, int lo = 0, int hi = 1 << 30) {
    int tid = tid_in;
    unsigned* ctl = (unsigned*)(P.ws + OFF_CTL);
    volatile LAS int* misc = (volatile LAS int*)(L + MISC_OFF);
    for (;;) {
        if (tid == 0) misc[0] = (int)atomicAdd(ctl + l + 2 * rep, 1u);
        __syncthreads();
        int it = misc[0] + lo;
        __syncthreads();
        if (it >= IT_TOTAL || it >= hi) break;
        asm volatile("" : "+v"(tid));
        if (it < IT_SSDP) { ssd_mfma_item(P, l, it >> 4, it & 15, L, tid); continue; } it -= IT_SSDP;
        if (it < IT_HGP) { const int b = it >> 3, hd = (it >> 1) & 3, vh = it & 1;
            hg_mfma_half(P, l, b, hd, vh, L, tid);
            asm volatile("s_waitcnt vmcnt(0)" ::: "memory"); __syncthreads();
            if (tid == 0) { __builtin_amdgcn_fence(__ATOMIC_RELEASE, "agent"); asm volatile("s_waitcnt vmcnt(0)" ::: "memory"); (void)atomicAdd(ctl + 16 + rep * 64 + l * 32 + b * 4 + hd, 1u); }
            continue; } it -= IT_HGP;
        if (it < IT_S5P) { s5_item(P, l, true, it >> 5, it & 31, L, tid); continue; } it -= IT_S5P;
        if (it < IT_SSDS) { ssd_s4_item(P, l, it >> 2, it & 3, L, tid); continue; } it -= IT_SSDS;
        if (it < IT_HGS) { const int b = it >> 2, hd = it & 3;
            hg_half(P, l, false, b, hd, 0, L, tid); hg_half(P, l, false, b, hd, 1, L, tid);
            asm volatile("s_waitcnt vmcnt(0)" ::: "memory"); __syncthreads();
            hg_norm(P, l, MP + b * 4, 4, hd, tid);
            continue; } it -= IT_HGS;
        if (it < IT_S5S) { s5_item(P, l, false, it >> 5, it & 31, L, tid); continue; } it -= IT_S5S;
        if (it < IT_CS) { convstate_item(P, l, it, tid); continue; } it -= IT_CS;
        { const int bh = it >> 2, rq = it & 3;
          if (tid == 0) { unsigned* c = ctl + 16 + rep * 64 + l * 32 + bh; unsigned sp = 0;
              while (__hip_atomic_load(c, __ATOMIC_RELAXED, __HIP_MEMORY_SCOPE_AGENT) < 2u && ++sp < (1u << 24)) __builtin_amdgcn_s_sleep(8); }
          __syncthreads();
          __builtin_amdgcn_fence(__ATOMIC_ACQUIRE, "agent"); asm volatile("s_waitcnt vmcnt(0)" ::: "memory");
          hg_norm(P, l, (bh >> 2) * 2048 + rq * 512, 512, bh & 3, tid); }
    }
}

__device__ __forceinline__ void small_res_gemm(const bf16_t* A, const bf16_t* Bt, int K, const Params& P, int from_in, int tid, int bid) {
    const int lane = tid & 63, w = tid >> 6, kq = lane >> 4, lc = lane & 15;
    for (int t = bid; t < 256; t += gridDim.x) {
        const int rt = t >> 4, ct = t & 15, r0 = MP + rt * 32 + (w >> 2) * 16, c0 = ct * 64 + (w & 3) * 16;
        const bf16_t* ap = A + (size_t)(r0 + lc) * K + kq * 8; const bf16_t* bp = Bt + (size_t)(c0 + lc) * K + kq * 8;
        f32x4 acc = (f32x4){0.f, 0.f, 0.f, 0.f};
        { bf16x8 a0[8], b0[8], a1[8], b1[8]; const int nb = K >> 8;
#define SG_LD(AX, BX, I) do { _Pragma("unroll") for (int i_ = 0; i_ < 8; ++i_) { AX[i_] = *(const bf16x8*)(ap + (I) * 256 + i_ * 32); BX[i_] = *(const bf16x8*)(bp + (I) * 256 + i_ * 32); } } while (0)
#define SG_MM(AX, BX) do { _Pragma("unroll") for (int i_ = 0; i_ < 8; ++i_) acc = __builtin_amdgcn_mfma_f32_16x16x32_bf16(AX[i_], BX[i_], acc, 0, 0, 0); } while (0)
          SG_LD(a0, b0, 0);
          for (int i = 0; i < nb; i += 2) {
              if (i + 1 < nb) SG_LD(a1, b1, i + 1);
              SG_MM(a0, b0);
              if (i + 2 < nb) SG_LD(a0, b0, i + 2);
              if (i + 1 < nb) SG_MM(a1, b1);
          }
#undef SG_LD
#undef SG_MM
        }
#pragma unroll
        for (int j = 0; j < 4; ++j) { const int r = r0 + kq * 4 + j, c = c0 + lc;
            const float base = from_in ? P.in[I_XS][(size_t)(r - MP) * DM + c] : P.out[(size_t)r * DM + c];
            P.out[(size_t)r * DM + c] = base + acc[j]; }
    }
}

template <int MODE>
__device__ __forceinline__ void small_sg_gemm(const bf16_t* A, const bf16_t* Bt, int K, const Params& P, int tid, int bid) {
    const int lane = tid & 63, w = tid >> 6, kq = lane >> 4, lc = lane & 15;
    for (int t = bid; t < 256; t += gridDim.x) {
        const int rt = t >> 4, ct = t & 15, r0 = MP + rt * 32 + (w >> 2) * 16, c0 = ct * 64 + (w & 3) * 16;
        const bf16_t* ap = A + (size_t)(r0 + lc) * K + kq * 8; const bf16_t* bp = Bt + (size_t)(c0 + lc) * K + kq * 8;
        f32x4 acc = (f32x4){0.f, 0.f, 0.f, 0.f};
        { bf16x8 a0[8], b0[8], a1[8], b1[8]; const int nb = K >> 8;
#define SG_LD(AX, BX, I) do { _Pragma("unroll") for (int i_ = 0; i_ < 8; ++i_) { AX[i_] = *(const bf16x8*)(ap + (I) * 256 + i_ * 32); BX[i_] = *(const bf16x8*)(bp + (I) * 256 + i_ * 32); } } while (0)
#define SG_MM(AX, BX) do { _Pragma("unroll") for (int i_ = 0; i_ < 8; ++i_) acc = __builtin_amdgcn_mfma_f32_16x16x32_bf16(AX[i_], BX[i_], acc, 0, 0, 0); } while (0)
          SG_LD(a0, b0, 0);
          for (int i = 0; i < nb; i += 2) {
              if (i + 1 < nb) SG_LD(a1, b1, i + 1);
              SG_MM(a0, b0);
              if (i + 2 < nb) SG_LD(a0, b0, i + 2);
              if (i + 1 < nb) SG_MM(a1, b1);
          }
#undef SG_LD
#undef SG_MM
        }
#pragma unroll
        for (int j = 0; j < 4; ++j) { const int r = r0 + kq * 4 + j, c = c0 + lc;
            const bf16_t* proj = (const bf16_t*)(P.ws + OFF_PROJ); bf16_t* mp = (bf16_t*)(P.ws + OFF_TCAT) + (size_t)r * 1024 + c;
            float val = sigm(bf2f(proj[(size_t)r * NPROJ + C_GATE + MODE * 1024 + c])) * acc[j];
            if (MODE == 1) { const f32x4* sp = (const f32x4*)((const float*)(P.ws + OFF_SSQ) + (size_t)r * 16); const f32x4 s0 = sp[0], s1 = sp[1], s2 = sp[2], s3 = sp[3];
                const float tot = ((s0[0] + s0[1]) + (s0[2] + s0[3])) + ((s1[0] + s1[1]) + (s1[2] + s1[3])) + ((s2[0] + s2[1]) + (s2[2] + s2[3])) + ((s3[0] + s3[1]) + (s3[2] + s3[3]));
                val *= 1.f / sqrtf(tot * (1.f / 1024.f) + EPSN); *mp = f2bf(val); }
            else *mp = f2bf(bf2f(*mp) + val); }
    }
}

__device__ __forceinline__ void small_g1_tail(const bf16_t* A, const bf16_t* Bt, bf16_t* proj, int tid, int bid) {
    const int lane = tid & 63, w = tid >> 6, kq = lane >> 4, lc = lane & 15;
    const bf16_t* bp = Bt + (size_t)(8704 + lc) * 1024 + kq * 8;
    for (int t = bid * 8 + w; t < MT / 16; t += gridDim.x * 8) {
        const bf16_t* ap = A + (size_t)(t * 16 + lc) * 1024 + kq * 8;
        f32x4 acc = (f32x4){0.f, 0.f, 0.f, 0.f};
        bf16x8 a0[8], b0[8], a1[8], b1[8];
#define SG_LD(AX, BX, I) do { _Pragma("unroll") for (int i_ = 0; i_ < 8; ++i_) { AX[i_] = *(const bf16x8*)(ap + (I) * 256 + i_ * 32); BX[i_] = *(const bf16x8*)(bp + (I) * 256 + i_ * 32); } } while (0)
#define SG_MM(AX, BX) do { _Pragma("unroll") for (int i_ = 0; i_ < 8; ++i_) acc = __builtin_amdgcn_mfma_f32_16x16x32_bf16(AX[i_], BX[i_], acc, 0, 0, 0); } while (0)
        SG_LD(a0, b0, 0); SG_LD(a1, b1, 1); SG_MM(a0, b0); SG_LD(a0, b0, 2); SG_MM(a1, b1); SG_LD(a1, b1, 3); SG_MM(a0, b0); SG_MM(a1, b1);
#undef SG_LD
#undef SG_MM
#pragma unroll
        for (int j = 0; j < 4; ++j) proj[(size_t)(t * 16 + kq * 4 + j) * NPROJ + 8704 + lc] = f2bf(acc[j]);
    }
}

template <int MODE>
__device__ __forceinline__ void small_gemm_ks(const bf16_t* A, const bf16_t* Bt, const int K, const Params& P, int from_in, LAS unsigned char* L, int tid, int bid) {
    const int lane = tid & 63, w = tid >> 6, kq = lane >> 4, lc = lane & 15;
    LAS float* red = (LAS float*)L;
    const int ks = K >> 3, nst = ks >> 5;
    for (int t = bid; t < 256; t += gridDim.x) {
        const int rbase = MP + (t >> 4) * 32, cbase = (t & 15) * 64;
        const bf16_t* ap = A + (size_t)(rbase + lc) * K + w * ks + kq * 8; const bf16_t* bp = Bt + (size_t)(cbase + lc) * K + w * ks + kq * 8;
        f32x4 acc[2][4];
#pragma unroll
        for (int i = 0; i < 2; ++i)
#pragma unroll
            for (int j = 0; j < 4; ++j) acc[i][j] = (f32x4){0.f, 0.f, 0.f, 0.f};
        for (int s0 = 0; s0 < nst; s0 += 6) {
            bf16x8 a[6][2], b[6][4];
#pragma unroll
            for (int i = 0; i < 6; ++i) if (s0 + i < nst) {
#pragma unroll
                for (int r = 0; r < 2; ++r) a[i][r] = *(const bf16x8*)(ap + (size_t)r * 16 * K + (s0 + i) * 32);
#pragma unroll
                for (int c = 0; c < 4; ++c) b[i][c] = *(const bf16x8*)(bp + (size_t)c * 16 * K + (s0 + i) * 32); }
#pragma unroll
            for (int i = 0; i < 6; ++i) if (s0 + i < nst) {
#pragma unroll
                for (int r = 0; r < 2; ++r)
#pragma unroll
                    for (int c = 0; c < 4; ++c) acc[r][c] = __builtin_amdgcn_mfma_f32_16x16x32_bf16(a[i][r], b[i][c], acc[r][c], 0, 0, 0); }
        }
#pragma unroll
        for (int r = 0; r < 2; ++r)
#pragma unroll
            for (int c = 0; c < 4; ++c) *(LAS f32x4*)(red + ((w * 8 + r * 4 + c) * 64 + lane) * 4) = acc[r][c];
        __syncthreads();
        f32x4 sum = (f32x4){0.f, 0.f, 0.f, 0.f};
#pragma unroll
        for (int ww = 0; ww < 8; ++ww) sum += *(const LAS f32x4*)(red + ((ww * 8 + w) * 64 + lane) * 4);
        const int r0 = rbase + (w >> 2) * 16, c0 = cbase + (w & 3) * 16;
#pragma unroll
        for (int j = 0; j < 4; ++j) { const int r = r0 + kq * 4 + j, c = c0 + lc;
            if (MODE == 0) { const float base = from_in ? P.in[I_XS][(size_t)(r - MP) * DM + c] : P.out[(size_t)r * DM + c]; P.out[(size_t)r * DM + c] = base + sum[j]; }
            else { const bf16_t* proj = (const bf16_t*)(P.ws + OFF_PROJ); bf16_t* mp = (bf16_t*)(P.ws + OFF_TCAT) + (size_t)r * 1024 + c;
                float val = sigm(bf2f(proj[(size_t)r * NPROJ + C_GATE + MODE * 1024 + c])) * sum[j];
                if (MODE == 1) { const f32x4* sp = (const f32x4*)((const float*)(P.ws + OFF_SSQ) + (size_t)r * 16); const f32x4 s0 = sp[0], s1 = sp[1], s2 = sp[2], s3 = sp[3];
                    const float tot = ((s0[0] + s0[1]) + (s0[2] + s0[3])) + ((s1[0] + s1[1]) + (s1[2] + s1[3])) + ((s2[0] + s2[1]) + (s2[2] + s2[3])) + ((s3[0] + s3[1]) + (s3[2] + s3[3]));
                    val *= 1.f / sqrtf(tot * (1.f / 1024.f) + EPSN); *mp = f2bf(val); }
                else *mp = f2bf(bf2f(*mp) + val); } }
        __syncthreads();
    }
}

#define XB_TMO      128
#define XB_XCNT(j)  (256  + 64 * (j))
#define XB_XSUB(j)  (1280 + 64 * (j))
#define XB_XGEN(j)  (2304 + 64 * (j))
#define XB_TOP      3328
#define XB_TOPGEN   3392
#define XCD_BAR_WORDS 3456
#define XB_SPIN_CAP (1u << 18)
__device__ __forceinline__ unsigned xb_ld(unsigned* p)              { return __hip_atomic_load(p, __ATOMIC_RELAXED, __HIP_MEMORY_SCOPE_AGENT); }
__device__ __forceinline__ unsigned xb_add(unsigned* p, unsigned v) { return __hip_atomic_fetch_add(p, v, __ATOMIC_RELAXED, __HIP_MEMORY_SCOPE_AGENT); }
__device__ __forceinline__ unsigned xb_xcc_id() { return (unsigned)__builtin_amdgcn_s_getreg((3 << 11) | 20) & 0xFu; }
#define XB_SPIN(cond, bar) do { unsigned _sp = 0; while (cond) { __builtin_amdgcn_s_sleep(1); \
    if ((++_sp & 255u) == 0u) { if (xb_ld(&(bar)[XB_TMO])) break; if (_sp > XB_SPIN_CAP) { atomicAdd(&(bar)[XB_TMO], 1u); break; } } } } while (0)
__device__ __forceinline__ void xcd_barrier_post(unsigned* bar, int tid) { if (tid == 0) (void)xb_add(&bar[XB_XCNT(xb_xcc_id())], 1u); }
__device__ __forceinline__ void xcd_barrier_complete(unsigned* bar, unsigned x, unsigned& nloc, unsigned& nx) {
    const unsigned G = gridDim.x;
    unsigned sum, cnt, mine, sp = 0u;
    for (;;) {
        sum = 0u; cnt = 0u; mine = 0u;
#pragma unroll
        for (unsigned j = 0; j < 16; ++j) { const unsigned c = xb_ld(&bar[XB_XCNT(j)]); sum += c; cnt += (c > 0u) ? 1u : 0u; mine = (j == x) ? c : mine; }
        if (sum == G) break;
        __builtin_amdgcn_s_sleep(1);
        if ((++sp & 255u) == 0u) { if (xb_ld(&bar[XB_TMO])) break; if (sp > XB_SPIN_CAP) { atomicAdd(&bar[XB_TMO], 1u); break; } }
    }
    nloc = mine > 0u ? mine : 1u; nx = cnt > 0u ? cnt : 1u;
}
__device__ __forceinline__ void xcd_barrier(unsigned* bar, volatile LAS unsigned* st, int tid) {
    asm volatile("s_waitcnt vmcnt(0)" ::: "memory");
    __syncthreads();
    if (tid == 0) {
        const unsigned x = xb_xcc_id();
        __builtin_amdgcn_s_waitcnt(0);
        unsigned nloc = st[0], nx = st[1];
        if (nloc == 0u) { xcd_barrier_complete(bar, x, nloc, nx); st[0] = nloc; st[1] = nx; }
        const unsigned old = xb_add(&bar[XB_XSUB(x)], 1u);
        const unsigned gen = old / nloc;
        if (old + 1u == (gen + 1u) * nloc) {
            __builtin_amdgcn_fence(__ATOMIC_RELEASE, "agent");
            asm volatile("s_waitcnt vmcnt(0)" ::: "memory");
            const unsigned og = xb_add(&bar[XB_TOP], 1u);
            const unsigned tg = og / nx;
            if (og + 1u == (tg + 1u) * nx) xb_add(&bar[XB_TOPGEN], 1u);
            else XB_SPIN(xb_ld(&bar[XB_TOPGEN]) == tg, bar);
            __builtin_amdgcn_fence(__ATOMIC_ACQUIRE, "agent");
            xb_add(&bar[XB_XGEN(x)], 1u);
            asm volatile("s_waitcnt vmcnt(0)" ::: "memory");
        } else {
            XB_SPIN(xb_ld(&bar[XB_XGEN(x)]) == gen, bar);
            __builtin_amdgcn_fence(__ATOMIC_ACQUIRE, "agent");
            asm volatile("s_waitcnt vmcnt(0)" ::: "memory");
        }
    }
    __syncthreads();
}

__global__ void __launch_bounds__(NTH, 2) mega(Params P) {
    extern __shared__ __attribute__((aligned(16))) unsigned char lds_raw[];
    LAS unsigned char* L = (LAS unsigned char*)lds_raw;
    cg::grid_group grid = cg::this_grid();
    const int G = gridDim.x;
    const int wave_s = __builtin_amdgcn_readfirstlane((int)threadIdx.x >> 6);
#define TIDL() ({ int ln_; asm volatile("v_mbcnt_lo_u32_b32 %0, -1, 0\n\tv_mbcnt_hi_u32_b32 %0, -1, %0" : "=v"(ln_)); int t_ = wave_s * 64 + ln_; t_; })
#define BIDL() ({ int b_ = blockIdx.x; asm volatile("" : "+s"(b_)); b_; })
    const int tid0 = TIDL();
    unsigned char* ws = P.ws;
    unsigned* barw = (unsigned*)(ws + OFF_BAR);
    volatile LAS unsigned* xst = (volatile LAS unsigned*)(L + MISC_OFF + 16);
    if (tid0 == 0) { xst[0] = 0u; xst[1] = 0u; }
    __syncthreads();
    xcd_barrier_post(barw, tid0);
    if (ws == nullptr) grid.sync();
#define GSYNC() xcd_barrier(barw, xst, TIDL())
#ifndef DUP
#define DUP 0
#endif
#pragma unroll 1
    for (int l = 0; l < 2; ++l) {
        convert_weights(P, l, L, TIDL());
        if (DUP & 4) convert_weights(P, l, L, TIDL());
        norm_rows_bf16(P, l == 0, P.in[I_N1W] + l * 1024, (bf16_t*)(ws + OFF_XN), TIDL());
        GSYNC();
        small_g1_tail((const bf16_t*)(ws + OFF_XN), (const bf16_t*)(ws + W_IN), (bf16_t*)(ws + OFF_PROJ), TIDL(), BIDL());
        { Gemm g{(const bf16_t*)(ws + OFF_XN), (const bf16_t*)(ws + W_IN), MT, 8704, 1024}; StaticOrder S; S.init(MT, 8704, G, BIDL());
          EpiStoreBf16 E{(bf16_t*)(ws + OFF_PROJ), NPROJ}; gemm_phase(L, g, S, E, TIDL()); if (DUP & 2) gemm_phase(L, g, S, E, TIDL()); }
        GSYNC();
        mix_phase(P, l, L, TIDL());
        GSYNC();
        if (DUP & 1) { mix_phase(P, l, L, TIDL(), 1); GSYNC(); }
        if (DUP & 64) { mix_phase(P, l, L, TIDL(), 1, IT_SSDP + IT_HGP, IT_SSDP + IT_HGP + IT_S5P); GSYNC(); }
        if (DUP & 1024) { mix_phase(P, l, L, TIDL(), 1, 0, IT_SSDP); GSYNC(); }
        if (DUP & 2048) { mix_phase(P, l, L, TIDL(), 1, IT_SSDP, IT_SSDP + IT_HGP); GSYNC(); }
        if (DUP & 128) { mix_phase(P, l, L, TIDL(), 1, IT_SSDP + IT_HGP + IT_S5P, IT_TOTAL); GSYNC(); }
        small_gemm_ks<1>((const bf16_t*)(ws + OFF_XN), (const bf16_t*)(ws + W_SSD), 1024, P, 0, L, TIDL(), BIDL());
        { Gemm g{(const bf16_t*)(ws + OFF_XN), (const bf16_t*)(ws + W_SSD), MP, 1024, 1024}; StaticOrder S; S.init(MP, 1024, G, BIDL());
          EpiSG<true, false> E{(const bf16_t*)(ws + OFF_PROJ), (bf16_t*)(ws + OFF_TCAT), (const float*)(ws + OFF_SSQ), 1}; gemm_phase(L, g, S, E, TIDL()); }
        GSYNC();
        { Gemm g{(const bf16_t*)(ws + OFF_AGLU), (const bf16_t*)(ws + W_GLU), MT, 2048, 512}; StaticOrder S; S.init(MT, 2048, G, BIDL());
          EpiGlu E{(const bf16_t*)(ws + OFF_PROJ), (bf16_t*)(ws + OFF_TCAT)}; gemm_phase(L, g, S, E, TIDL()); }
        GSYNC();
        small_gemm_ks<2>((const bf16_t*)(ws + OFF_AHG), (const bf16_t*)(ws + W_HG), 512, P, 0, L, TIDL(), BIDL());
        { Gemm g{(const bf16_t*)(ws + OFF_AHG), (const bf16_t*)(ws + W_HG), MP, 1024, 512}; StaticOrder S; S.init(MP, 1024, G, BIDL());
          EpiSG<false, true> E{(const bf16_t*)(ws + OFF_PROJ), (bf16_t*)(ws + OFF_TCAT), nullptr, 2}; gemm_phase(L, g, S, E, TIDL()); }
        GSYNC();
        small_gemm_ks<0>((const bf16_t*)(ws + OFF_TCAT), (const bf16_t*)(ws + W_O3), 1024, P, l == 0, L, TIDL(), BIDL());
        { Gemm g{(const bf16_t*)(ws + OFF_TCAT), (const bf16_t*)(ws + W_O3), MP, 1024, 1024}; StaticOrder S; S.init(MP, 1024, G, BIDL());
          EpiRes E{P.in[I_XP], P.in[I_XS], P.out, l == 0}; gemm_phase(L, g, S, E, TIDL()); }
        GSYNC();
        norm_rows_bf16(P, 0, P.in[I_N2W] + l * 1024, (bf16_t*)(ws + OFF_XN), TIDL());
        GSYNC();
        { Gemm g{(const bf16_t*)(ws + OFF_XN), (const bf16_t*)(ws + W_UP), MT, NUP, 1024}; StaticOrder S; S.init(MT, NUP, G, BIDL());
          EpiStoreBf16 E{(bf16_t*)(ws + OFF_PROJ), NUP}; gemm_phase(L, g, S, E, TIDL()); if (DUP & 8) gemm_phase(L, g, S, E, TIDL()); }
        GSYNC();
        ffn_conv_phase(P, l, TIDL());
        if (DUP & 32) ffn_conv_phase(P, l, TIDL());
        if (DUP & 512) { for (int q_ = 0; q_ < 10; ++q_) GSYNC(); }
        if (DUP & 256) norm_rows_bf16(P, 0, P.in[I_N2W] + l * 1024, (bf16_t*)(ws + OFF_AGLU), TIDL());
        GSYNC();
        small_gemm_ks<0>((const bf16_t*)(ws + OFF_TCAT), (const bf16_t*)(ws + W_DN), DFF, P, 0, L, TIDL(), BIDL());
        { Gemm g{(const bf16_t*)(ws + OFF_TCAT), (const bf16_t*)(ws + W_DN), MP, 1024, DFF}; StaticOrder S; S.init(MP, 1024, G, BIDL());
          EpiRes E{P.in[I_XP], P.in[I_XS], P.out, 0}; gemm_phase(L, g, S, E, TIDL()); }
        GSYNC();
    }
    final_norm(P, TIDL());
}

extern "C" void kernel_launch(void* const* d_in, const int* in_sizes, int n_in, void* d_out, int out_size, void* d_ws, size_t ws_size, hipStream_t stream) {
    static int grid_blocks = 0;
    if (grid_blocks == 0) {
        if (n_in != 36 || ws_size < WS_END) { fprintf(stderr, "kernel_launch: unexpected n_in %d / ws_size %zu\n", n_in, ws_size); grid_blocks = -1; return; }
        int dev = 0, cus = 0, per_cu = 0;
        hipGetDevice(&dev);
        hipDeviceGetAttribute(&cus, hipDeviceAttributeMultiprocessorCount, dev);
        hipFuncSetAttribute((const void*)mega, hipFuncAttributeMaxDynamicSharedMemorySize, LDS_BYTES);
        hipOccupancyMaxActiveBlocksPerMultiprocessor(&per_cu, (const void*)mega, NTH, LDS_BYTES);
        if (per_cu < 1) per_cu = 1;
        grid_blocks = cus * 1;
        (void)hipGetLastError();
    }
    if (grid_blocks < 0) return;
    Params p{};
    for (int i = 0; i < 36; ++i) p.in[i] = (const float*)d_in[i];
    p.out = (float*)d_out; p.ws = (unsigned char*)d_ws;
    void* args[] = {&p};
    (void)hipMemsetAsync((unsigned char*)d_ws + OFF_CTL, 0, WS_END - OFF_CTL, stream);
    hipError_t e = hipLaunchCooperativeKernel((const void*)mega, dim3(grid_blocks), dim3(NTH), args, LDS_BYTES, stream);
    if (e != hipSuccess) fprintf(stderr, "cooperative launch failed: %s (grid %d)\n", hipGetErrorString(e), grid_blocks);
}
```

```cpp
#include <hip/hip_runtime.h>
#include <hip/hip_cooperative_groups.h>
#include <cstdio>
namespace cg = cooperative_groups;

#define LAS __attribute__((address_space(3)))
typedef float f32x2 __attribute__((ext_vector_type(2)));
typedef unsigned u32x2 __attribute__((ext_vector_type(2)));

constexpr int MP = 16384, MS = 512, MT = MP + MS;
constexpr int DM = 1024, NPROJ = 8960, NPROJ_REAL = 8720, DFF = 2816, NUP = 5632;
constexpr int C_U = 0, C_Z = 512, C_XBC = 1536, C_DT = 3584, C_Q = 3600, C_F = 4112, C_I = 4624, C_G = 5136, C_GATE = 5648;
constexpr float EPSN = 1e-6f;
constexpr size_t W_IN = 0, W_GLU = 18350080, W_SSD = 20447232, W_HG = 22544384, W_O3 = 23592960, W_UP = 29884416, W_DN = 41418752;
constexpr size_t OFF_XN = 47185920, OFF_PROJ = 81788928, OFF_AGLU = 384565248, OFF_AHG = 401866752, OFF_SSQ = 419168256, OFF_TCAT = 420249600, OFF_CTL = 524058624, OFF_BAR = 524062720, WS_END = 524079104;
constexpr size_t O_PS5R = 17301504, O_PS5I = 17334272, O_PSSD = 17367040, O_PSSDC = 19464192, O_PHG = 19562496, O_PFFC = 20611072;
constexpr size_t O_SS5R = 20701184, O_SS5I = 21225472, O_SSSD = 21749760, O_SSSDC = 55304192, O_SHG = 56877056, O_SFFC = 73654272;
constexpr int MISC_OFF = 151552, LDS_BYTES = MISC_OFF + 256;

struct Params {
    const float* in[36];
    float* out;
    unsigned char* ws;
};
enum { I_XP = 0, I_XS, I_S5R, I_S5I, I_SSD, I_SSDC, I_HG, I_FFC, I_N1W, I_WIN, I_S5LDT, I_S5LR, I_S5LI, I_S5BR, I_S5BI, I_S5CR, I_S5CI, I_S5D, I_S5GLU,
       I_CONVW, I_CONVB, I_DTB, I_ALOG, I_SSDD, I_SSDNW, I_SSDWO, I_LB, I_HGNW, I_HGWO, I_WO, I_N2W, I_WUP, I_FCW, I_FCB, I_WDN, I_NFW };

namespace pg8 {
#define PG8_LAS __attribute__((address_space(3)))
typedef unsigned short bf16_t;
typedef short bf16x8 __attribute__((ext_vector_type(8)));
typedef float f32x4 __attribute__((ext_vector_type(4)));
typedef unsigned u32x4 __attribute__((ext_vector_type(4)));
constexpr int BM = 256, BK = 64, HALF = 128, HTB = HALF * BK * 2  , STAGE_BYTES = 8 * HTB, NXCD = 8, WGM = 8;

__host__ __device__ __forceinline__ int lds_byte(int r, int c) { const int st = (r >> 4) * 2 + (c >> 5), rr = r & 15, cc = c & 31, ob = rr * 64 + cc * 2; return st * 1024 + (ob ^ (((ob >> 9) & 1) << 5)); }
__host__ __device__ __forceinline__ void stage_rc(int b, int& R, int& C) { const int st = b / 1024, sb = b % 1024, swz = sb ^ (((sb >> 9) & 1) << 5); R = (st >> 1) * 16 + swz / 64; C = (st & 1) * 32 + (swz % 64) / 2; }
__host__ __device__ __forceinline__ int perm32(int rho) { const int n = rho >> 4, i = rho & 15; return 8 * (i >> 2) + 4 * n + (i & 3); }

struct Unit { int pm, pn; };
struct Gemm { const bf16_t* A; const bf16_t* Bt; int M, N, K; };

struct StaticOrder {
    int nM, nN, nwg, G, c;
    __host__ __device__ void init(int M, int N, int G_, int c_) { nM = M / BM; nN = N / BM; nwg = nM * nN; G = G_; c = c_; }
    __host__ __device__ bool next(int i, Unit& u) const {
        const long L = (long)i * G + c; if (L >= nwg) return false;
        int wgid = (int)L; { const int q = nwg / NXCD, r = nwg % NXCD, xcd = wgid % NXCD, off = wgid / NXCD; wgid = (xcd < r ? xcd * (q + 1) : r * (q + 1) + (xcd - r) * q) + off; }
        const int nig = WGM * nN, gid = wgid / nig, fm = gid * WGM, gsz = (nM - fm) < WGM ? (nM - fm) : WGM;
        u.pm = fm + ((wgid % nig) % gsz); u.pn = (wgid % nig) / gsz; return true;
    }
    __device__ __forceinline__ void a_ready(const Unit&) const {}
    __device__ __forceinline__ void done(const Unit&) const {}
};
typedef __bf16 bf16x2_t __attribute__((ext_vector_type(2)));
__device__ __forceinline__ unsigned cvt_pk_bf16(float lo, float hi) { f32x2 v = {lo, hi}; bf16x2_t h = __builtin_convertvector(v, bf16x2_t); return __builtin_bit_cast(unsigned, h); }
__device__ __forceinline__ float bf2f(unsigned b) { return __builtin_bit_cast(float, b << 16); }
__device__ __forceinline__ float bflo(unsigned w) { return __builtin_bit_cast(float, w << 16); }
__device__ __forceinline__ float bfhi(unsigned w) { return __builtin_bit_cast(float, w & 0xffff0000u); }
__device__ __forceinline__ bf16_t f2bf(float f) { return __builtin_bit_cast(bf16_t, (__bf16)f); }
__device__ __forceinline__ float sigm(float x) { return __builtin_amdgcn_rcpf(1.f + __expf(-x)); }
__device__ __forceinline__ float silu(float x) { return x * __builtin_amdgcn_rcpf(1.f + __expf(-x)); }
__device__ __forceinline__ float gelu_tanh(float x) { const float u = 0.7978845608028654f * (x + 0.044715f * x * x * x); const float th = 1.f - 2.f * __builtin_amdgcn_rcpf(__expf(2.f * u) + 1.f); return 0.5f * x * (1.f + th); }
__device__ __forceinline__ float dpp_f(float v, int ctrl_sel) { return v; }
#define DPP_ADD(v, CTRL) ((v) + __builtin_bit_cast(float, __builtin_amdgcn_update_dpp(0, __builtin_bit_cast(int, (v)), (CTRL), 0xF, 0xF, true)))
__device__ __forceinline__ float sum8(float v) { v = DPP_ADD(v, 0xB1); v = DPP_ADD(v, 0x4E); v = DPP_ADD(v, 0x141); return v; }
__device__ __forceinline__ float wave_sum(float v) {
    v = DPP_ADD(v, 0xB1); v = DPP_ADD(v, 0x4E); v = DPP_ADD(v, 0x141); v = DPP_ADD(v, 0x140);
    const float a = __builtin_bit_cast(float, __builtin_amdgcn_readlane(__builtin_bit_cast(int, v), 0)), b = __builtin_bit_cast(float, __builtin_amdgcn_readlane(__builtin_bit_cast(int, v), 16));
    const float c = __builtin_bit_cast(float, __builtin_amdgcn_readlane(__builtin_bit_cast(int, v), 32)), d = __builtin_bit_cast(float, __builtin_amdgcn_readlane(__builtin_bit_cast(int, v), 48));
    return (a + b) + (c + d);
}
__device__ __forceinline__ float wave_prefix(float v, int lane) {
    v = DPP_ADD(v, 0x111); v = DPP_ADD(v, 0x112); v = DPP_ADD(v, 0x114); v = DPP_ADD(v, 0x118);
    const float t0 = __builtin_bit_cast(float, __builtin_amdgcn_readlane(__builtin_bit_cast(int, v), 15)), t1 = __builtin_bit_cast(float, __builtin_amdgcn_readlane(__builtin_bit_cast(int, v), 31));
    const float t2 = __builtin_bit_cast(float, __builtin_amdgcn_readlane(__builtin_bit_cast(int, v), 47));
    const int r = lane >> 4;
    return v + (r >= 1 ? t0 : 0.f) + (r >= 2 ? t1 : 0.f) + (r >= 3 ? t2 : 0.f);
}

struct EpiStoreBf16 {
    static constexpr bool PERM = true, AFTER_DRAIN = false;
    bf16_t* O; int ldc;
    __device__ __forceinline__ void operator()(const f32x4 (&acc)[2][2][4][2], const Unit& u, int wr, int wc, int fr, int fq) const {
        const int row0 = u.pm * BM + wr * 64 + fr, col0 = u.pn * BM + wc * 32 + 8 * fq;
#pragma unroll
        for (int ai = 0; ai < 2; ++ai)
#pragma unroll
            for (int m = 0; m < 4; ++m) { bf16_t* rowp = O + (size_t)(row0 + ai * HALF + m * 16) * ldc + col0;
#pragma unroll
                for (int bj = 0; bj < 2; ++bj) { const f32x4 v0 = acc[ai][bj][m][0], v1 = acc[ai][bj][m][1];
                    u32x4 w; w.x = cvt_pk_bf16(v0[0], v0[1]); w.y = cvt_pk_bf16(v0[2], v0[3]); w.z = cvt_pk_bf16(v1[0], v1[1]); w.w = cvt_pk_bf16(v1[2], v1[3]);
                    *(u32x4*)(rowp + bj * HALF) = w; } }
    }
};
struct EpiGlu {
    static constexpr bool PERM = true, AFTER_DRAIN = false;
    const bf16_t* proj; bf16_t* tcat;
    __device__ __forceinline__ void operator()(const f32x4 (&acc)[2][2][4][2], const Unit& u, int wr, int wc, int fr, int fq) const {
        const int row0 = u.pm * BM + wr * 64 + fr, oc = u.pn * 128 + wc * 32 + 8 * fq;
#pragma unroll
        for (int ai = 0; ai < 2; ++ai) {
            u32x4 gl[4], od[4];
#pragma unroll
            for (int m = 0; m < 4; ++m) { const size_t r = (size_t)(row0 + ai * HALF + m * 16); gl[m] = *(const u32x4*)(proj + r * NPROJ + C_GATE + oc); od[m] = *(const u32x4*)(tcat + r * 1024 + oc); }
            __builtin_amdgcn_sched_barrier(0);
#pragma unroll
            for (int m = 0; m < 4; ++m) { const size_t r = (size_t)(row0 + ai * HALF + m * 16);
                const f32x4 a0 = acc[ai][0][m][0], a1 = acc[ai][0][m][1], g0 = acc[ai][1][m][0], g1 = acc[ai][1][m][1];
                float t[8];
                t[0] = sigm(bflo(gl[m].x)) * a0[0] * sigm(g0[0]) + bflo(od[m].x); t[1] = sigm(bfhi(gl[m].x)) * a0[1] * sigm(g0[1]) + bfhi(od[m].x);
                t[2] = sigm(bflo(gl[m].y)) * a0[2] * sigm(g0[2]) + bflo(od[m].y); t[3] = sigm(bfhi(gl[m].y)) * a0[3] * sigm(g0[3]) + bfhi(od[m].y);
                t[4] = sigm(bflo(gl[m].z)) * a1[0] * sigm(g1[0]) + bflo(od[m].z); t[5] = sigm(bfhi(gl[m].z)) * a1[1] * sigm(g1[1]) + bfhi(od[m].z);
                t[6] = sigm(bflo(gl[m].w)) * a1[2] * sigm(g1[2]) + bflo(od[m].w); t[7] = sigm(bfhi(gl[m].w)) * a1[3] * sigm(g1[3]) + bfhi(od[m].w);
                u32x4 w; w.x = cvt_pk_bf16(t[0], t[1]); w.y = cvt_pk_bf16(t[2], t[3]); w.z = cvt_pk_bf16(t[4], t[5]); w.w = cvt_pk_bf16(t[6], t[7]);
                *(u32x4*)(tcat + r * 1024 + oc) = w; }
            __builtin_amdgcn_sched_barrier(0);
        }
    }
};
template <bool RSTD, bool RMW> struct EpiSG {
    static constexpr bool PERM = true, AFTER_DRAIN = false;
    const bf16_t* proj; bf16_t* tcat; const float* ssq; int br;
    __device__ __forceinline__ void operator()(const f32x4 (&acc)[2][2][4][2], const Unit& u, int wr, int wc, int fr, int fq) const {
        const int row0 = u.pm * BM + wr * 64 + fr, col0 = u.pn * BM + wc * 32 + 8 * fq;
#pragma unroll
        for (int ai = 0; ai < 2; ++ai) {
            float sc[4] = {1.f, 1.f, 1.f, 1.f};
            if (RSTD) { f32x4 sv[4][4];
#pragma unroll
                for (int m = 0; m < 4; ++m) { const f32x4* sp = (const f32x4*)(ssq + (size_t)(row0 + ai * HALF + m * 16) * 16); sv[m][0] = sp[0]; sv[m][1] = sp[1]; sv[m][2] = sp[2]; sv[m][3] = sp[3]; }
                __builtin_amdgcn_sched_barrier(0);
#pragma unroll
                for (int m = 0; m < 4; ++m) { const f32x4 q = (sv[m][0] + sv[m][1]) + (sv[m][2] + sv[m][3]); sc[m] = 1.f / sqrtf(((q[0] + q[1]) + (q[2] + q[3])) * (1.f / 1024.f) + EPSN); } }
            u32x4 gl[4][2], od[4][2];
#pragma unroll
            for (int m = 0; m < 4; ++m)
#pragma unroll
                for (int bj = 0; bj < 2; ++bj) { const size_t r = (size_t)(row0 + ai * HALF + m * 16); const int c = col0 + bj * HALF;
                    gl[m][bj] = *(const u32x4*)(proj + r * NPROJ + C_GATE + br * 1024 + c); if (RMW) od[m][bj] = *(const u32x4*)(tcat + r * 1024 + c); }
            __builtin_amdgcn_sched_barrier(0);
#pragma unroll
            for (int m = 0; m < 4; ++m)
#pragma unroll
                for (int bj = 0; bj < 2; ++bj) { const size_t r = (size_t)(row0 + ai * HALF + m * 16); const int c = col0 + bj * HALF;
                    const f32x4 v0 = acc[ai][bj][m][0], v1 = acc[ai][bj][m][1]; const u32x4 g = gl[m][bj]; const float s = sc[m];
                    float t[8] = { sigm(bflo(g.x)) * s * v0[0], sigm(bfhi(g.x)) * s * v0[1], sigm(bflo(g.y)) * s * v0[2], sigm(bfhi(g.y)) * s * v0[3],
                                   sigm(bflo(g.z)) * s * v1[0], sigm(bfhi(g.z)) * s * v1[1], sigm(bflo(g.w)) * s * v1[2], sigm(bfhi(g.w)) * s * v1[3] };
                    if (RMW) { const u32x4 o = od[m][bj];
                        t[0] += bflo(o.x); t[1] += bfhi(o.x); t[2] += bflo(o.y); t[3] += bfhi(o.y); t[4] += bflo(o.z); t[5] += bfhi(o.z); t[6] += bflo(o.w); t[7] += bfhi(o.w); }
                    u32x4 w; w.x = cvt_pk_bf16(t[0], t[1]); w.y = cvt_pk_bf16(t[2], t[3]); w.z = cvt_pk_bf16(t[4], t[5]); w.w = cvt_pk_bf16(t[6], t[7]);
                    *(u32x4*)(tcat + r * 1024 + c) = w; }
            __builtin_amdgcn_sched_barrier(0);
        }
    }
};
struct EpiRes {
    static constexpr bool PERM = false, AFTER_DRAIN = false;
    const float* xp; const float* xs; float* xres; int from_in;
    __device__ __forceinline__ void operator()(const f32x4 (&acc)[2][2][4][2], const Unit& u, int wr, int wc, int fr, int fq) const {
        const int row0 = u.pm * BM + wr * 64 + fr, col0 = u.pn * BM + wc * 32 + 4 * fq;
#pragma unroll
        for (int ai = 0; ai < 2; ++ai) {
            f32x4 bs[4][2][2];
#pragma unroll
            for (int m = 0; m < 4; ++m) { const int r = row0 + ai * HALF + m * 16;
                const float* src = from_in ? (r < MP ? xp + (size_t)r * DM : xs + (size_t)(r - MP) * DM) + col0 : xres + (size_t)r * DM + col0;
#pragma unroll
                for (int bj = 0; bj < 2; ++bj)
#pragma unroll
                    for (int n = 0; n < 2; ++n) bs[m][bj][n] = *(const f32x4*)(src + bj * HALF + n * 16); }
            __builtin_amdgcn_sched_barrier(0);
#pragma unroll
            for (int m = 0; m < 4; ++m) { float* dst = xres + (size_t)(row0 + ai * HALF + m * 16) * DM + col0;
#pragma unroll
                for (int bj = 0; bj < 2; ++bj)
#pragma unroll
                    for (int n = 0; n < 2; ++n) *(f32x4*)(dst + bj * HALF + n * 16) = bs[m][bj][n] + acc[ai][bj][m][n]; }
            __builtin_amdgcn_sched_barrier(0);
        }
    }
};

template <class Epi, class Sched>
__device__ __forceinline__ void gemm_phase(PG8_LAS unsigned char* lds, const Gemm g, const Sched& S, const Epi& E, int tid_in) {
    int tid = tid_in; asm volatile("" : "+v"(tid));
    const int wid = __builtin_amdgcn_readfirstlane(tid >> 6), lane = tid & 63, wr = wid >> 2, wc = wid & 3, fr = lane & 15, fq = lane >> 4;
    const int K = g.K, nt = K / BK;
    unsigned voffA[2], voffB[2];
#pragma unroll
    for (int i = 0; i < 2; ++i) { int R, C; stage_rc(tid * 16 + i * 8192, R, C); const int Rb = Epi::PERM ? ((R & ~31) + perm32(R & 31)) : R;
        voffA[i] = (unsigned)(R * K + C) * 2u; voffB[i] = (unsigned)(Rb * K + C) * 2u; }
    const size_t kstep = (size_t)(BK * 2);
    const size_t hstep = (size_t)HALF * K * 2;
    const size_t tstep = 2 * hstep;
    const unsigned ldsw = (unsigned)wid * 1024u;
    const int aoff = lds_byte(wr * 64 + fr, fq * 8), boff = lds_byte(wc * 32 + fr, fq * 8);
#define PG8_SA(b, h) (((b) * 2 + (h)) * HTB)
#define PG8_SB(b, h) ((4 + (b) * 2 + (h)) * HTB)
#define PG8_STAGE(bufoff, gbase, voff) do { _Pragma("unroll") for (int _i = 0; _i < 2; ++_i) \
        __builtin_amdgcn_global_load_lds((const unsigned*)((const char*)(gbase) + (voff)[_i]), (PG8_LAS unsigned*)(lds + (bufoff) + ldsw + _i * 8192), 16, 0, 0); } while (0)
#define PG8_LDA(dst, b, h) do { _Pragma("unroll") for (int m = 0; m < 4; ++m) _Pragma("unroll") for (int k = 0; k < 2; ++k) dst[m][k] = *(const PG8_LAS bf16x8*)(lds + PG8_SA(b, h) + aoff + m * 2048 + k * 1024); } while (0)
#define PG8_LDB(dst, b, h) do { _Pragma("unroll") for (int n = 0; n < 2; ++n) _Pragma("unroll") for (int k = 0; k < 2; ++k) dst[n][k] = *(const PG8_LAS bf16x8*)(lds + PG8_SB(b, h) + boff + n * 2048 + k * 1024); } while (0)
#define PG8_MMA(ai, bj, At, Bt) do { __builtin_amdgcn_s_setprio(1); _Pragma("unroll") for (int m = 0; m < 4; ++m) _Pragma("unroll") for (int n = 0; n < 2; ++n) _Pragma("unroll") for (int k = 0; k < 2; ++k) \
        acc[ai][bj][m][n] = __builtin_amdgcn_mfma_f32_16x16x32_bf16(Bt[n][k], At[m][k], acc[ai][bj][m][n], 0, 0, 0); __builtin_amdgcn_s_setprio(0); } while (0)
#define PG8_WAIT_V(n) asm volatile("s_waitcnt vmcnt(" #n ")" ::: "memory")
#define PG8_WAIT_L(n) asm volatile("s_waitcnt lgkmcnt(" #n ")" ::: "memory")
#define PG8_BAR __builtin_amdgcn_s_barrier()
#define PG8_SCHED __builtin_amdgcn_sched_barrier(0)
    Unit cur, nxt; int ui = 0;
    if (!S.next(0, cur)) return;
    f32x4 acc[2][2][4][2];
#pragma unroll
    for (int a = 0; a < 2; ++a)
#pragma unroll
        for (int b = 0; b < 2; ++b)
#pragma unroll
            for (int m = 0; m < 4; ++m)
#pragma unroll
                for (int n = 0; n < 2; ++n) acc[a][b][m][n] = (f32x4){0.f, 0.f, 0.f, 0.f};
    bf16x8 At[4][2], B0[2][2], B1[2][2];
    const char* cA = (const char*)g.A + (size_t)cur.pm * tstep; const char* cB = (const char*)g.Bt + (size_t)cur.pn * tstep;
    S.a_ready(cur);
    PG8_STAGE(PG8_SB(0, 0), cB, voffB); PG8_STAGE(PG8_SA(0, 0), cA, voffA); PG8_STAGE(PG8_SB(0, 1), cB + hstep, voffB); PG8_STAGE(PG8_SA(0, 1), cA + hstep, voffA);
    if (wr == 1) PG8_BAR;
    PG8_WAIT_V(4); PG8_BAR;
    PG8_STAGE(PG8_SB(1, 0), cB + kstep, voffB); PG8_STAGE(PG8_SA(1, 0), cA + kstep, voffA); PG8_STAGE(PG8_SB(1, 1), cB + hstep + kstep, voffB);
    PG8_WAIT_V(6); PG8_BAR;
    for (;;) {
        const bool has_next = S.next(ui + 1, nxt);
        const char* nA = has_next ? (const char*)g.A + (size_t)nxt.pm * tstep : cA; const char* nB = has_next ? (const char*)g.Bt + (size_t)nxt.pn * tstep : cB;
        for (int t = 0; t < nt; t += 2) {
            const bool last = (t == nt - 2);
            const char* a1 = cA + (size_t)(t + 1) * kstep;
            const char* a2 = last ? nA : cA + (size_t)(t + 2) * kstep; const char* b2 = last ? nB : cB + (size_t)(t + 2) * kstep;
            const char* a3 = a2 + kstep; const char* b3 = b2 + kstep;
            if (last && has_next) S.a_ready(nxt);
            PG8_LDB(B0, 0, 0); PG8_SCHED; PG8_LDA(At, 0, 0); PG8_STAGE(PG8_SA(1, 1), a1 + hstep, voffA);
            PG8_WAIT_L(8); PG8_BAR; PG8_WAIT_L(0); PG8_MMA(0, 0, At, B0); PG8_BAR; PG8_SCHED;
            PG8_LDB(B1, 0, 1); PG8_STAGE(PG8_SB(0, 0), b2, voffB);
            PG8_BAR; PG8_WAIT_L(0); PG8_MMA(0, 1, At, B1); PG8_BAR;
            PG8_LDA(At, 0, 1); PG8_STAGE(PG8_SA(0, 0), a2, voffA);
            PG8_BAR; PG8_WAIT_L(0); PG8_MMA(1, 0, At, B0); PG8_BAR; PG8_SCHED;
            PG8_STAGE(PG8_SB(0, 1), b2 + hstep, voffB);
            PG8_WAIT_V(6); PG8_BAR; PG8_MMA(1, 1, At, B1); PG8_BAR;
            PG8_LDB(B0, 1, 0); PG8_SCHED; PG8_LDA(At, 1, 0); PG8_STAGE(PG8_SA(0, 1), a2 + hstep, voffA);
            PG8_WAIT_L(8); PG8_BAR; PG8_WAIT_L(0); PG8_MMA(0, 0, At, B0); PG8_BAR; PG8_SCHED;
            PG8_LDB(B1, 1, 1); PG8_STAGE(PG8_SB(1, 0), b3, voffB);
            PG8_BAR; PG8_WAIT_L(0); PG8_MMA(0, 1, At, B1); PG8_BAR;
            PG8_LDA(At, 1, 1); PG8_STAGE(PG8_SA(1, 0), a3, voffA);
            PG8_BAR; PG8_WAIT_L(0); PG8_MMA(1, 0, At, B0); PG8_BAR; PG8_SCHED;
            PG8_STAGE(PG8_SB(1, 1), b3 + hstep, voffB);
            PG8_WAIT_V(6); PG8_BAR; PG8_MMA(1, 1, At, B1); PG8_BAR;
        }
        if constexpr (!Epi::AFTER_DRAIN) { E(acc, cur, wr, wc, fr, fq); S.done(cur); }
        if (!has_next) break;
#pragma unroll
        for (int a = 0; a < 2; ++a)
#pragma unroll
            for (int b = 0; b < 2; ++b)
#pragma unroll
                for (int m = 0; m < 4; ++m)
#pragma unroll
                    for (int n = 0; n < 2; ++n) acc[a][b][m][n] = (f32x4){0.f, 0.f, 0.f, 0.f};
        cur = nxt; cA = nA; cB = nB; ++ui;
    }
    PG8_WAIT_V(0);
    if (wr == 0) PG8_BAR;
    PG8_BAR;
    if constexpr (Epi::AFTER_DRAIN) { E.fused(acc, cur, wr, wc, fr, fq, lds, wid, lane); S.done(cur); }
#undef PG8_SA
#undef PG8_SB
#undef PG8_STAGE
#undef PG8_LDA
#undef PG8_LDB
#undef PG8_MMA
#undef PG8_WAIT_V
#undef PG8_WAIT_L
#undef PG8_BAR
#undef PG8_SCHED
}
}
using namespace pg8;
__device__ __forceinline__ u32x4 pack8(float a0, float a1, float a2, float a3, float a4, float a5, float a6, float a7) { u32x4 w; w.x = cvt_pk_bf16(a0, a1); w.y = cvt_pk_bf16(a2, a3); w.z = cvt_pk_bf16(a4, a5); w.w = cvt_pk_bf16(a6, a7); return w; }
constexpr int NTH = 512;

template <int MODE>
__device__ __forceinline__ void cvt_wt(const float* W, int K, int N, int Nphys, bf16_t* WT, int ldk, int koff, LAS float* scr, int tid, int rot) {
    const int nnb = Nphys / 64, ntile = (K / 64) * nnb;
    int bx_ = blockIdx.x; asm volatile("" : "+s"(bx_));
    for (int it = (bx_ + rot) % (int)gridDim.x; it < ntile; it += gridDim.x) {
        const int kb = it / nnb, nb = it % nnb, k0 = kb * 64, n0 = nb * 64;
        int src0 = n0;
        if (MODE == 2) { const int blk = n0 >> 8, within = n0 & 255; src0 = (within >> 7) * 1024 + blk * 128 + (within & 127); }
        const int c = tid & 63;
#pragma unroll
        for (int i = 0; i < 8; ++i) { const int kk = (tid >> 6) + 8 * i;
            float v = 0.f; if (MODE != 1 || src0 + c < N) v = W[(size_t)(k0 + kk) * N + src0 + c];
            scr[kk * 65 + c] = v; }
        __syncthreads();
        { const int n = tid >> 3, ch = tid & 7; const LAS float* s = scr + (8 * ch) * 65 + n;
          u32x4 o; o.x = cvt_pk_bf16(s[0], s[65]); o.y = cvt_pk_bf16(s[130], s[195]); o.z = cvt_pk_bf16(s[260], s[325]); o.w = cvt_pk_bf16(s[390], s[455]);
          *(u32x4*)(WT + (size_t)(n0 + n) * ldk + koff + k0 + 8 * ch) = o; }
        __syncthreads();
    }
}
__device__ __forceinline__ void convert_weights(const Params& P, int l, LAS unsigned char* L, int tid) {
    LAS float* scr = (LAS float*)L; unsigned char* ws = P.ws;
    cvt_wt<1>(P.in[I_WIN] + (size_t)l * 1024 * NPROJ_REAL, 1024, NPROJ_REAL, NPROJ, (bf16_t*)(ws + W_IN), 1024, 0, scr, tid, 0);
    cvt_wt<2>(P.in[I_S5GLU] + (size_t)l * 512 * 2048, 512, 2048, 2048, (bf16_t*)(ws + W_GLU), 512, 0, scr, tid, 192);
    cvt_wt<0>(P.in[I_SSDWO] + (size_t)l * 1024 * 1024, 1024, 1024, 1024, (bf16_t*)(ws + W_SSD), 1024, 0, scr, tid, 192);
    cvt_wt<0>(P.in[I_HGWO] + (size_t)l * 512 * 1024, 512, 1024, 1024, (bf16_t*)(ws + W_HG), 512, 0, scr, tid, 192);
    cvt_wt<0>(P.in[I_WO] + (size_t)l * 1024 * 1024, 1024, 1024, 1024, (bf16_t*)(ws + W_O3), 1024, 0, scr, tid, 64);
    cvt_wt<0>(P.in[I_WUP] + (size_t)l * 1024 * NUP, 1024, NUP, NUP, (bf16_t*)(ws + W_UP), 1024, 0, scr, tid, 128);
    cvt_wt<0>(P.in[I_WDN] + (size_t)l * DFF * 1024, DFF, 1024, 1024, (bf16_t*)(ws + W_DN), DFF, 0, scr, tid, 0);
}

__device__ __forceinline__ void norm_rows_bf16(const Params& P, int from_in, const float* w, bf16_t* out, int tid) {
    const int lane = tid & 63, gw = blockIdx.x * 8 + (tid >> 6), ngw = gridDim.x * 8;
    f32x4 wv[4];
#pragma unroll
    for (int j = 0; j < 4; ++j) wv[j] = ((const f32x4*)w)[lane + 64 * j];
    for (int row0 = gw; row0 < MT; row0 += 2 * ngw) {
        f32x4 v[2][4]; float ss[2] = {0.f, 0.f};
#pragma unroll
        for (int u = 0; u < 2; ++u) { const int row = (row0 + u * ngw < MT) ? row0 + u * ngw : row0;
            const float* xr = from_in ? (row < MP ? P.in[I_XP] + (size_t)row * DM : P.in[I_XS] + (size_t)(row - MP) * DM) : P.out + (size_t)row * DM;
#pragma unroll
            for (int j = 0; j < 4; ++j) v[u][j] = ((const f32x4*)xr)[lane + 64 * j]; }
#pragma unroll
        for (int u = 0; u < 2; ++u) {
#pragma unroll
            for (int j = 0; j < 4; ++j) ss[u] += (v[u][j][0] * v[u][j][0] + v[u][j][1] * v[u][j][1]) + (v[u][j][2] * v[u][j][2] + v[u][j][3] * v[u][j][3]);
            const float rstd = 1.f / sqrtf(wave_sum(ss[u]) * (1.f / 1024.f) + EPSN);
            if (u == 0 || row0 + ngw < MT) { u32x2* o = (u32x2*)(out + (size_t)(row0 + u * ngw) * DM);
#pragma unroll
                for (int j = 0; j < 4; ++j) { u32x2 q; q.x = cvt_pk_bf16(v[u][j][0] * rstd * wv[j][0], v[u][j][1] * rstd * wv[j][1]); q.y = cvt_pk_bf16(v[u][j][2] * rstd * wv[j][2], v[u][j][3] * rstd * wv[j][3]); o[lane + 64 * j] = q; } } }
    }
}
__device__ __forceinline__ void final_norm(const Params& P, int tid) {
    const int lane = tid & 63, gw = blockIdx.x * 8 + (tid >> 6), ngw = gridDim.x * 8;
    const float* w = P.in[I_NFW];
    f32x4 wv[4];
#pragma unroll
    for (int j = 0; j < 4; ++j) wv[j] = ((const f32x4*)w)[lane + 64 * j];
    for (int row0 = gw; row0 < MT; row0 += 2 * ngw) {
        f32x4 v[2][4];
#pragma unroll
        for (int u = 0; u < 2; ++u) { const int row = (row0 + u * ngw < MT) ? row0 + u * ngw : row0; const float* xr = P.out + (size_t)row * DM;
#pragma unroll
            for (int j = 0; j < 4; ++j) v[u][j] = ((const f32x4*)xr)[lane + 64 * j]; }
#pragma unroll
        for (int u = 0; u < 2; ++u) { float ss = 0.f;
#pragma unroll
            for (int j = 0; j < 4; ++j) ss += (v[u][j][0] * v[u][j][0] + v[u][j][1] * v[u][j][1]) + (v[u][j][2] * v[u][j][2] + v[u][j][3] * v[u][j][3]);
            const float rstd = 1.f / sqrtf(wave_sum(ss) * (1.f / 1024.f) + EPSN);
            if (u == 0 || row0 + ngw < MT) { float* xr = P.out + (size_t)(row0 + u * ngw) * DM;
#pragma unroll
                for (int j = 0; j < 4; ++j) ((f32x4*)xr)[lane + 64 * j] = v[u][j] * rstd * wv[j]; } }
    }
}

__device__ __forceinline__ void ffn_conv_phase(const Params& P, int l, int tid) {
    const bf16_t* up = (const bf16_t*)(P.ws + OFF_PROJ); bf16_t* hff = (bf16_t*)(P.ws + OFF_TCAT);
    const float* cw = P.in[I_FCW] + (size_t)l * 3 * DFF; const float* cb = P.in[I_FCB] + (size_t)l * DFF;
    const int nun = (2048 + 128) * 352;
    for (int un = blockIdx.x * NTH + tid; un < nun; un += gridDim.x * NTH) {
        const int run = un / 352, c0 = (un - run * 352) * 8;
        const bool pr = run < 2048; const int nrow = pr ? 8 : 4, r0 = pr ? run * 8 : MP + (run - 2048) * 4, b = pr ? run >> 8 : run - 2048, t0 = pr ? (run & 255) * 8 : 0;
        u32x4 ar[8], gr[8];
#pragma unroll
        for (int i = 0; i < 8; ++i) { const int rr = r0 + (i < nrow ? i : nrow - 1); ar[i] = *(const u32x4*)(up + (size_t)rr * NUP + c0); gr[i] = *(const u32x4*)(up + (size_t)rr * NUP + DFF + c0); }
        float x0[8], x1[8];
        if (pr) {
            if (t0 > 0) { const u32x4 ua = *(const u32x4*)(up + (size_t)(r0 - 2) * NUP + c0), ub = *(const u32x4*)(up + (size_t)(r0 - 1) * NUP + c0);
                x0[0] = bflo(ua.x); x0[1] = bfhi(ua.x); x0[2] = bflo(ua.y); x0[3] = bfhi(ua.y); x0[4] = bflo(ua.z); x0[5] = bfhi(ua.z); x0[6] = bflo(ua.w); x0[7] = bfhi(ua.w);
                x1[0] = bflo(ub.x); x1[1] = bfhi(ub.x); x1[2] = bflo(ub.y); x1[3] = bfhi(ub.y); x1[4] = bflo(ub.z); x1[5] = bfhi(ub.z); x1[6] = bflo(ub.w); x1[7] = bfhi(ub.w);
            } else {
#pragma unroll
                for (int i = 0; i < 8; ++i) { x0[i] = 0.f; x1[i] = 0.f; } }
        } else { const float* st = P.in[I_FFC] + (size_t)(l * 128 + b) * 2 * DFF + c0;
            const f32x4 s0 = *(const f32x4*)st, s1 = *(const f32x4*)(st + 4), s2 = *(const f32x4*)(st + DFF), s3 = *(const f32x4*)(st + DFF + 4);
            x0[0] = s0[0]; x0[1] = s0[1]; x0[2] = s0[2]; x0[3] = s0[3]; x0[4] = s1[0]; x0[5] = s1[1]; x0[6] = s1[2]; x0[7] = s1[3];
            x1[0] = s2[0]; x1[1] = s2[1]; x1[2] = s2[2]; x1[3] = s2[3]; x1[4] = s3[0]; x1[5] = s3[1]; x1[6] = s3[2]; x1[7] = s3[3]; }
        float w0[8], w1[8], w2[8], bv[8];
        { const f32x4 a0 = *(const f32x4*)(cw + c0), a1 = *(const f32x4*)(cw + c0 + 4), b0 = *(const f32x4*)(cw + DFF + c0), b1 = *(const f32x4*)(cw + DFF + c0 + 4);
          const f32x4 d0 = *(const f32x4*)(cw + 2 * DFF + c0), d1 = *(const f32x4*)(cw + 2 * DFF + c0 + 4), e0 = *(const f32x4*)(cb + c0), e1 = *(const f32x4*)(cb + c0 + 4);
#pragma unroll
          for (int i = 0; i < 4; ++i) { w0[i] = a0[i]; w0[4 + i] = a1[i]; w1[i] = b0[i]; w1[4 + i] = b1[i]; w2[i] = d0[i]; w2[4 + i] = d1[i]; bv[i] = e0[i]; bv[4 + i] = e1[i]; } }
#pragma unroll
        for (int i = 0; i < 8; ++i) if (i < nrow) {
            const u32x4 a2 = ar[i], gg = gr[i];
            const float x2[8] = { bflo(a2.x), bfhi(a2.x), bflo(a2.y), bfhi(a2.y), bflo(a2.z), bfhi(a2.z), bflo(a2.w), bfhi(a2.w) };
            const float gv[8] = { bflo(gg.x), bfhi(gg.x), bflo(gg.y), bfhi(gg.y), bflo(gg.z), bfhi(gg.z), bflo(gg.w), bfhi(gg.w) };
            float hv[8];
#pragma unroll
            for (int j = 0; j < 8; ++j) { const float cv = x0[j] * w0[j] + x1[j] * w1[j] + x2[j] * w2[j] + bv[j]; hv[j] = silu(cv) * gv[j]; }
            *(u32x4*)(hff + (size_t)(r0 + i) * DFF + c0) = pack8(hv[0], hv[1], hv[2], hv[3], hv[4], hv[5], hv[6], hv[7]);
            const int t = t0 + i;
            if (pr && t >= 2046) { float* d = P.out + O_PFFC + ((size_t)(l * 8 + b) * 2 + (t - 2046)) * DFF + c0;
                *(f32x4*)d = (f32x4){x2[0], x2[1], x2[2], x2[3]}; *(f32x4*)(d + 4) = (f32x4){x2[4], x2[5], x2[6], x2[7]}; }
            if (!pr && i >= 2) { float* d = P.out + O_SFFC + ((size_t)(l * 128 + b) * 2 + (i - 2)) * DFF + c0;
                *(f32x4*)d = (f32x4){x2[0], x2[1], x2[2], x2[3]}; *(f32x4*)(d + 4) = (f32x4){x2[4], x2[5], x2[6], x2[7]}; }
#pragma unroll
            for (int j = 0; j < 8; ++j) { x0[j] = x1[j]; x1[j] = x2[j]; }
        }
    }
}

__device__ __forceinline__ float softplus(float x) { const float t = __expf(x); const float sm = t * (1.f - t * (0.5f - t * 0.33333334f)); return x > 20.f ? x : (t < 0.03f ? sm : __logf(1.f + t)); }

__device__ __forceinline__ void ssd_item(const Params& P, int l, bool prompt, int b, int h, LAS unsigned char* L, int tid) {
    const int Lseq = prompt ? 2048 : 4, row0 = prompt ? b * 2048 : MP + b * 4, g = h >> 2;
    LAS float* Bs = (LAS float*)L; LAS float* Cs = Bs + 4096; LAS float* xs = Cs + 4096; LAS float* zs = xs + 2048; LAS float* yb = zs + 2048; LAS float* dts = yb + 2048; LAS float* dAs = dts + 32;
    const bf16_t* proj = (const bf16_t*)(P.ws + OFF_PROJ);
    int role = 3, col = 0, xc = 0, dstride = 64; LAS float* dst = xs;
    if (tid < 128) { xc = 1024 + g * 128 + tid; dst = Bs + tid; dstride = 128; role = 0; }
    else if (tid < 256) { xc = 1536 + g * 128 + (tid - 128); dst = Cs + (tid - 128); dstride = 128; role = 0; }
    else if (tid < 320) { xc = h * 64 + (tid - 256); dst = xs + (tid - 256); dstride = 64; role = 0; }
    else if (tid < 384) { col = C_Z + h * 64 + (tid - 320); dst = zs + (tid - 320); dstride = 64; role = 1; }
    else if (tid < 416) role = 2;
    if (role == 0) col = C_XBC + xc;
    float w0 = 0.f, w1 = 0.f, w2 = 0.f, w3 = 0.f, cb = 0.f, r0 = 0.f, r1 = 0.f, r2 = 0.f;
    if (role == 0) { const float* cw = P.in[I_CONVW] + (size_t)l * 4 * 2048; w0 = cw[xc]; w1 = cw[2048 + xc]; w2 = cw[4096 + xc]; w3 = cw[6144 + xc]; cb = P.in[I_CONVB][l * 2048 + xc];
        if (!prompt) { const float* st = P.in[I_SSDC] + (size_t)(l * 128 + b) * 3 * 2048; r0 = st[xc]; r1 = st[2048 + xc]; r2 = st[4096 + xc]; } }
    const float dt_bias = P.in[I_DTB][l * 16 + h], aneg = -__expf(P.in[I_ALOG][l * 16 + h]), Dh = P.in[I_SSDD][l * 16 + h];
    const int p = tid >> 3, ns = tid & 7;
    f32x4 s[4];
    if (prompt) {
#pragma unroll
        for (int i = 0; i < 4; ++i) s[i] = (f32x4){0.f, 0.f, 0.f, 0.f};
    } else { const float* sp = P.in[I_SSD] + ((size_t)((l * 128 + b) * 16 + h) * 64 + p) * 128 + 4 * ns;
#pragma unroll
        for (int i = 0; i < 4; ++i) s[i] = *(const f32x4*)(sp + 32 * i); }
    bf16_t* Assd = (bf16_t*)(P.ws + OFF_XN); float* ssq = (float*)(P.ws + OFF_SSQ);
    const float* nw = P.in[I_SSDNW] + l * 1024 + h * 64;
    unsigned short rv[4];
#define SSD_LOAD(T0) do { if (role <= 1) { _Pragma("unroll") for (int tt = 0; tt < 4; ++tt) { int r_ = (T0) + tt; r_ = r_ < Lseq ? r_ : Lseq - 1; rv[tt] = proj[(size_t)(row0 + r_) * NPROJ + col]; } } \
        else if (role == 2) { int r_ = (T0) + (tid - 384); r_ = r_ < Lseq ? r_ : Lseq - 1; rv[0] = proj[(size_t)(row0 + r_) * NPROJ + C_DT + h]; } } while (0)
    SSD_LOAD(0);
    for (int t0 = 0; t0 < Lseq; t0 += 32) {
        const int len = (Lseq - t0) < 32 ? (Lseq - t0) : 32;
        if (role == 0) {
#pragma unroll
            for (int tt = 0; tt < 4; ++tt) { const float raw = bf2f(rv[tt]); const float y = r0 * w0 + r1 * w1 + r2 * w2 + raw * w3 + cb; dst[tt * dstride] = silu(y); r0 = r1; r1 = r2; r2 = raw; }
        } else if (role == 1) {
#pragma unroll
            for (int tt = 0; tt < 4; ++tt) dst[tt * dstride] = bf2f(rv[tt]);
        } else if (role == 2) { const int tt = tid - 384;
            const float raw = bf2f(rv[0]); const float dt = softplus(raw + dt_bias); dts[tt] = dt; dAs[tt] = __expf(dt * aneg); }
        __syncthreads();
        if (t0 + 32 < Lseq) SSD_LOAD(t0 + 32);
#define SSD_LD(Bx, Cx, dAx, dtx, xvx, TT) do { const int t_ = (TT) & 31; _Pragma("unroll") for (int i = 0; i < 4; ++i) { Bx[i] = *(const LAS f32x4*)(Bs + t_ * 128 + 32 * i + 4 * ns); Cx[i] = *(const LAS f32x4*)(Cs + t_ * 128 + 32 * i + 4 * ns); } \
            dAx = dAs[t_]; dtx = dts[t_]; xvx = xs[t_ * 64 + p]; } while (0)
#define SSD_STEP(Bx, Cx, dAx, dtx, xvx, TT) do { const float xdt_ = xvx * dtx; f32x4 y4_ = (f32x4){0.f, 0.f, 0.f, 0.f}; \
            _Pragma("unroll") for (int i = 0; i < 4; ++i) { s[i] = s[i] * dAx + Bx[i] * xdt_; y4_ += s[i] * Cx[i]; } \
            const float y_ = sum8((y4_[0] + y4_[1]) + (y4_[2] + y4_[3])); if (ns == 0) yb[(TT) * 64 + p] = y_; } while (0)
        { f32x4 B0[4], C0[4], B1[4], C1[4]; float dA0, dt0, xv0, dA1, dt1, xv1;
          SSD_LD(B0, C0, dA0, dt0, xv0, 0);
          for (int tt = 0; tt < len; tt += 2) {
              SSD_LD(B1, C1, dA1, dt1, xv1, tt + 1);
              SSD_STEP(B0, C0, dA0, dt0, xv0, tt);
              SSD_LD(B0, C0, dA0, dt0, xv0, tt + 2);
              SSD_STEP(B1, C1, dA1, dt1, xv1, tt + 1);
          } }
        __syncthreads();
        { const int tt = tid >> 4, q = tid & 15; f32x4 v = *(const LAS f32x4*)(yb + tt * 64 + 4 * q);
          { const f32x4 xv4 = *(const LAS f32x4*)(xs + tt * 64 + 4 * q), z4 = *(const LAS f32x4*)(zs + tt * 64 + 4 * q);
            v[0] = (v[0] + Dh * xv4[0]) * silu(z4[0]); v[1] = (v[1] + Dh * xv4[1]) * silu(z4[1]); v[2] = (v[2] + Dh * xv4[2]) * silu(z4[2]); v[3] = (v[3] + Dh * xv4[3]) * silu(z4[3]); }
          float sq = (v[0] * v[0] + v[1] * v[1]) + (v[2] * v[2] + v[3] * v[3]);
          sq = sum8(sq); sq = DPP_ADD(sq, 0x140);
          if (tt < len) { const size_t row = (size_t)(row0 + t0 + tt); const f32x4 wv = *(const f32x4*)(nw + 4 * q);
              u32x2 o; o.x = cvt_pk_bf16(v[0] * wv[0], v[1] * wv[1]); o.y = cvt_pk_bf16(v[2] * wv[2], v[3] * wv[3]);
              *(u32x2*)(Assd + row * DM + h * 64 + 4 * q) = o;
              if (q == 0) ssq[row * 16 + h] = sq; } }
    }
    { float* sp = P.out + (prompt ? O_PSSD + ((size_t)((l * 8 + b) * 16 + h) * 64 + p) * 128 : O_SSSD + ((size_t)((l * 128 + b) * 16 + h) * 64 + p) * 128) + 4 * ns;
#pragma unroll
      for (int i = 0; i < 4; ++i) *(f32x4*)(sp + 32 * i) = s[i]; }
    __syncthreads();
}

__device__ __forceinline__ void ssd_s4_item(const Params& P, int l, int b, int g, LAS unsigned char* L, int tid) {
    const int row0 = MP + b * 4;
    LAS float* Bs = (LAS float*)L; LAS float* Cs = Bs + 512; LAS float* xs = Cs + 512; LAS float* zs = xs + 1024; LAS float* yb = zs + 1024; LAS float* dts = yb + 1024; LAS float* dAs = dts + 16;
    const bf16_t* proj = (const bf16_t*)(P.ws + OFF_PROJ);
    const bool isx = tid >= 256; const int hh2 = (tid - 256) >> 6, p2 = (tid - 256) & 63;
    const int xc = !isx ? (tid < 128 ? 1024 + g * 128 + tid : 1536 + g * 128 + (tid - 128)) : (4 * g + hh2) * 64 + p2;
    LAS float* dst = !isx ? (tid < 128 ? Bs + tid : Cs + (tid - 128)) : xs + hh2 * 256 + p2;
    const int dstride = !isx ? 128 : 64;
    const float* cw = P.in[I_CONVW] + (size_t)l * 4 * 2048; const float w0 = cw[xc], w1 = cw[2048 + xc], w2 = cw[4096 + xc], w3 = cw[6144 + xc], cb = P.in[I_CONVB][l * 2048 + xc];
    const float* st = P.in[I_SSDC] + (size_t)(l * 128 + b) * 3 * 2048; float r0 = st[xc], r1 = st[2048 + xc], r2 = st[4096 + xc];
    unsigned short rv[4], zv[4] = {0, 0, 0, 0};
#pragma unroll
    for (int tt = 0; tt < 4; ++tt) { rv[tt] = proj[(size_t)(row0 + tt) * NPROJ + C_XBC + xc]; if (isx) zv[tt] = proj[(size_t)(row0 + tt) * NPROJ + C_Z + (4 * g + hh2) * 64 + p2]; }
    float dtr = 0.f, dtb = 0.f, an = 0.f;
    if (tid < 16) { const int hh = tid >> 2, tt = tid & 3; dtr = bf2f(proj[(size_t)(row0 + tt) * NPROJ + C_DT + 4 * g + hh]); dtb = P.in[I_DTB][l * 16 + 4 * g + hh]; an = -__expf(P.in[I_ALOG][l * 16 + 4 * g + hh]); }
    const int p = tid >> 3, ns = tid & 7;
    f32x4 s[4][4];
#pragma unroll
    for (int hh = 0; hh < 4; ++hh) { const float* sp = P.in[I_SSD] + ((size_t)((l * 128 + b) * 16 + 4 * g + hh) * 64 + p) * 128 + 4 * ns;
#pragma unroll
        for (int i = 0; i < 4; ++i) s[hh][i] = *(const f32x4*)(sp + 32 * i); }
#pragma unroll
    for (int tt = 0; tt < 4; ++tt) { const float raw = bf2f(rv[tt]); const float y = r0 * w0 + r1 * w1 + r2 * w2 + raw * w3 + cb; dst[tt * dstride] = silu(y); r0 = r1; r1 = r2; r2 = raw; }
    if (isx) {
#pragma unroll
        for (int tt = 0; tt < 4; ++tt) zs[hh2 * 256 + tt * 64 + p2] = bf2f(zv[tt]); }
    if (tid < 16) { const float dt = softplus(dtr + dtb); dts[tid] = dt; dAs[tid] = __expf(dt * an); }
    __syncthreads();
#pragma unroll
    for (int tt = 0; tt < 4; ++tt) {
        f32x4 Bv[4], Cv[4];
#pragma unroll
        for (int i = 0; i < 4; ++i) { Bv[i] = *(const LAS f32x4*)(Bs + tt * 128 + 32 * i + 4 * ns); Cv[i] = *(const LAS f32x4*)(Cs + tt * 128 + 32 * i + 4 * ns); }
#pragma unroll
        for (int hh = 0; hh < 4; ++hh) { const float dA = dAs[hh * 4 + tt], xdt = xs[hh * 256 + tt * 64 + p] * dts[hh * 4 + tt];
            f32x4 y4 = (f32x4){0.f, 0.f, 0.f, 0.f};
#pragma unroll
            for (int i = 0; i < 4; ++i) { s[hh][i] = s[hh][i] * dA + Bv[i] * xdt; y4 += s[hh][i] * Cv[i]; }
            const float y = sum8((y4[0] + y4[1]) + (y4[2] + y4[3])); if (ns == 0) yb[hh * 256 + tt * 64 + p] = y; }
    }
#pragma unroll
    for (int hh = 0; hh < 4; ++hh) { float* sp = P.out + O_SSSD + ((size_t)((l * 128 + b) * 16 + 4 * g + hh) * 64 + p) * 128 + 4 * ns;
#pragma unroll
        for (int i = 0; i < 4; ++i) *(f32x4*)(sp + 32 * i) = s[hh][i]; }
    __syncthreads();
    { const int pair = (tid >> 4) & 15, q = tid & 15, hh = pair >> 2, tt = pair & 3, h = 4 * g + hh;
      f32x4 v = *(const LAS f32x4*)(yb + pair * 64 + 4 * q); const f32x4 xv4 = *(const LAS f32x4*)(xs + pair * 64 + 4 * q), z4 = *(const LAS f32x4*)(zs + pair * 64 + 4 * q);
      const float Dh = P.in[I_SSDD][l * 16 + h];
      v[0] = (v[0] + Dh * xv4[0]) * silu(z4[0]); v[1] = (v[1] + Dh * xv4[1]) * silu(z4[1]); v[2] = (v[2] + Dh * xv4[2]) * silu(z4[2]); v[3] = (v[3] + Dh * xv4[3]) * silu(z4[3]);
      float sq = (v[0] * v[0] + v[1] * v[1]) + (v[2] * v[2] + v[3] * v[3]);
      sq = sum8(sq); sq = DPP_ADD(sq, 0x140);
      if (tid < 256) { const size_t row = (size_t)(row0 + tt); const f32x4 wv = *(const f32x4*)(P.in[I_SSDNW] + l * 1024 + h * 64 + 4 * q);
          u32x2 o; o.x = cvt_pk_bf16(v[0] * wv[0], v[1] * wv[1]); o.y = cvt_pk_bf16(v[2] * wv[2], v[3] * wv[3]);
          *(u32x2*)((bf16_t*)(P.ws + OFF_XN) + row * DM + h * 64 + 4 * q) = o;
          if (q == 0) ((float*)(P.ws + OFF_SSQ))[row * 16 + h] = sq; } }
    __syncthreads();
}

template <int KT>
__device__ __forceinline__ f32x4 mma_rt(const LAS bf16_t* A, int pa, const LAS bf16_t* Bt, int pb, f32x4 acc, int lane) {
    const LAS bf16_t* ap = A + (lane & 15) * pa + (lane >> 4) * 8; const LAS bf16_t* bp = Bt + (lane & 15) * pb + (lane >> 4) * 8;
#pragma unroll
    for (int kt = 0; kt < KT; ++kt) { const bf16x8 a = *(const LAS bf16x8*)(ap + kt * 32), b = *(const LAS bf16x8*)(bp + kt * 32); acc = __builtin_amdgcn_mfma_f32_16x16x32_bf16(a, b, acc, 0, 0, 0); }
    return acc;
}

__device__ __forceinline__ void ssd_mfma_item(const Params& P, int l, int b, int h, LAS unsigned char* L, int tid) {
    constexpr int PC = 136, PT = 72;
    LAS bf16_t* Cl = (LAS bf16_t*)L; LAS bf16_t* Bl = (LAS bf16_t*)(L + 17408); LAS bf16_t* BTl = (LAS bf16_t*)(L + 34816); LAS float* ybuf = (LAS float*)(L + 121856);
    LAS bf16_t* XdT = (LAS bf16_t*)(L + 53248); LAS bf16_t* XwT = (LAS bf16_t*)(L + 62464); LAS bf16_t* Gl = (LAS bf16_t*)(L + 71680); LAS bf16_t* Sl = (LAS bf16_t*)(L + 80896);
    LAS float* xf = (LAS float*)(L + 98304); LAS float* dtl = (LAS float*)(L + 114688); LAS float* acl = dtl + 64;
    const bf16_t* proj = (const bf16_t*)(P.ws + OFF_PROJ);
    const int lane = tid & 63, w = tid >> 6, kq = lane >> 4, lc = lane & 15, g = h >> 2, row0 = b * 2048;
    const float dt_bias = P.in[I_DTB][l * 16 + h], aneg = -__expf(P.in[I_ALOG][l * 16 + h]), Dh = P.in[I_SSDD][l * 16 + h];
    const bool stg = tid < 320;
#define SSD_TASK(TK) const int task_ = (TK) == 0 ? tid : 512 + tid; const bool tv_ = (TK) == 0 || tid < 128; const int oct_ = task_ % 40, rg4_ = task_ / 40; \
        const int kind_ = oct_ < 16 ? 0 : (oct_ < 32 ? 1 : 2); const int ch0_ = kind_ == 0 ? oct_ * 8 : (kind_ == 1 ? (oct_ - 16) * 8 : (oct_ - 32) * 8); \
        const int xc0_ = kind_ == 0 ? 1024 + g * 128 + ch0_ : (kind_ == 1 ? 1536 + g * 128 + ch0_ : h * 64 + ch0_); const int cbase_ = kind_ == 0 ? ch0_ : (kind_ == 1 ? 128 + ch0_ : 256 + ch0_); const int s0_ = rg4_ * 4;
    LAS float* wl = (LAS float*)(L + 115200);
    LAS float* nwl = wl + 1600;
    if (stg) { const int xc = tid < 128 ? 1024 + g * 128 + tid : (tid < 256 ? 1536 + g * 128 + (tid - 128) : h * 64 + (tid - 256));
        const float* cwp = P.in[I_CONVW] + (size_t)l * 4 * 2048 + xc;
        wl[tid] = cwp[0]; wl[320 + tid] = cwp[2048]; wl[640 + tid] = cwp[4096]; wl[960 + tid] = cwp[6144]; wl[1280 + tid] = P.in[I_CONVB][l * 2048 + xc]; }
    else if (tid < 384) nwl[tid - 320] = P.in[I_SSDNW][l * 1024 + h * 64 + (tid - 320)];
    for (int i = tid; i < 64 * PC / 2; i += NTH) ((LAS unsigned*)Sl)[i] = 0u;
    f32x4 accS[4];
#pragma unroll
    for (int i = 0; i < 4; ++i) accS[i] = (f32x4){0.f, 0.f, 0.f, 0.f};
    bf16_t* Assd = (bf16_t*)(P.ws + OFF_XN); float* ssq = (float*)(P.ws + OFF_SSQ);
    u32x4 raw[2][7]; unsigned short dtraw = 0; u32x4 zraw;
#define SSDM_LOAD(C) do { _Pragma("unroll") for (int tk = 0; tk < 2; ++tk) { SSD_TASK(tk) if (tv_) { _Pragma("unroll") for (int r = 0; r < 7; ++r) { const int gr_ = (C) * 64 + s0_ - 3 + r; \
            raw[tk][r] = gr_ >= 0 ? *(const u32x4*)(proj + (size_t)(row0 + gr_) * NPROJ + C_XBC + xc0_) : (u32x4){0u, 0u, 0u, 0u}; } } } \
        if (w == 0) dtraw = proj[(size_t)(row0 + (C) * 64 + lane) * NPROJ + C_DT + h]; \
        zraw = *(const u32x4*)(proj + (size_t)(row0 + (C) * 64 + (tid >> 3)) * NPROJ + C_Z + h * 64 + 8 * (tid & 7)); } while (0)
    SSDM_LOAD(0);
    __syncthreads();
    for (int c = 0; c < 32; ++c) {
        if (w == 0) { const float dt = softplus(bf2f(dtraw) + dt_bias); float a = dt * aneg;
            a = wave_prefix(a, lane);
            dtl[lane] = dt; acl[lane] = a; }
        const u32x4 zcur = zraw;
        __syncthreads();
#pragma unroll
        for (int tk = 0; tk < 2; ++tk) { SSD_TASK(tk)
          if (tv_) {
            float cw[4][8], cbv[8];
#pragma unroll
            for (int k = 0; k < 4; ++k) { const f32x4 a = *(const LAS f32x4*)(wl + k * 320 + cbase_), c4 = *(const LAS f32x4*)(wl + k * 320 + cbase_ + 4);
                cw[k][0] = a[0]; cw[k][1] = a[1]; cw[k][2] = a[2]; cw[k][3] = a[3]; cw[k][4] = c4[0]; cw[k][5] = c4[1]; cw[k][6] = c4[2]; cw[k][7] = c4[3]; }
            { const f32x4 a = *(const LAS f32x4*)(wl + 1280 + cbase_), c4 = *(const LAS f32x4*)(wl + 1280 + cbase_ + 4);
              cbv[0] = a[0]; cbv[1] = a[1]; cbv[2] = a[2]; cbv[3] = a[3]; cbv[4] = c4[0]; cbv[5] = c4[1]; cbv[6] = c4[2]; cbv[7] = c4[3]; }
            {
                float o8[4][8];
#pragma unroll
                for (int i = 0; i < 4; ++i) {
#pragma unroll
                    for (int j = 0; j < 8; ++j) { float y = cbv[j];
#pragma unroll
                        for (int k = 0; k < 4; ++k) { const u32x4 rr = raw[tk][i + k]; const unsigned wd = (j >> 1) == 0 ? rr.x : ((j >> 1) == 1 ? rr.y : ((j >> 1) == 2 ? rr.z : rr.w));
                            y += cw[k][j] * ((j & 1) ? bfhi(wd) : bflo(wd)); }
                        o8[i][j] = silu(y); } }
                const int s0 = s0_, kind = kind_, ch0 = ch0_;
                if (kind == 0) {
#pragma unroll
                    for (int i = 0; i < 4; ++i) *(LAS u32x4*)(Bl + (s0 + i) * PC + ch0) = pack8(o8[i][0], o8[i][1], o8[i][2], o8[i][3], o8[i][4], o8[i][5], o8[i][6], o8[i][7]);
#pragma unroll
                    for (int j = 0; j < 8; ++j) { u32x2 q; q.x = cvt_pk_bf16(o8[0][j], o8[1][j]); q.y = cvt_pk_bf16(o8[2][j], o8[3][j]); *(LAS u32x2*)(BTl + (ch0 + j) * PT + s0) = q; }
                } else if (kind == 1) {
#pragma unroll
                    for (int i = 0; i < 4; ++i) *(LAS u32x4*)(Cl + (s0 + i) * PC + ch0) = pack8(o8[i][0], o8[i][1], o8[i][2], o8[i][3], o8[i][4], o8[i][5], o8[i][6], o8[i][7]);
                } else {
                    const f32x4 d0 = *(const LAS f32x4*)(dtl + s0), a0 = *(const LAS f32x4*)(acl + s0);
                    const float alast = acl[63];
                    float dv[4] = {d0[0], d0[1], d0[2], d0[3]};
                    float ev[4] = {a0[0], a0[1], a0[2], a0[3]};
#pragma unroll
                    for (int i = 0; i < 4; ++i) ev[i] = dv[i] * __expf(alast - ev[i]);
#pragma unroll
                    for (int i = 0; i < 4; ++i) { *(LAS f32x4*)(xf + (s0 + i) * 64 + ch0) = (f32x4){o8[i][0], o8[i][1], o8[i][2], o8[i][3]}; *(LAS f32x4*)(xf + (s0 + i) * 64 + ch0 + 4) = (f32x4){o8[i][4], o8[i][5], o8[i][6], o8[i][7]}; }
#pragma unroll
                    for (int j = 0; j < 8; ++j) { u32x2 q;
                        q.x = cvt_pk_bf16(o8[0][j] * dv[0], o8[1][j] * dv[1]); q.y = cvt_pk_bf16(o8[2][j] * dv[2], o8[3][j] * dv[3]); *(LAS u32x2*)(XdT + (ch0 + j) * PT + s0) = q;
                        q.x = cvt_pk_bf16(o8[0][j] * ev[0], o8[1][j] * ev[1]); q.y = cvt_pk_bf16(o8[2][j] * ev[2], o8[3][j] * ev[3]); *(LAS u32x2*)(XwT + (ch0 + j) * PT + s0) = q; }
                }
            }
          }
        }
        __syncthreads();
        if (c + 1 < 32) SSDM_LOAD(c + 1);
        f32x4 y2[2];
#pragma unroll
        for (int ti = 0; ti < 2; ++ti) { const int tile = 2 * w + ti, qi = tile >> 2, si = tile & 3;
            f32x4 acc = (f32x4){0.f, 0.f, 0.f, 0.f};
            if (si <= qi) acc = mma_rt<4>(Cl + qi * 16 * PC, PC, Bl + si * 16 * PC, PC, acc, lane);
            const int q0 = qi * 16 + kq * 4, s = si * 16 + lc; const f32x4 aq = *(const LAS f32x4*)(acl + q0); const float as = acl[s];
#pragma unroll
            for (int j = 0; j < 4; ++j) { const float gv = (s <= q0 + j) ? acc[j] * __expf(aq[j] - as) : 0.f; Gl[(q0 + j) * PT + s] = f2bf(gv); }
            y2[ti] = mma_rt<4>(Cl + qi * 16 * PC, PC, Sl + si * 16 * PC, PC, (f32x4){0.f, 0.f, 0.f, 0.f}, lane);
        }
        __syncthreads();
        f32x4 yv[2];
#pragma unroll
        for (int ti = 0; ti < 2; ++ti) { const int tile = 2 * w + ti, qi = tile >> 2, pi = tile & 3;
            const f32x4 y1 = mma_rt<2>(Gl + qi * 16 * PT, PT, XdT + pi * 16 * PT, PT, (f32x4){0.f, 0.f, 0.f, 0.f}, lane);
            const f32x4 aq = *(const LAS f32x4*)(acl + qi * 16 + kq * 4);
#pragma unroll
            for (int j = 0; j < 4; ++j) yv[ti][j] = y1[j] + __expf(aq[j]) * y2[ti][j]; }
        { const float dec = __expf(acl[63]);
#pragma unroll
          for (int i = 0; i < 4; ++i) { const int tile = 4 * w + i, pi = tile >> 3, ni = tile & 7;
              accS[i] = accS[i] * dec; accS[i] = mma_rt<2>(XwT + pi * 16 * PT, PT, BTl + ni * 16 * PT, PT, accS[i], lane);
#pragma unroll
              for (int j = 0; j < 4; ++j) Sl[(pi * 16 + kq * 4 + j) * PC + ni * 16 + lc] = f2bf(accS[i][j]); } }
#pragma unroll
        for (int ti = 0; ti < 2; ++ti) { const int tile = 2 * w + ti, qi = tile >> 2, pi = tile & 3;
#pragma unroll
            for (int j = 0; j < 4; ++j) ybuf[(qi * 16 + kq * 4 + j) * 68 + pi * 16 + lc] = yv[ti][j]; }
        __syncthreads();
        { const int tt = tid >> 3, q8 = tid & 7; const size_t row = (size_t)(row0 + c * 64 + tt);
          const f32x4 v0 = *(const LAS f32x4*)(ybuf + tt * 68 + 8 * q8), v1 = *(const LAS f32x4*)(ybuf + tt * 68 + 8 * q8 + 4);
          const f32x4 x0 = *(const LAS f32x4*)(xf + tt * 64 + 8 * q8), x1 = *(const LAS f32x4*)(xf + tt * 64 + 8 * q8 + 4);
          const f32x4 nw0 = *(const LAS f32x4*)(nwl + 8 * q8), nw1 = *(const LAS f32x4*)(nwl + 8 * q8 + 4);
          float o[8];
          o[0] = (v0[0] + Dh * x0[0]) * silu(bflo(zcur.x)); o[1] = (v0[1] + Dh * x0[1]) * silu(bfhi(zcur.x));
          o[2] = (v0[2] + Dh * x0[2]) * silu(bflo(zcur.y)); o[3] = (v0[3] + Dh * x0[3]) * silu(bfhi(zcur.y));
          o[4] = (v1[0] + Dh * x1[0]) * silu(bflo(zcur.z)); o[5] = (v1[1] + Dh * x1[1]) * silu(bfhi(zcur.z));
          o[6] = (v1[2] + Dh * x1[2]) * silu(bflo(zcur.w)); o[7] = (v1[3] + Dh * x1[3]) * silu(bfhi(zcur.w));
          float sq = 0.f;
#pragma unroll
          for (int j = 0; j < 8; ++j) sq += o[j] * o[j];
          sq = sum8(sq);
          *(u32x4*)(Assd + row * DM + h * 64 + 8 * q8) = pack8(o[0] * nw0[0], o[1] * nw0[1], o[2] * nw0[2], o[3] * nw0[3], o[4] * nw1[0], o[5] * nw1[1], o[6] * nw1[2], o[7] * nw1[3]);
          if (q8 == 0) ssq[row * 16 + h] = sq; }
    }
#undef SSDM_LOAD
#undef SSD_TASK
    { int t2 = tid; asm volatile("" : "+v"(t2)); const int lane = t2 & 63, w = t2 >> 6, kq = lane >> 4, lc = lane & 15;
      float* sp = P.out + O_PSSD + (size_t)((l * 8 + b) * 16 + h) * 64 * 128;
#pragma unroll
      for (int i = 0; i < 4; ++i) { const int tile = 4 * w + i, pi = tile >> 3, ni = tile & 7;
#pragma unroll
          for (int j = 0; j < 4; ++j) sp[(size_t)(pi * 16 + kq * 4 + j) * 128 + ni * 16 + lc] = accS[i][j]; } }
    __syncthreads();
}

__device__ __forceinline__ void hg_half(const Params& P, int l, bool prompt, int b, int hd, int vh, LAS unsigned char* L, int tid) {
    const int Lseq = prompt ? 2048 : 4, row0 = prompt ? b * 2048 : MP + b * 4;
    LAS float* fs = (LAS float*)L; LAS float* qs = fs + 4096; LAS float* vs = qs + 4096; LAS float* ob = vs + 2048;
    const bf16_t* proj = (const bf16_t*)(P.ws + OFF_PROJ); float* oraw = (float*)(P.ws + OFF_TCAT);
    int role = 3, col = 0, dstride = 128; LAS float* dst = fs; float lb = 0.f;
    if (tid < 128) { col = C_F + hd * 128 + tid; dst = fs + tid; role = 0;
        if (l > 0) { const float l0 = P.in[I_LB][hd * 128 + tid], l1 = P.in[I_LB][512 + hd * 128 + tid]; lb = 1.f / (1.f + expf(l0 - l1)); } }
    else if (tid < 256) { col = C_Q + hd * 128 + (tid - 128); dst = qs + (tid - 128); role = 1; }
    else if (tid < 320) { col = C_I + hd * 128 + vh * 64 + (tid - 256); dst = vs + (tid - 256); dstride = 64; role = 1; }
    const int v = tid >> 3, ks = tid & 7;
    f32x4 S[4];
    const size_t sbase = ((size_t)hd * 128) * 128 + vh * 64 + v;
    if (prompt) {
#pragma unroll
        for (int i = 0; i < 4; ++i) S[i] = (f32x4){0.f, 0.f, 0.f, 0.f};
    } else { const float* sp = P.in[I_HG] + (size_t)(l * 128 + b) * 4 * 16384 + sbase;
#pragma unroll
        for (int i = 0; i < 4; ++i)
#pragma unroll
            for (int j = 0; j < 4; ++j) S[i][j] = sp[(size_t)(32 * i + 4 * ks + j) * 128]; }
    unsigned short rv[4];
#define HG_LOAD(T0) do { if (role <= 1) { _Pragma("unroll") for (int tt = 0; tt < 4; ++tt) { int r_ = (T0) + tt; r_ = r_ < Lseq ? r_ : Lseq - 1; rv[tt] = proj[(size_t)(row0 + r_) * NPROJ + col]; } } } while (0)
    HG_LOAD(0);
    for (int t0 = 0; t0 < Lseq; t0 += 32) {
        const int len = (Lseq - t0) < 32 ? (Lseq - t0) : 32;
        if (role == 0) {
#pragma unroll
            for (int tt = 0; tt < 4; ++tt) { const float z = bf2f(rv[tt]); dst[tt * 128] = lb + (1.f - lb) * sigm(z); }
        } else if (role == 1) {
#pragma unroll
            for (int tt = 0; tt < 4; ++tt) dst[tt * dstride] = bf2f(rv[tt]);
        }
        __syncthreads();
        if (t0 + 32 < Lseq) HG_LOAD(t0 + 32);
#define HG_LD(Fx, Qx, vvx, TT) do { const int t_ = (TT) & 31; _Pragma("unroll") for (int i = 0; i < 4; ++i) { Fx[i] = *(const LAS f32x4*)(fs + t_ * 128 + 32 * i + 4 * ks); Qx[i] = *(const LAS f32x4*)(qs + t_ * 128 + 32 * i + 4 * ks); } \
            vvx = vs[t_ * 64 + v]; } while (0)
#define HG_STEP(Fx, Qx, vvx, TT) do { f32x4 o4_ = (f32x4){0.f, 0.f, 0.f, 0.f}; \
            _Pragma("unroll") for (int i = 0; i < 4; ++i) { S[i] = Fx[i] * (S[i] - vvx) + vvx; o4_ += S[i] * Qx[i]; } \
            const float o_ = sum8((o4_[0] + o4_[1]) + (o4_[2] + o4_[3])); if (ks == 0) ob[(TT) * 64 + v] = o_; } while (0)
        { f32x4 F0[4], Q0[4], F1[4], Q1[4]; float vv0, vv1;
          HG_LD(F0, Q0, vv0, 0);
          for (int tt = 0; tt < len; tt += 2) {
              HG_LD(F1, Q1, vv1, tt + 1);
              HG_STEP(F0, Q0, vv0, tt);
              HG_LD(F0, Q0, vv0, tt + 2);
              HG_STEP(F1, Q1, vv1, tt + 1);
          } }
        __syncthreads();
        { const int tt = tid >> 4, q = tid & 15;
          if (tt < len) *(f32x4*)(oraw + (size_t)(row0 + t0 + tt) * 512 + hd * 128 + vh * 64 + 4 * q) = *(const LAS f32x4*)(ob + tt * 64 + 4 * q); }
    }
    { float* sp = P.out + (prompt ? O_PHG + (size_t)(l * 8 + b) * 4 * 16384 : O_SHG + (size_t)(l * 128 + b) * 4 * 16384) + sbase;
#pragma unroll
      for (int i = 0; i < 4; ++i)
#pragma unroll
          for (int j = 0; j < 4; ++j) sp[(size_t)(32 * i + 4 * ks + j) * 128] = S[i][j]; }
    __syncthreads();
}
__device__ __forceinline__ void hg_mfma_half(const Params& P, int l, int b, int hd, int vh, LAS unsigned char* L, int tid) {
    constexpr int PC = 136, PT = 72;
    LAS bf16_t* Qt = (LAS bf16_t*)L; LAS bf16_t* Kt = (LAS bf16_t*)(L + 17408); LAS bf16_t* Qs = (LAS bf16_t*)(L + 34816); LAS bf16_t* Al = (LAS bf16_t*)(L + 52224);
    LAS bf16_t* VT = (LAS bf16_t*)(L + 61440); LAS bf16_t* KdT = (LAS bf16_t*)(L + 70656); LAS bf16_t* ST = (LAS bf16_t*)(L + 89088);
    LAS float* tot = (LAS float*)(L + 106496); LAS float* el = (LAS float*)(L + 114688); LAS float* lbl = (LAS float*)(L + 115200); LAS float* plx = (LAS float*)(L + 115712);
    const bf16_t* proj = (const bf16_t*)(P.ws + OFF_PROJ); float* oraw = (float*)(P.ws + OFF_TCAT);
    const int lane = tid & 63, w = tid >> 6, kq = lane >> 4, lc = lane & 15, row0 = b * 2048;
    const bool isf = tid < 256; const int t2 = tid & 255, oct = t2 & 15, rg = t2 >> 4, k0 = oct * 8, s0 = rg * 4;
    const bool hasv = !isf && oct < 8;
    const int colA = (isf ? C_F : C_Q) + hd * 128 + k0, colV = C_I + hd * 128 + vh * 64 + k0;
    if (tid < 128) { float lb = 0.f; if (l > 0) { const float l0 = P.in[I_LB][hd * 128 + tid], l1 = P.in[I_LB][512 + hd * 128 + tid]; lb = 1.f / (1.f + expf(l0 - l1)); } lbl[tid] = lb; }
    for (int i = tid; i < 64 * PC / 2; i += NTH) ((LAS unsigned*)ST)[i] = 0u;
    f32x4 accS[4];
#pragma unroll
    for (int i = 0; i < 4; ++i) accS[i] = (f32x4){0.f, 0.f, 0.f, 0.f};
    u32x4 rawA[4], rawV[4];
#define HGM_LOAD(C) do { _Pragma("unroll") for (int r = 0; r < 4; ++r) { const size_t ro_ = (size_t)(row0 + (C) * 64 + s0 + r) * NPROJ; \
            rawA[r] = *(const u32x4*)(proj + ro_ + colA); if (hasv) rawV[r] = *(const u32x4*)(proj + ro_ + colV); } } while (0)
#define UNP(rr, j) (((j) & 1) ? bfhi(((j) >> 1) == 0 ? (rr).x : (((j) >> 1) == 1 ? (rr).y : (((j) >> 1) == 2 ? (rr).z : (rr).w))) : bflo(((j) >> 1) == 0 ? (rr).x : (((j) >> 1) == 1 ? (rr).y : (((j) >> 1) == 2 ? (rr).z : (rr).w))))
    HGM_LOAD(0);
    __syncthreads();
    for (int c = 0; c < 32; ++c) {
        int tl_ = tid; asm volatile("" : "+v"(tl_));
        const int lane = tl_ & 63, w = tl_ >> 6, kq = lane >> 4, lc = lane & 15;
        const bool isf = tl_ < 256; const int t2 = tl_ & 255, oct = t2 & 15, rg = t2 >> 4, k0 = oct * 8, s0 = rg * 4;
        const bool hasv = !isf && oct < 8;
        const int colA = (isf ? C_F : C_Q) + hd * 128 + k0, colV = C_I + hd * 128 + vh * 64 + k0;
        float pl[4][8], kk[4][8];
        if (isf) {
            const f32x4 la = *(const LAS f32x4*)(lbl + k0), lb4 = *(const LAS f32x4*)(lbl + k0 + 4);
            const float lbv[8] = {la[0], la[1], la[2], la[3], lb4[0], lb4[1], lb4[2], lb4[3]};
#pragma unroll
            for (int j = 0; j < 8; ++j) { float run = 0.f;
#pragma unroll
                for (int i = 0; i < 4; ++i) { const float z = UNP(rawA[i], j); const float t = __expf(-z), r = __builtin_amdgcn_rcpf(1.f + t);
                    const float f = lbv[j] + (1.f - lbv[j]) * r; kk[i][j] = (1.f - lbv[j]) * t * r; run += __logf(f); pl[i][j] = run; } }
            *(LAS f32x4*)(tot + rg * 128 + k0) = (f32x4){pl[3][0], pl[3][1], pl[3][2], pl[3][3]}; *(LAS f32x4*)(tot + rg * 128 + k0 + 4) = (f32x4){pl[3][4], pl[3][5], pl[3][6], pl[3][7]};
#pragma unroll
            for (int i = 0; i < 4; ++i) { *(LAS f32x4*)(plx + (s0 + i) * 128 + k0) = (f32x4){pl[i][0], pl[i][1], pl[i][2], pl[i][3]}; *(LAS f32x4*)(plx + (s0 + i) * 128 + k0 + 4) = (f32x4){pl[i][4], pl[i][5], pl[i][6], pl[i][7]}; }
        } else {
#pragma unroll
            for (int i = 0; i < 4; ++i)
#pragma unroll
                for (int j = 0; j < 8; ++j) { pl[i][j] = 0.f; kk[i][j] = 0.f; }
            if (hasv) {
#pragma unroll
                for (int j = 0; j < 8; ++j) { u32x2 q; q.x = cvt_pk_bf16(UNP(rawV[0], j), UNP(rawV[1], j)); q.y = cvt_pk_bf16(UNP(rawV[2], j), UNP(rawV[3], j)); *(LAS u32x2*)(VT + (k0 + j) * PT + s0) = q; } }
        }
        __syncthreads();
        { float base[8], ref[8], bl[8];
#pragma unroll
          for (int j = 0; j < 8; ++j) { base[j] = 0.f; ref[j] = 0.f; bl[j] = 0.f; }
#pragma unroll
          for (int r = 0; r < 16; ++r) { const f32x4 t0 = *(const LAS f32x4*)(tot + r * 128 + k0), t1 = *(const LAS f32x4*)(tot + r * 128 + k0 + 4);
              const float tv[8] = {t0[0], t0[1], t0[2], t0[3], t1[0], t1[1], t1[2], t1[3]};
#pragma unroll
              for (int j = 0; j < 8; ++j) { if (r < rg) base[j] += tv[j]; if (r < 8) ref[j] += tv[j]; bl[j] += tv[j]; } }
          if (isf) {
              float kt[4][8], kd[4][8];
#pragma unroll
              for (int j = 0; j < 8; ++j) { const float e1 = __expf(bl[j] - ref[j]);
#pragma unroll
                  for (int i = 0; i < 4; ++i) { kt[i][j] = kk[i][j] * __expf(ref[j] - (base[j] + pl[i][j])); kd[i][j] = kt[i][j] * e1; } }
#pragma unroll
              for (int i = 0; i < 4; ++i) *(LAS u32x4*)(Kt + (s0 + i) * PC + k0) = pack8(kt[i][0], kt[i][1], kt[i][2], kt[i][3], kt[i][4], kt[i][5], kt[i][6], kt[i][7]);
#pragma unroll
              for (int j = 0; j < 8; ++j) { u32x2 q; q.x = cvt_pk_bf16(kd[0][j], kd[1][j]); q.y = cvt_pk_bf16(kd[2][j], kd[3][j]); *(LAS u32x2*)(KdT + (k0 + j) * PT + s0) = q; }
              if (rg == 0) { *(LAS f32x4*)(el + k0) = (f32x4){__expf(bl[0]), __expf(bl[1]), __expf(bl[2]), __expf(bl[3])}; *(LAS f32x4*)(el + k0 + 4) = (f32x4){__expf(bl[4]), __expf(bl[5]), __expf(bl[6]), __expf(bl[7])}; }
          } else {
              float e2[8];
#pragma unroll
              for (int j = 0; j < 8; ++j) e2[j] = __expf(ref[j]);
#pragma unroll
              for (int i = 0; i < 4; ++i) { float qt[8], qs[8];
                  const f32x4 p0 = *(const LAS f32x4*)(plx + (s0 + i) * 128 + k0), p1 = *(const LAS f32x4*)(plx + (s0 + i) * 128 + k0 + 4);
                  const float pv[8] = {p0[0], p0[1], p0[2], p0[3], p1[0], p1[1], p1[2], p1[3]};
#pragma unroll
                  for (int j = 0; j < 8; ++j) { const float qv = UNP(rawA[i], j); qt[j] = qv * __expf(base[j] + pv[j] - ref[j]); qs[j] = qt[j] * e2[j]; }
                  *(LAS u32x4*)(Qt + (s0 + i) * PC + k0) = pack8(qt[0], qt[1], qt[2], qt[3], qt[4], qt[5], qt[6], qt[7]);
                  *(LAS u32x4*)(Qs + (s0 + i) * PC + k0) = pack8(qs[0], qs[1], qs[2], qs[3], qs[4], qs[5], qs[6], qs[7]); }
          } }
        __syncthreads();
        if (c + 1 < 32) HGM_LOAD(c + 1);
        f32x4 o2[2];
#pragma unroll
        for (int ti = 0; ti < 2; ++ti) { const int tile = 2 * w + ti, qi = tile >> 2, si = tile & 3;
            f32x4 acc = (f32x4){0.f, 0.f, 0.f, 0.f};
            if (si <= qi) acc = mma_rt<4>(Qt + qi * 16 * PC, PC, Kt + si * 16 * PC, PC, acc, lane);
            const int q0 = qi * 16 + kq * 4, s = si * 16 + lc;
#pragma unroll
            for (int j = 0; j < 4; ++j) Al[(q0 + j) * PT + s] = f2bf((s <= q0 + j) ? acc[j] : 0.f);
            o2[ti] = mma_rt<4>(Qs + qi * 16 * PC, PC, ST + si * 16 * PC, PC, (f32x4){0.f, 0.f, 0.f, 0.f}, lane);
        }
        __syncthreads();
#pragma unroll
        for (int ti = 0; ti < 2; ++ti) { const int tile = 2 * w + ti, qi = tile >> 2, vi = tile & 3;
            const f32x4 o1 = mma_rt<2>(Al + qi * 16 * PT, PT, VT + vi * 16 * PT, PT, o2[ti], lane);
            float* op = oraw + (size_t)(row0 + c * 64 + qi * 16 + kq * 4) * 512 + hd * 128 + vh * 64 + vi * 16 + lc;
#pragma unroll
            for (int j = 0; j < 4; ++j) op[(size_t)j * 512] = o1[j]; }
#pragma unroll
        for (int i = 0; i < 4; ++i) { const int tile = 4 * w + i, vi = tile >> 3, ki = tile & 7;
            const float dec = el[ki * 16 + lc];
            accS[i] = accS[i] * dec; accS[i] = mma_rt<2>(VT + vi * 16 * PT, PT, KdT + ki * 16 * PT, PT, accS[i], lane);
#pragma unroll
            for (int j = 0; j < 4; ++j) ST[(vi * 16 + kq * 4 + j) * PC + ki * 16 + lc] = f2bf(accS[i][j]); }
        __syncthreads();
    }
#undef HGM_LOAD
#undef UNP
    { int t2 = tid; asm volatile("" : "+v"(t2)); const int lane = t2 & 63, w = t2 >> 6, kq = lane >> 4, lc = lane & 15;
      float* sp = P.out + O_PHG + (size_t)((l * 8 + b) * 4 + hd) * 16384 + vh * 64;
#pragma unroll
      for (int i = 0; i < 4; ++i) { const int tile = 4 * w + i, vi = tile >> 3, ki = tile & 7;
#pragma unroll
          for (int j = 0; j < 4; ++j) sp[(size_t)(ki * 16 + lc) * 128 + vi * 16 + kq * 4 + j] = accS[i][j]; } }
    __syncthreads();
}

__device__ __forceinline__ void hg_norm(const Params& P, int l, int row0, int nrows, int hd, int tid) {
    const int sub = tid & 7, rg = tid >> 3;
    const bf16_t* proj = (const bf16_t*)(P.ws + OFF_PROJ); const float* oraw = (const float*)(P.ws + OFF_TCAT); bf16_t* Ahg = (bf16_t*)(P.ws + OFF_AHG);
    const float* nwp = P.in[I_HGNW] + l * 512 + hd * 128 + 16 * sub;
    f32x4 nw[4];
#pragma unroll
    for (int i = 0; i < 4; ++i) nw[i] = *(const f32x4*)(nwp + 4 * i);
    for (int r = rg; r < ((nrows + 63) & ~63); r += 64) { const int rr = r < nrows ? r : nrows - 1; const size_t row = (size_t)(row0 + rr);
        const float* op = oraw + row * 512 + hd * 128 + 16 * sub;
        f32x4 o[4]; float ss = 0.f;
#pragma unroll
        for (int i = 0; i < 4; ++i) { o[i] = *(const f32x4*)(op + 4 * i); ss += (o[i][0] * o[i][0] + o[i][1] * o[i][1]) + (o[i][2] * o[i][2] + o[i][3] * o[i][3]); }
        const u32x4 g0 = *(const u32x4*)(proj + row * NPROJ + C_G + hd * 128 + 16 * sub), g1 = *(const u32x4*)(proj + row * NPROJ + C_G + hd * 128 + 16 * sub + 8);
        ss = sum8(ss);
        const float rstd = 1.f / sqrtf(ss * (1.f / 128.f) + EPSN);
        u32x4 w0, w1;
        w0.x = cvt_pk_bf16(o[0][0] * rstd * nw[0][0] * silu(bflo(g0.x)), o[0][1] * rstd * nw[0][1] * silu(bfhi(g0.x)));
        w0.y = cvt_pk_bf16(o[0][2] * rstd * nw[0][2] * silu(bflo(g0.y)), o[0][3] * rstd * nw[0][3] * silu(bfhi(g0.y)));
        w0.z = cvt_pk_bf16(o[1][0] * rstd * nw[1][0] * silu(bflo(g0.z)), o[1][1] * rstd * nw[1][1] * silu(bfhi(g0.z)));
        w0.w = cvt_pk_bf16(o[1][2] * rstd * nw[1][2] * silu(bflo(g0.w)), o[1][3] * rstd * nw[1][3] * silu(bfhi(g0.w)));
        w1.x = cvt_pk_bf16(o[2][0] * rstd * nw[2][0] * silu(bflo(g1.x)), o[2][1] * rstd * nw[2][1] * silu(bfhi(g1.x)));
        w1.y = cvt_pk_bf16(o[2][2] * rstd * nw[2][2] * silu(bflo(g1.y)), o[2][3] * rstd * nw[2][3] * silu(bfhi(g1.y)));
        w1.z = cvt_pk_bf16(o[3][0] * rstd * nw[3][0] * silu(bflo(g1.z)), o[3][1] * rstd * nw[3][1] * silu(bfhi(g1.z)));
        w1.w = cvt_pk_bf16(o[3][2] * rstd * nw[3][2] * silu(bflo(g1.w)), o[3][3] * rstd * nw[3][3] * silu(bfhi(g1.w)));
        if (r < nrows) { *(u32x4*)(Ahg + row * 512 + hd * 128 + 16 * sub) = w0; *(u32x4*)(Ahg + row * 512 + hd * 128 + 16 * sub + 8) = w1; }
    }
}

__device__ __forceinline__ void s5_item(const Params& P, int l, bool prompt, int bq, int g, LAS unsigned char* L, int tid) {
    const int lane = tid & 63, w = tid >> 6, n = lane, jc = lane & 15, tq = lane >> 4;
    LAS float* us = (LAS float*)(L + w * 14336); LAS bf16_t* Xc = (LAS bf16_t*)(L + w * 14336 + 1024); LAS float* BUl = (LAS float*)(L + w * 14336 + 5376); LAS float* hl = (LAS float*)(L + 8 * 14336);
    const bf16_t* proj = (const bf16_t*)(P.ws + OFF_PROJ); bf16_t* Aglu = (bf16_t*)(P.ws + OFF_AGLU);
    const int lg = l * 32 + g;
    const float delta = expf(P.in[I_S5LDT][lg]), lr = P.in[I_S5LR][lg * 64 + n], li = P.in[I_S5LI][lg * 64 + n];
    const float mag = expf(lr * delta), ab_re = mag * cosf(li * delta), ab_im = mag * sinf(li * delta);
    const float den = lr * lr + li * li, nr = ab_re - 1.f, co_re = (nr * lr + ab_im * li) / den, co_im = (ab_im * lr - nr * li) / den;
    bf16x8 Bu[8];
#pragma unroll
    for (int tile = 0; tile < 4; ++tile) { const int nn = tile * 16 + jc; const float cr = __shfl(co_re, nn), ci = __shfl(co_im, nn);
        u32x4 pr = (u32x4){0u, 0u, 0u, 0u}, pi = (u32x4){0u, 0u, 0u, 0u};
        if (tq < 2) { const f32x4* br4 = (const f32x4*)(P.in[I_S5BR] + ((size_t)lg * 64 + nn) * 16 + tq * 8); const f32x4* bi4 = (const f32x4*)(P.in[I_S5BI] + ((size_t)lg * 64 + nn) * 16 + tq * 8);
            const f32x4 a0 = br4[0], a1 = br4[1], c0 = bi4[0], c1 = bi4[1];
            pr = pack8(cr * a0[0] - ci * c0[0], cr * a0[1] - ci * c0[1], cr * a0[2] - ci * c0[2], cr * a0[3] - ci * c0[3], cr * a1[0] - ci * c1[0], cr * a1[1] - ci * c1[1], cr * a1[2] - ci * c1[2], cr * a1[3] - ci * c1[3]);
            pi = pack8(cr * c0[0] + ci * a0[0], cr * c0[1] + ci * a0[1], cr * c0[2] + ci * a0[2], cr * c0[3] + ci * a0[3], cr * c1[0] + ci * a1[0], cr * c1[1] + ci * a1[1], cr * c1[2] + ci * a1[2], cr * c1[3] + ci * a1[3]); }
        Bu[tile] = __builtin_bit_cast(bf16x8, pr); Bu[4 + tile] = __builtin_bit_cast(bf16x8, pi); }
    bf16x8 Breg[4];
    { const float* cr = P.in[I_S5CR] + ((size_t)lg * 16 + jc) * 64; const float* ci = P.in[I_S5CI] + ((size_t)lg * 16 + jc) * 64;
#pragma unroll
      for (int kt = 0; kt < 4; ++kt) { const float* src = (kt < 2 ? cr : ci) + (kt & 1) * 32 + tq * 8; const float sg = kt < 2 ? 1.f : -1.f;
          const f32x4 a = *(const f32x4*)src, c = *(const f32x4*)(src + 4);
          Breg[kt] = __builtin_bit_cast(bf16x8, pack8(sg * a[0], sg * a[1], sg * a[2], sg * a[3], sg * c[0], sg * c[1], sg * c[2], sg * c[3])); } }
    const float dj = P.in[I_S5D][l * 512 + g * 16 + jc];
    const int b = prompt ? bq : bq * 8 + w;
    const int rowseg = prompt ? b * 2048 + w * 256 : MP + b * 4;
    const int nchunk = prompt ? 16 : 1, clen = prompt ? 16 : 4;
    const int tA = jc < clen ? jc : clen - 1;
#define S5_LDA(CH) ((tq < 2) ? *(const u32x4*)(proj + (size_t)(rowseg + (CH) * 16 + tA) * NPROJ + C_U + g * 16 + tq * 8) : (u32x4){0u, 0u, 0u, 0u})
#define S5_BU(AF) do { const bf16x8 a_ = __builtin_bit_cast(bf16x8, (AF)); _Pragma("unroll") for (int tile = 0; tile < 8; ++tile) { \
        const f32x4 d_ = __builtin_amdgcn_mfma_f32_16x16x32_bf16(a_, Bu[tile], (f32x4){0.f, 0.f, 0.f, 0.f}, 0, 0, 0); \
        _Pragma("unroll") for (int j = 0; j < 4; ++j) BUl[(tq * 4 + j) * 132 + tile * 16 + jc] = d_[j]; } } while (0)
    float xr = 0.f, xi = 0.f;
    if (prompt) {
        u32x4 af = S5_LDA(0);
        for (int ch = 0; ch < nchunk; ++ch) {
            S5_BU(af);
            __syncthreads();
            if (ch + 1 < nchunk) af = S5_LDA(ch + 1);
            for (int tt = 0; tt < 16; ++tt) { const float bur = BUl[tt * 132 + n], bui = BUl[tt * 132 + 64 + n];
                const float nxr = ab_re * xr - ab_im * xi + bur, nxi = ab_re * xi + ab_im * xr + bui; xr = nxr; xi = nxi; }
            __syncthreads();
        }
        hl[(w * 64 + n) * 2] = xr; hl[(w * 64 + n) * 2 + 1] = xi;
        float pr_ = ab_re, pi_ = ab_im;
#pragma unroll
        for (int q = 0; q < 8; ++q) { const float a = pr_ * pr_ - pi_ * pi_, c = 2.f * pr_ * pi_; pr_ = a; pi_ = c; }
        __syncthreads();
        xr = 0.f; xi = 0.f;
        for (int ww = 0; ww < w; ++ww) { const float hr = hl[(ww * 64 + n) * 2], hi = hl[(ww * 64 + n) * 2 + 1]; const float a = pr_ * xr - pi_ * xi + hr, c = pr_ * xi + pi_ * xr + hi; xr = a; xi = c; }
    } else { xr = P.in[I_S5R][((size_t)(l * 128 + b) * 32 + g) * 64 + n]; xi = P.in[I_S5I][((size_t)(l * 128 + b) * 32 + g) * 64 + n]; }
    u32x2 uu2; { const int t = (lane >> 2) < clen ? (lane >> 2) : clen - 1; uu2 = *(const u32x2*)(proj + (size_t)(rowseg + t) * NPROJ + C_U + g * 16 + (lane & 3) * 4); }
    u32x4 af2 = S5_LDA(0);
    for (int ch = 0; ch < nchunk; ++ch) {
        { const int t = lane >> 2, q4 = lane & 3;
          *(LAS f32x4*)(us + t * 16 + q4 * 4) = (f32x4){bflo(uu2.x), bfhi(uu2.x), bflo(uu2.y), bfhi(uu2.y)}; }
        S5_BU(af2);
        __syncthreads();
        if (ch + 1 < nchunk) { uu2 = *(const u32x2*)(proj + (size_t)(rowseg + (ch + 1) * 16 + (lane >> 2)) * NPROJ + C_U + g * 16 + (lane & 3) * 4); af2 = S5_LDA(ch + 1); }
        for (int tt = 0; tt < clen; ++tt) { const float bur = BUl[tt * 132 + n], bui = BUl[tt * 132 + 64 + n];
            const float nxr = ab_re * xr - ab_im * xi + bur, nxi = ab_re * xi + ab_im * xr + bui; xr = nxr; xi = nxi;
            Xc[tt * 136 + n] = f2bf(xr); Xc[tt * 136 + 64 + n] = f2bf(xi); }
        __syncthreads();
        f32x4 acc = (f32x4){0.f, 0.f, 0.f, 0.f};
#pragma unroll
        for (int kt = 0; kt < 4; ++kt) { const bf16x8 a = *(const LAS bf16x8*)(Xc + jc * 136 + kt * 32 + tq * 8); acc = __builtin_amdgcn_mfma_f32_16x16x32_bf16(a, Breg[kt], acc, 0, 0, 0); }
#pragma unroll
        for (int j = 0; j < 4; ++j) { const int t = tq * 4 + j;
            if (t < clen) { const float y = acc[j] + dj * us[t * 16 + jc]; Aglu[(size_t)(rowseg + ch * 16 + t) * 512 + g * 16 + jc] = f2bf(gelu_tanh(y)); } }
        __syncthreads();
    }
#undef S5_LDA
#undef S5_BU
    if (prompt) { if (w == 7) { P.out[O_PS5R + ((size_t)(l * 8 + b) * 32 + g) * 64 + n] = xr; P.out[O_PS5I + ((size_t)(l * 8 + b) * 32 + g) * 64 + n] = xi; } }
    else { P.out[O_SS5R + ((size_t)(l * 128 + b) * 32 + g) * 64 + n] = xr; P.out[O_SS5I + ((size_t)(l * 128 + b) * 32 + g) * 64 + n] = xi; }
}

__device__ __forceinline__ void convstate_item(const Params& P, int l, int sq, int tid) {
    const bf16_t* proj = (const bf16_t*)(P.ws + OFF_PROJ);
    const bool pr = sq < 8; const int b = pr ? sq : sq - 8;
    const int rbase = pr ? b * 2048 + 2045 : MP + b * 4 + 1;
    float* dst = P.out + (pr ? O_PSSDC + (size_t)(l * 8 + b) * 3 * 2048 : O_SSSDC + (size_t)(l * 128 + b) * 3 * 2048);
    for (int e = tid; e < 768; e += NTH) { const int j = e >> 8, oc = e & 255;
        const u32x4 v = *(const u32x4*)(proj + (size_t)(rbase + j) * NPROJ + C_XBC + oc * 8);
        *(f32x4*)(dst + j * 2048 + oc * 8) = (f32x4){bflo(v.x), bfhi(v.x), bflo(v.y), bfhi(v.y)};
        *(f32x4*)(dst + j * 2048 + oc * 8 + 4) = (f32x4){bflo(v.z), bfhi(v.z), bflo(v.w), bfhi(v.w)}; }
}

constexpr int IT_SSDP = 128, IT_HGP = 64, IT_S5P = 256, IT_SSDS = 512, IT_HGS = 512, IT_S5S = 512, IT_CS = 136, IT_HGN = 128;
constexpr int IT_TOTAL = IT_SSDP + IT_HGP + IT_S5P + IT_SSDS + IT_HGS + IT_S5S + IT_CS + IT_HGN;
__device__ __forceinline__ void mix_phase(const Params& P, int l, LAS unsigned char* L, int tid_in, int rep = 0, int lo = 0, int hi = 1 << 30) {
    int tid = tid_in;
    unsigned* ctl = (unsigned*)(P.ws + OFF_CTL);
    volatile LAS int* misc = (volatile LAS int*)(L + MISC_OFF);
    constexpr int IT_HEAVY = IT_SSDP + IT_HGP + IT_S5P;
    bool pre = false;
    for (;;) {
        if (!pre && tid == 0) misc[0] = (int)atomicAdd(ctl + l + 2 * rep, 1u);
        __syncthreads();
        int it = misc[0] + lo;
        __syncthreads();
        if (it >= IT_TOTAL || it >= hi) break;
        const bool light = it >= IT_HEAVY;
        int nxt = 0; if (light && tid == 0) nxt = (int)atomicAdd(ctl + l + 2 * rep, 1u);
        asm volatile("" : "+v"(tid));
      do {
        if (it < IT_SSDP) { ssd_mfma_item(P, l, it >> 4, it & 15, L, tid); continue; } it -= IT_SSDP;
        if (it < IT_HGP) { const int b = it >> 3, hd = (it >> 1) & 3, vh = it & 1;
            hg_mfma_half(P, l, b, hd, vh, L, tid);
            asm volatile("s_waitcnt vmcnt(0)" ::: "memory"); __syncthreads();
            if (tid == 0) { __builtin_amdgcn_fence(__ATOMIC_RELEASE, "agent"); asm volatile("s_waitcnt vmcnt(0)" ::: "memory"); (void)atomicAdd(ctl + 16 + rep * 64 + l * 32 + b * 4 + hd, 1u); }
            continue; } it -= IT_HGP;
        if (it < IT_S5P) { s5_item(P, l, true, it >> 5, it & 31, L, tid); continue; } it -= IT_S5P;
        if (it < IT_SSDS) { ssd_s4_item(P, l, it >> 2, it & 3, L, tid); continue; } it -= IT_SSDS;
        if (it < IT_HGS) { const int b = it >> 2, hd = it & 3;
            hg_half(P, l, false, b, hd, 0, L, tid); hg_half(P, l, false, b, hd, 1, L, tid);
            asm volatile("s_waitcnt vmcnt(0)" ::: "memory"); __syncthreads();
            hg_norm(P, l, MP + b * 4, 4, hd, tid);
            continue; } it -= IT_HGS;
        if (it < IT_S5S) { s5_item(P, l, false, it >> 5, it & 31, L, tid); continue; } it -= IT_S5S;
        if (it < IT_CS) { convstate_item(P, l, it, tid); continue; } it -= IT_CS;
        { const int bh = it >> 2, rq = it & 3;
          if (tid == 0) { unsigned* c = ctl + 16 + rep * 64 + l * 32 + bh; unsigned sp = 0;
              while (__hip_atomic_load(c, __ATOMIC_RELAXED, __HIP_MEMORY_SCOPE_AGENT) < 2u && ++sp < (1u << 24)) __builtin_amdgcn_s_sleep(8); }
          __syncthreads();
          __builtin_amdgcn_fence(__ATOMIC_ACQUIRE, "agent"); asm volatile("s_waitcnt vmcnt(0)" ::: "memory");
          hg_norm(P, l, (bh >> 2) * 2048 + rq * 512, 512, bh & 3, tid); }
      } while (0);
        if (light && tid == 0) misc[0] = nxt;
        pre = light;
    }
}

__device__ __forceinline__ void small_res_gemm(const bf16_t* A, const bf16_t* Bt, int K, const Params& P, int from_in, int tid, int bid) {
    const int lane = tid & 63, w = tid >> 6, kq = lane >> 4, lc = lane & 15;
    for (int t = bid; t < 256; t += gridDim.x) {
        const int rt = t >> 4, ct = t & 15, r0 = MP + rt * 32 + (w >> 2) * 16, c0 = ct * 64 + (w & 3) * 16;
        const bf16_t* ap = A + (size_t)(r0 + lc) * K + kq * 8; const bf16_t* bp = Bt + (size_t)(c0 + lc) * K + kq * 8;
        f32x4 acc = (f32x4){0.f, 0.f, 0.f, 0.f};
        { bf16x8 a0[8], b0[8], a1[8], b1[8]; const int nb = K >> 8;
#define SG_LD(AX, BX, I) do { _Pragma("unroll") for (int i_ = 0; i_ < 8; ++i_) { AX[i_] = *(const bf16x8*)(ap + (I) * 256 + i_ * 32); BX[i_] = *(const bf16x8*)(bp + (I) * 256 + i_ * 32); } } while (0)
#define SG_MM(AX, BX) do { _Pragma("unroll") for (int i_ = 0; i_ < 8; ++i_) acc = __builtin_amdgcn_mfma_f32_16x16x32_bf16(AX[i_], BX[i_], acc, 0, 0, 0); } while (0)
          SG_LD(a0, b0, 0);
          for (int i = 0; i < nb; i += 2) {
              if (i + 1 < nb) SG_LD(a1, b1, i + 1);
              SG_MM(a0, b0);
              if (i + 2 < nb) SG_LD(a0, b0, i + 2);
              if (i + 1 < nb) SG_MM(a1, b1);
          }
#undef SG_LD
#undef SG_MM
        }
#pragma unroll
        for (int j = 0; j < 4; ++j) { const int r = r0 + kq * 4 + j, c = c0 + lc;
            const float base = from_in ? P.in[I_XS][(size_t)(r - MP) * DM + c] : P.out[(size_t)r * DM + c];
            P.out[(size_t)r * DM + c] = base + acc[j]; }
    }
}

template <int MODE>
__device__ __forceinline__ void small_sg_gemm(const bf16_t* A, const bf16_t* Bt, int K, const Params& P, int tid, int bid) {
    const int lane = tid & 63, w = tid >> 6, kq = lane >> 4, lc = lane & 15;
    for (int t = bid; t < 256; t += gridDim.x) {
        const int rt = t >> 4, ct = t & 15, r0 = MP + rt * 32 + (w >> 2) * 16, c0 = ct * 64 + (w & 3) * 16;
        const bf16_t* ap = A + (size_t)(r0 + lc) * K + kq * 8; const bf16_t* bp = Bt + (size_t)(c0 + lc) * K + kq * 8;
        f32x4 acc = (f32x4){0.f, 0.f, 0.f, 0.f};
        { bf16x8 a0[8], b0[8], a1[8], b1[8]; const int nb = K >> 8;
#define SG_LD(AX, BX, I) do { _Pragma("unroll") for (int i_ = 0; i_ < 8; ++i_) { AX[i_] = *(const bf16x8*)(ap + (I) * 256 + i_ * 32); BX[i_] = *(const bf16x8*)(bp + (I) * 256 + i_ * 32); } } while (0)
#define SG_MM(AX, BX) do { _Pragma("unroll") for (int i_ = 0; i_ < 8; ++i_) acc = __builtin_amdgcn_mfma_f32_16x16x32_bf16(AX[i_], BX[i_], acc, 0, 0, 0); } while (0)
          SG_LD(a0, b0, 0);
          for (int i = 0; i < nb; i += 2) {
              if (i + 1 < nb) SG_LD(a1, b1, i + 1);
              SG_MM(a0, b0);
              if (i + 2 < nb) SG_LD(a0, b0, i + 2);
              if (i + 1 < nb) SG_MM(a1, b1);
          }
#undef SG_LD
#undef SG_MM
        }
#pragma unroll
        for (int j = 0; j < 4; ++j) { const int r = r0 + kq * 4 + j, c = c0 + lc;
            const bf16_t* proj = (const bf16_t*)(P.ws + OFF_PROJ); bf16_t* mp = (bf16_t*)(P.ws + OFF_TCAT) + (size_t)r * 1024 + c;
            float val = sigm(bf2f(proj[(size_t)r * NPROJ + C_GATE + MODE * 1024 + c])) * acc[j];
            if (MODE == 1) { const f32x4* sp = (const f32x4*)((const float*)(P.ws + OFF_SSQ) + (size_t)r * 16); const f32x4 s0 = sp[0], s1 = sp[1], s2 = sp[2], s3 = sp[3];
                const float tot = ((s0[0] + s0[1]) + (s0[2] + s0[3])) + ((s1[0] + s1[1]) + (s1[2] + s1[3])) + ((s2[0] + s2[1]) + (s2[2] + s2[3])) + ((s3[0] + s3[1]) + (s3[2] + s3[3]));
                val *= 1.f / sqrtf(tot * (1.f / 1024.f) + EPSN); *mp = f2bf(val); }
            else *mp = f2bf(bf2f(*mp) + val); }
    }
}

__device__ __forceinline__ void small_g1_tail(const bf16_t* A, const bf16_t* Bt, bf16_t* proj, int tid, int bid) {
    const int lane = tid & 63, w = tid >> 6, kq = lane >> 4, lc = lane & 15;
    const bf16_t* bp = Bt + (size_t)(8704 + lc) * 1024 + kq * 8;
    for (int t = bid * 8 + w; t < MT / 16; t += gridDim.x * 8) {
        const bf16_t* ap = A + (size_t)(t * 16 + lc) * 1024 + kq * 8;
        f32x4 acc = (f32x4){0.f, 0.f, 0.f, 0.f};
        bf16x8 a0[8], b0[8], a1[8], b1[8];
#define SG_LD(AX, BX, I) do { _Pragma("unroll") for (int i_ = 0; i_ < 8; ++i_) { AX[i_] = *(const bf16x8*)(ap + (I) * 256 + i_ * 32); BX[i_] = *(const bf16x8*)(bp + (I) * 256 + i_ * 32); } } while (0)
#define SG_MM(AX, BX) do { _Pragma("unroll") for (int i_ = 0; i_ < 8; ++i_) acc = __builtin_amdgcn_mfma_f32_16x16x32_bf16(AX[i_], BX[i_], acc, 0, 0, 0); } while (0)
        SG_LD(a0, b0, 0); SG_LD(a1, b1, 1); SG_MM(a0, b0); SG_LD(a0, b0, 2); SG_MM(a1, b1); SG_LD(a1, b1, 3); SG_MM(a0, b0); SG_MM(a1, b1);
#undef SG_LD
#undef SG_MM
#pragma unroll
        for (int j = 0; j < 4; ++j) proj[(size_t)(t * 16 + kq * 4 + j) * NPROJ + 8704 + lc] = f2bf(acc[j]);
    }
}

template <int MODE>
__device__ __forceinline__ void small_gemm_ks(const bf16_t* A, const bf16_t* Bt, const int K, const Params& P, int from_in, LAS unsigned char* L, int tid, int bid) {
    const int lane = tid & 63, w = tid >> 6, kq = lane >> 4, lc = lane & 15;
    LAS float* red = (LAS float*)L;
    const int ks = K >> 3, nst = ks >> 5;
    for (int t = bid; t < 256; t += gridDim.x) {
        const int rbase = MP + (t >> 4) * 32, cbase = (t & 15) * 64;
        const bf16_t* ap = A + (size_t)(rbase + lc) * K + w * ks + kq * 8; const bf16_t* bp = Bt + (size_t)(cbase + lc) * K + w * ks + kq * 8;
        f32x4 acc[2][4];
#pragma unroll
        for (int i = 0; i < 2; ++i)
#pragma unroll
            for (int j = 0; j < 4; ++j) acc[i][j] = (f32x4){0.f, 0.f, 0.f, 0.f};
        for (int s0 = 0; s0 < nst; s0 += 6) {
            bf16x8 a[6][2], b[6][4];
#pragma unroll
            for (int i = 0; i < 6; ++i) if (s0 + i < nst) {
#pragma unroll
                for (int r = 0; r < 2; ++r) a[i][r] = *(const bf16x8*)(ap + (size_t)r * 16 * K + (s0 + i) * 32);
#pragma unroll
                for (int c = 0; c < 4; ++c) b[i][c] = *(const bf16x8*)(bp + (size_t)c * 16 * K + (s0 + i) * 32); }
#pragma unroll
            for (int i = 0; i < 6; ++i) if (s0 + i < nst) {
#pragma unroll
                for (int r = 0; r < 2; ++r)
#pragma unroll
                    for (int c = 0; c < 4; ++c) acc[r][c] = __builtin_amdgcn_mfma_f32_16x16x32_bf16(a[i][r], b[i][c], acc[r][c], 0, 0, 0); }
        }
#pragma unroll
        for (int r = 0; r < 2; ++r)
#pragma unroll
            for (int c = 0; c < 4; ++c) *(LAS f32x4*)(red + ((w * 8 + r * 4 + c) * 64 + lane) * 4) = acc[r][c];
        __syncthreads();
        f32x4 sum = (f32x4){0.f, 0.f, 0.f, 0.f};
#pragma unroll
        for (int ww = 0; ww < 8; ++ww) sum += *(const LAS f32x4*)(red + ((ww * 8 + w) * 64 + lane) * 4);
        const int r0 = rbase + (w >> 2) * 16, c0 = cbase + (w & 3) * 16;
#pragma unroll
        for (int j = 0; j < 4; ++j) { const int r = r0 + kq * 4 + j, c = c0 + lc;
            if (MODE == 0) { const float base = from_in ? P.in[I_XS][(size_t)(r - MP) * DM + c] : P.out[(size_t)r * DM + c]; P.out[(size_t)r * DM + c] = base + sum[j]; }
            else { const bf16_t* proj = (const bf16_t*)(P.ws + OFF_PROJ); bf16_t* mp = (bf16_t*)(P.ws + OFF_TCAT) + (size_t)r * 1024 + c;
                float val = sigm(bf2f(proj[(size_t)r * NPROJ + C_GATE + MODE * 1024 + c])) * sum[j];
                if (MODE == 1) { const f32x4* sp = (const f32x4*)((const float*)(P.ws + OFF_SSQ) + (size_t)r * 16); const f32x4 s0 = sp[0], s1 = sp[1], s2 = sp[2], s3 = sp[3];
                    const float tot = ((s0[0] + s0[1]) + (s0[2] + s0[3])) + ((s1[0] + s1[1]) + (s1[2] + s1[3])) + ((s2[0] + s2[1]) + (s2[2] + s2[3])) + ((s3[0] + s3[1]) + (s3[2] + s3[3]));
                    val *= 1.f / sqrtf(tot * (1.f / 1024.f) + EPSN); *mp = f2bf(val); }
                else *mp = f2bf(bf2f(*mp) + val); } }
        __syncthreads();
    }
}

#define XB_TMO      128
#define XB_XCNT(j)  (256  + 64 * (j))
#define XB_XSUB(j)  (1280 + 64 * (j))
#define XB_XGEN(j)  (2304 + 64 * (j))
#define XB_TOP      3328
#define XB_TOPGEN   3392
#define XCD_BAR_WORDS 3456
#define XB_SPIN_CAP (1u << 18)
__device__ __forceinline__ unsigned xb_ld(unsigned* p)              { return __hip_atomic_load(p, __ATOMIC_RELAXED, __HIP_MEMORY_SCOPE_AGENT); }
__device__ __forceinline__ unsigned xb_add(unsigned* p, unsigned v) { return __hip_atomic_fetch_add(p, v, __ATOMIC_RELAXED, __HIP_MEMORY_SCOPE_AGENT); }
__device__ __forceinline__ unsigned xb_xcc_id() { return (unsigned)__builtin_amdgcn_s_getreg((3 << 11) | 20) & 0xFu; }
#define XB_SPIN(cond, bar) do { unsigned _sp = 0; while (cond) { __builtin_amdgcn_s_sleep(1); \
    if ((++_sp & 255u) == 0u) { if (xb_ld(&(bar)[XB_TMO])) break; if (_sp > XB_SPIN_CAP) { atomicAdd(&(bar)[XB_TMO], 1u); break; } } } } while (0)
__device__ __forceinline__ void xcd_barrier_post(unsigned* bar, int tid) { if (tid == 0) (void)xb_add(&bar[XB_XCNT(xb_xcc_id())], 1u); }
__device__ __forceinline__ void xcd_barrier_complete(unsigned* bar, unsigned x, unsigned& nloc, unsigned& nx) {
    const unsigned G = gridDim.x;
    unsigned sum, cnt, mine, sp = 0u;
    for (;;) {
        sum = 0u; cnt = 0u; mine = 0u;
#pragma unroll
        for (unsigned j = 0; j < 16; ++j) { const unsigned c = xb_ld(&bar[XB_XCNT(j)]); sum += c; cnt += (c > 0u) ? 1u : 0u; mine = (j == x) ? c : mine; }
        if (sum == G) break;
        __builtin_amdgcn_s_sleep(1);
        if ((++sp & 255u) == 0u) { if (xb_ld(&bar[XB_TMO])) break; if (sp > XB_SPIN_CAP) { atomicAdd(&bar[XB_TMO], 1u); break; } }
    }
    nloc = mine > 0u ? mine : 1u; nx = cnt > 0u ? cnt : 1u;
}
__device__ __forceinline__ void xcd_barrier(unsigned* bar, volatile LAS unsigned* st, int tid) {
    asm volatile("s_waitcnt vmcnt(0)" ::: "memory");
    __syncthreads();
    if (tid == 0) {
        const unsigned x = xb_xcc_id();
        __builtin_amdgcn_s_waitcnt(0);
        unsigned nloc = st[0], nx = st[1];
        if (nloc == 0u) { xcd_barrier_complete(bar, x, nloc, nx); st[0] = nloc; st[1] = nx; }
        const unsigned old = xb_add(&bar[XB_XSUB(x)], 1u);
        const unsigned gen = old / nloc;
        if (old + 1u == (gen + 1u) * nloc) {
            __builtin_amdgcn_fence(__ATOMIC_RELEASE, "agent");
            asm volatile("s_waitcnt vmcnt(0)" ::: "memory");
            const unsigned og = xb_add(&bar[XB_TOP], 1u);
            const unsigned tg = og / nx;
            if (og + 1u == (tg + 1u) * nx) xb_add(&bar[XB_TOPGEN], 1u);
            else XB_SPIN(xb_ld(&bar[XB_TOPGEN]) == tg, bar);
            __builtin_amdgcn_fence(__ATOMIC_ACQUIRE, "agent");
            xb_add(&bar[XB_XGEN(x)], 1u);
            asm volatile("s_waitcnt vmcnt(0)" ::: "memory");
        } else {
            XB_SPIN(xb_ld(&bar[XB_XGEN(x)]) == gen, bar);
            __builtin_amdgcn_fence(__ATOMIC_ACQUIRE, "agent");
            asm volatile("s_waitcnt vmcnt(0)" ::: "memory");
        }
    }
    __syncthreads();
}

__global__ void __launch_bounds__(NTH, 2) mega(Params P) {
    extern __shared__ __attribute__((aligned(16))) unsigned char lds_raw[];
    LAS unsigned char* L = (LAS unsigned char*)lds_raw;
    cg::grid_group grid = cg::this_grid();
    const int G = gridDim.x;
    const int wave_s = __builtin_amdgcn_readfirstlane((int)threadIdx.x >> 6);
#define TIDL() ({ int ln_; asm volatile("v_mbcnt_lo_u32_b32 %0, -1, 0\n\tv_mbcnt_hi_u32_b32 %0, -1, %0" : "=v"(ln_)); int t_ = wave_s * 64 + ln_; t_; })
#define BIDL() ({ int b_ = blockIdx.x; asm volatile("" : "+s"(b_)); b_; })
    const int tid0 = TIDL();
    unsigned char* ws = P.ws;
    unsigned* barw = (unsigned*)(ws + OFF_BAR);
    volatile LAS unsigned* xst = (volatile LAS unsigned*)(L + MISC_OFF + 16);
    if (tid0 == 0) { xst[0] = 0u; xst[1] = 0u; }
    __syncthreads();
    xcd_barrier_post(barw, tid0);
    if (ws == nullptr) grid.sync();
#define GSYNC() xcd_barrier(barw, xst, TIDL())
#ifndef DUP
#define DUP 0
#endif
#pragma unroll 1
    for (int l = 0; l < 2; ++l) {
        convert_weights(P, l, L, TIDL());
        if (DUP & 4) convert_weights(P, l, L, TIDL());
        norm_rows_bf16(P, l == 0, P.in[I_N1W] + l * 1024, (bf16_t*)(ws + OFF_XN), TIDL());
        GSYNC();
        small_g1_tail((const bf16_t*)(ws + OFF_XN), (const bf16_t*)(ws + W_IN), (bf16_t*)(ws + OFF_PROJ), TIDL(), BIDL());
        { Gemm g{(const bf16_t*)(ws + OFF_XN), (const bf16_t*)(ws + W_IN), MT, 8704, 1024}; StaticOrder S; S.init(MT, 8704, G, BIDL());
          EpiStoreBf16 E{(bf16_t*)(ws + OFF_PROJ), NPROJ}; gemm_phase(L, g, S, E, TIDL()); if (DUP & 2) gemm_phase(L, g, S, E, TIDL()); }
        GSYNC();
        mix_phase(P, l, L, TIDL());
        GSYNC();
        if (DUP & 1) { mix_phase(P, l, L, TIDL(), 1); GSYNC(); }
        if (DUP & 64) { mix_phase(P, l, L, TIDL(), 1, IT_SSDP + IT_HGP, IT_SSDP + IT_HGP + IT_S5P); GSYNC(); }
        if (DUP & 1024) { mix_phase(P, l, L, TIDL(), 1, 0, IT_SSDP); GSYNC(); }
        if (DUP & 2048) { mix_phase(P, l, L, TIDL(), 1, IT_SSDP, IT_SSDP + IT_HGP); GSYNC(); }
        if (DUP & 128) { mix_phase(P, l, L, TIDL(), 1, IT_SSDP + IT_HGP + IT_S5P, IT_TOTAL); GSYNC(); }
        small_gemm_ks<1>((const bf16_t*)(ws + OFF_XN), (const bf16_t*)(ws + W_SSD), 1024, P, 0, L, TIDL(), BIDL());
        { Gemm g{(const bf16_t*)(ws + OFF_XN), (const bf16_t*)(ws + W_SSD), MP, 1024, 1024}; StaticOrder S; S.init(MP, 1024, G, BIDL());
          EpiSG<true, false> E{(const bf16_t*)(ws + OFF_PROJ), (bf16_t*)(ws + OFF_TCAT), (const float*)(ws + OFF_SSQ), 1}; gemm_phase(L, g, S, E, TIDL()); }
        GSYNC();
        { Gemm g{(const bf16_t*)(ws + OFF_AGLU), (const bf16_t*)(ws + W_GLU), MT, 2048, 512}; StaticOrder S; S.init(MT, 2048, G, BIDL());
          EpiGlu E{(const bf16_t*)(ws + OFF_PROJ), (bf16_t*)(ws + OFF_TCAT)}; gemm_phase(L, g, S, E, TIDL()); }
        GSYNC();
        small_gemm_ks<2>((const bf16_t*)(ws + OFF_AHG), (const bf16_t*)(ws + W_HG), 512, P, 0, L, TIDL(), BIDL());
        { Gemm g{(const bf16_t*)(ws + OFF_AHG), (const bf16_t*)(ws + W_HG), MP, 1024, 512}; StaticOrder S; S.init(MP, 1024, G, BIDL());
          EpiSG<false, true> E{(const bf16_t*)(ws + OFF_PROJ), (bf16_t*)(ws + OFF_TCAT), nullptr, 2}; gemm_phase(L, g, S, E, TIDL()); }
        GSYNC();
        small_gemm_ks<0>((const bf16_t*)(ws + OFF_TCAT), (const bf16_t*)(ws + W_O3), 1024, P, l == 0, L, TIDL(), BIDL());
        { Gemm g{(const bf16_t*)(ws + OFF_TCAT), (const bf16_t*)(ws + W_O3), MP, 1024, 1024}; StaticOrder S; S.init(MP, 1024, G, BIDL());
          EpiRes E{P.in[I_XP], P.in[I_XS], P.out, l == 0}; gemm_phase(L, g, S, E, TIDL()); }
        GSYNC();
        norm_rows_bf16(P, 0, P.in[I_N2W] + l * 1024, (bf16_t*)(ws + OFF_XN), TIDL());
        GSYNC();
        { Gemm g{(const bf16_t*)(ws + OFF_XN), (const bf16_t*)(ws + W_UP), MT, NUP, 1024}; StaticOrder S; S.init(MT, NUP, G, BIDL());
          EpiStoreBf16 E{(bf16_t*)(ws + OFF_PROJ), NUP}; gemm_phase(L, g, S, E, TIDL()); if (DUP & 8) gemm_phase(L, g, S, E, TIDL()); }
        GSYNC();
        ffn_conv_phase(P, l, TIDL());
        if (DUP & 32) ffn_conv_phase(P, l, TIDL());
        if (DUP & 512) { for (int q_ = 0; q_ < 10; ++q_) GSYNC(); }
        if (DUP & 256) norm_rows_bf16(P, 0, P.in[I_N2W] + l * 1024, (bf16_t*)(ws + OFF_AGLU), TIDL());
        GSYNC();
        small_gemm_ks<0>((const bf16_t*)(ws + OFF_TCAT), (const bf16_t*)(ws + W_DN), DFF, P, 0, L, TIDL(), BIDL());
        { Gemm g{(const bf16_t*)(ws + OFF_TCAT), (const bf16_t*)(ws + W_DN), MP, 1024, DFF}; StaticOrder S; S.init(MP, 1024, G, BIDL());
          EpiRes E{P.in[I_XP], P.in[I_XS], P.out, 0}; gemm_phase(L, g, S, E, TIDL()); }
        GSYNC();
    }
    final_norm(P, TIDL());
}

extern "C" void kernel_launch(void* const* d_in, const int* in_sizes, int n_in, void* d_out, int out_size, void* d_ws, size_t ws_size, hipStream_t stream) {
    static int grid_blocks = 0;
    if (grid_blocks == 0) {
        if (n_in != 36 || ws_size < WS_END) { fprintf(stderr, "kernel_launch: unexpected n_in %d / ws_size %zu\n", n_in, ws_size); grid_blocks = -1; return; }
        int dev = 0, cus = 0, per_cu = 0;
        hipGetDevice(&dev);
        hipDeviceGetAttribute(&cus, hipDeviceAttributeMultiprocessorCount, dev);
        hipFuncSetAttribute((const void*)mega, hipFuncAttributeMaxDynamicSharedMemorySize, LDS_BYTES);
        hipOccupancyMaxActiveBlocksPerMultiprocessor(&per_cu, (const void*)mega, NTH, LDS_BYTES);
        if (per_cu < 1) per_cu = 1;
        grid_blocks = cus * 1;
        (void)hipGetLastError();
    }
    if (grid_blocks < 0) return;
    Params p{};
    for (int i = 0; i < 36; ++i) p.in[i] = (const float*)d_in[i];
    p.out = (float*)d_out; p.ws = (unsigned char*)d_ws;
    void* args[] = {&p};
    (void)hipMemsetAsync((unsigned char*)d_ws + OFF_CTL, 0, WS_END - OFF_CTL, stream);
    hipError_t e = hipLaunchCooperativeKernel((const void*)mega, dim3(grid_blocks), dim3(NTH), args, LDS_BYTES, stream);
    if (e != hipSuccess) fprintf(stderr, "cooperative launch failed: %s (grid %d)\n", hipGetErrorString(e), grid_blocks);
}
```
